# Optimizing an MI355X kernel written in HIP

```python
import jax, jax.numpy as jnp
from jax import lax
import numpy as np

D_MODEL = 1024
BATCH = 16
SEQ = 2048
DEPTH = 4
DEC_BATCH = 8
DEC_SEQ = 4096
PAST_LEN = 128

N_META = 16
GRID_W = 64
CONV_DIM = 256
CONV_WIDTH = 3
NA_HEADS = 4
NA_HEAD_DIM = 64
NA_DIM = NA_HEADS * NA_HEAD_DIM
NA_MAX_WIN_H = 8
NA_WIN_W = 16
MLA_HEADS = 8
MLA_NOPE_DIM = 64
MLA_ROPE_DIM = 32
MLA_V_DIM = 64
MLA_Q_RANK = 768
MLA_KV_RANK = 256
MLA_DIM = MLA_HEADS * MLA_V_DIM
MIX_DIM = CONV_DIM + NA_DIM + MLA_DIM
IN_PROJ_DIM = 3 * CONV_DIM + 3 * NA_DIM + MLA_Q_RANK + MLA_KV_RANK + MLA_ROPE_DIM
FFN_DIM = 2816
ROPE_THETA = 10000.0
RMS_EPS = 1e-6
Q_BLOCK = 128
F32 = jnp.float32

kernel_name = 'hybrid_conv_natten_mla_encoder'


def _rms_norm(x, g):
    xf = x.astype(F32)
    y = xf * lax.rsqrt(jnp.mean(xf * xf, axis=-1, keepdims=True) + RMS_EPS)
    return (y * g.astype(F32)).astype(x.dtype)


def _swiglu(x, w_gu, w_down):
    gate, up = jnp.split(x @ w_gu, 2, axis=-1)
    return (jax.nn.silu(gate) * up) @ w_down


def _rope(x, pos):
    half = x.shape[-1] // 2
    inv_freq = ROPE_THETA ** (-jnp.arange(half, dtype=F32) / half)
    ang = pos.astype(F32)[:, None] * inv_freq[None, :]
    cos = jnp.cos(ang)[None, :, None, :].astype(x.dtype)
    sin = jnp.sin(ang)[None, :, None, :].astype(x.dtype)
    x1, x2 = x[..., :half], x[..., half:]
    return jnp.concatenate([x1 * cos - x2 * sin, x1 * sin + x2 * cos], axis=-1)


def _short_conv(u, w):
    up = jnp.pad(u, ((0, 0), (1, 1), (0, 0)))
    return w[0] * up[:, :-2] + w[1] * up[:, 1:-1] + w[2] * up[:, 2:]


def _neighbourhood_attention(q, k, v, rpb, meta_bias):
    B, L, H, dh = q.shape
    T = L - N_META
    rows = T // GRID_W
    win_h = min(NA_MAX_WIN_H, rows)
    scale = dh ** -0.5
    q_m, k_m, v_m = q[:, :N_META], k[:, :N_META], v[:, :N_META]
    mb = meta_bias.astype(F32)[None, :, None, :]
    s_mm = jnp.einsum('bqhd,bmhd->bhqm', q_m, k_m).astype(F32) * scale + mb
    p_mm = jax.nn.softmax(s_mm, axis=-1).astype(v.dtype)
    o_meta = jnp.einsum('bhqm,bmhd->bqhd', p_mm, v_m)
    q_g = q[:, N_META:].reshape(B, rows, GRID_W, H, dh)
    k_g = k[:, N_META:].reshape(B, rows, GRID_W, H, dh)
    v_g = v[:, N_META:].reshape(B, rows, GRID_W, H, dh)
    col_start = np.clip(np.arange(GRID_W) - NA_WIN_W // 2, 0, GRID_W - NA_WIN_W)
    col_idx = col_start[:, None] + np.arange(NA_WIN_W)[None, :]
    col_rel = col_idx - np.arange(GRID_W)[:, None] + (NA_WIN_W - 1)
    rpb_c = rpb.astype(F32)[:, :, col_rel]
    n_loc = win_h * NA_WIN_W

    def row_block(args):
        r, q_row = args
        rs = jnp.clip(r - win_h // 2, 0, rows - win_h)
        k_rows = lax.dynamic_slice_in_dim(k_g, rs, win_h, axis=1)
        v_rows = lax.dynamic_slice_in_dim(v_g, rs, win_h, axis=1)
        k_win = k_rows[:, :, col_idx]
        v_win = v_rows[:, :, col_idx]
        row_rel = rs + jnp.arange(win_h) - r + (NA_MAX_WIN_H - 1)
        bias = jnp.take(rpb_c, row_rel, axis=1).transpose(0, 2, 1, 3)
        s_loc = jnp.einsum('bchd,bwcvhd->bhcwv', q_row, k_win).astype(F32) * scale + bias[None]
        s_loc = s_loc.reshape(B, H, GRID_W, n_loc)
        s_met = jnp.einsum('bchd,bmhd->bhcm', q_row, k_m).astype(F32) * scale + mb
        p = jax.nn.softmax(jnp.concatenate([s_loc, s_met], axis=-1), axis=-1).astype(v.dtype)
        p_loc = p[..., :n_loc].reshape(B, H, GRID_W, win_h, NA_WIN_W)
        p_met = p[..., n_loc:]
        return (jnp.einsum('bhcwv,bwcvhd->bchd', p_loc, v_win)
                + jnp.einsum('bhcm,bmhd->bchd', p_met, v_m))

    o_grid = lax.map(row_block, (jnp.arange(rows, dtype=jnp.int32), jnp.moveaxis(q_g, 1, 0)))
    o_grid = jnp.moveaxis(o_grid, 0, 1).reshape(B, T, H, dh)
    return jnp.concatenate([o_meta, o_grid], axis=1)


def _mla(q_lat, kv_lat, k_pe_raw, pos, q_norm, w_uq, kv_norm, w_ukv):
    B, L, _ = q_lat.shape
    q = (_rms_norm(q_lat, q_norm) @ w_uq).reshape(B, L, MLA_HEADS, MLA_NOPE_DIM + MLA_ROPE_DIM)
    q_nope = q[..., :MLA_NOPE_DIM]
    q_pe = _rope(q[..., MLA_NOPE_DIM:], pos)
    kv = (_rms_norm(kv_lat, kv_norm) @ w_ukv).reshape(B, L, MLA_HEADS, MLA_NOPE_DIM + MLA_V_DIM)
    k_nope = kv[..., :MLA_NOPE_DIM]
    v = kv[..., MLA_NOPE_DIM:]
    k_pe = _rope(k_pe_raw[:, :, None, :], pos)[:, :, 0]
    scale = (MLA_NOPE_DIM + MLA_ROPE_DIM) ** -0.5

    def attend(args):
        qn, qp = args
        s = (jnp.einsum('bqhd,bkhd->bhqk', qn, k_nope)
             + jnp.einsum('bqhd,bkd->bhqk', qp, k_pe)).astype(F32) * scale
        p = jax.nn.softmax(s, axis=-1).astype(v.dtype)
        return jnp.einsum('bhqk,bkhd->bqhd', p, v)

    o_meta = attend((q_nope[:, :N_META], q_pe[:, :N_META]))
    T = L - N_META
    nblk = T // Q_BLOCK
    qn_b = jnp.moveaxis(q_nope[:, N_META:].reshape(B, nblk, Q_BLOCK, MLA_HEADS, MLA_NOPE_DIM), 1, 0)
    qp_b = jnp.moveaxis(q_pe[:, N_META:].reshape(B, nblk, Q_BLOCK, MLA_HEADS, MLA_ROPE_DIM), 1, 0)
    o_b = lax.map(attend, (qn_b, qp_b))
    o_real = jnp.moveaxis(o_b, 0, 1).reshape(B, T, MLA_HEADS, MLA_V_DIM)
    return jnp.concatenate([o_meta, o_real], axis=1).reshape(B, L, MLA_DIM)


SPLIT_POINTS = [int(i) for i in np.cumsum([CONV_DIM] * 3 + [NA_DIM] * 3 + [MLA_Q_RANK, MLA_KV_RANK])]


def _mixer(h, pos, w_in, conv_w, na_rpb, na_meta_bias, mla_q_norm, mla_w_uq, mla_kv_norm, mla_w_ukv,
           conv_out_norm, na_out_norm, mla_out_norm, w_o):
    B, L, _ = h.shape
    z = h @ w_in
    cb, cc, cu, nq, nk, nv, q_lat, kv_lat, k_pe_raw = jnp.split(z, SPLIT_POINTS, axis=-1)
    y_conv = cb * _short_conv(cc * cu, conv_w)
    shp = (B, L, NA_HEADS, NA_HEAD_DIM)
    y_na = _neighbourhood_attention(nq.reshape(shp), nk.reshape(shp), nv.reshape(shp),
                                    na_rpb, na_meta_bias).reshape(B, L, NA_DIM)
    y_mla = _mla(q_lat, kv_lat, k_pe_raw, pos, mla_q_norm, mla_w_uq, mla_kv_norm, mla_w_ukv)
    y = jnp.concatenate([_rms_norm(y_conv, conv_out_norm), _rms_norm(y_na, na_out_norm),
                         _rms_norm(y_mla, mla_out_norm)], axis=-1)
    return y @ w_o


def _layer(h, pos, w):
    (f1_pre, f1_gu, f1_down, f1_post, m_pre, w_in, conv_w, na_rpb, na_meta_bias, q_norm, w_uq,
     kv_norm, w_ukv, c_on, n_on, m_on, w_o, m_post, f2_pre, f2_gu, f2_down, f2_post) = w
    h = h + 0.5 * _rms_norm(_swiglu(_rms_norm(h, f1_pre), f1_gu, f1_down), f1_post)
    h = h + _rms_norm(_mixer(_rms_norm(h, m_pre), pos, w_in, conv_w, na_rpb, na_meta_bias, q_norm, w_uq,
                             kv_norm, w_ukv, c_on, n_on, m_on, w_o), m_post)
    h = h + 0.5 * _rms_norm(_swiglu(_rms_norm(h, f2_pre), f2_gu, f2_down), f2_post)
    return h


def _trunk(x, meta_tokens, weights):
    B, T, _ = x.shape
    L = N_META + T
    meta = jnp.broadcast_to(meta_tokens.astype(x.dtype)[None], (B, N_META, D_MODEL))
    h = jnp.concatenate([meta, x], axis=1)
    pos = jnp.arange(L, dtype=jnp.int32)
    for l in range(DEPTH):
        h = _layer(h, pos, tuple(wt[l] for wt in weights))
    return h[:, N_META:]


def setup_inputs(seed: int = 0) -> dict:
    key = jax.random.key(seed)
    ks = jax.random.split(key, 32)

    def w(k, shape, fan_in):
        return jax.random.normal(k, shape, F32) * fan_in ** -0.5

    def g(k, shape):
        return 1.0 + 0.05 * jax.random.normal(k, shape, F32)

    D = DEPTH
    return {
        'x_prompt': jax.random.normal(ks[0], (BATCH, SEQ, D_MODEL), F32),
        'x_sample': jax.random.normal(ks[1], (DEC_BATCH, DEC_SEQ, D_MODEL), F32),
        'meta_tokens': jax.random.normal(ks[2], (N_META, D_MODEL), F32),
        'ffn1_pre_norm': g(ks[3], (D, D_MODEL)),
        'ffn1_w_gu': w(ks[4], (D, D_MODEL, 2 * FFN_DIM), D_MODEL),
        'ffn1_w_down': w(ks[5], (D, FFN_DIM, D_MODEL), FFN_DIM),
        'ffn1_post_norm': g(ks[6], (D, D_MODEL)),
        'mix_pre_norm': g(ks[7], (D, D_MODEL)),
        'w_in': w(ks[8], (D, D_MODEL, IN_PROJ_DIM), D_MODEL),
        'conv_w': w(ks[9], (D, CONV_WIDTH, CONV_DIM), CONV_WIDTH),
        'na_rpb': 0.1 * jax.random.normal(ks[10], (D, NA_HEADS, 2 * NA_MAX_WIN_H - 1, 2 * NA_WIN_W - 1), F32),
        'na_meta_bias': 0.1 * jax.random.normal(ks[11], (D, NA_HEADS, N_META), F32),
        'mla_q_norm': g(ks[12], (D, MLA_Q_RANK)),
        'mla_w_uq': w(ks[13], (D, MLA_Q_RANK, MLA_HEADS * (MLA_NOPE_DIM + MLA_ROPE_DIM)), MLA_Q_RANK),
        'mla_kv_norm': g(ks[14], (D, MLA_KV_RANK)),
        'mla_w_ukv': w(ks[15], (D, MLA_KV_RANK, MLA_HEADS * (MLA_NOPE_DIM + MLA_V_DIM)), MLA_KV_RANK),
        'conv_out_norm': g(ks[16], (D, CONV_DIM)),
        'na_out_norm': g(ks[17], (D, NA_DIM)),
        'mla_out_norm': g(ks[18], (D, MLA_DIM)),
        'w_o': w(ks[19], (D, MIX_DIM, D_MODEL), MIX_DIM),
        'mix_post_norm': g(ks[20], (D, D_MODEL)),
        'ffn2_pre_norm': g(ks[21], (D, D_MODEL)),
        'ffn2_w_gu': w(ks[22], (D, D_MODEL, 2 * FFN_DIM), D_MODEL),
        'ffn2_w_down': w(ks[23], (D, FFN_DIM, D_MODEL), FFN_DIM),
        'ffn2_post_norm': g(ks[24], (D, D_MODEL)),
    }


def reference(x_prompt, x_sample, meta_tokens, ffn1_pre_norm, ffn1_w_gu, ffn1_w_down, ffn1_post_norm,
              mix_pre_norm, w_in, conv_w, na_rpb, na_meta_bias, mla_q_norm, mla_w_uq, mla_kv_norm, mla_w_ukv,
              conv_out_norm, na_out_norm, mla_out_norm, w_o, mix_post_norm, ffn2_pre_norm, ffn2_w_gu,
              ffn2_w_down, ffn2_post_norm):
    weights = (ffn1_pre_norm, ffn1_w_gu, ffn1_w_down, ffn1_post_norm, mix_pre_norm, w_in, conv_w, na_rpb,
               na_meta_bias, mla_q_norm, mla_w_uq, mla_kv_norm, mla_w_ukv, conv_out_norm, na_out_norm,
               mla_out_norm, w_o, mix_post_norm, ffn2_pre_norm, ffn2_w_gu, ffn2_w_down, ffn2_post_norm)
    y_prompt = _trunk(x_prompt, meta_tokens, weights)
    y_sample = _trunk(x_sample, meta_tokens, weights)
    return (y_prompt, y_sample)
```

```cpp
#include <hip/hip_runtime.h>
#include <hip/hip_cooperative_groups.h>
#include <cstdio>
#include <cstdint>
namespace cg = cooperative_groups;
namespace pg8 {
#define PG8_LAS __attribute__((address_space(3)))
typedef unsigned short bf16_t;
typedef short bf16x8 __attribute__((ext_vector_type(8)));
typedef float f32x4 __attribute__((ext_vector_type(4)));
typedef unsigned u32x4 __attribute__((ext_vector_type(4)));
constexpr int BM = 256, BK = 64, HALF = 128, HTB = HALF * BK * 2  , STAGE_BYTES = 8 * HTB, NXCD = 8, WGM = 8;

__host__ __device__ __forceinline__ int lds_byte(int r, int c) { const int st = (r >> 4) * 2 + (c >> 5), rr = r & 15, cc = c & 31, ob = rr * 64 + cc * 2; return st * 1024 + (ob ^ (((ob >> 9) & 1) << 5)); }
__host__ __device__ __forceinline__ void stage_rc(int b, int& R, int& C) { const int st = b / 1024, sb = b % 1024, swz = sb ^ (((sb >> 9) & 1) << 5); R = (st >> 1) * 16 + swz / 64; C = (st & 1) * 32 + (swz % 64) / 2; }
__host__ __device__ __forceinline__ int perm32(int rho) { const int n = rho >> 4, i = rho & 15; return 8 * (i >> 2) + 4 * n + (i & 3); }

struct Unit { int pm, pn; };
struct Gemm { const bf16_t* A; const bf16_t* Bt; int M, N, K, lda, ldb; };

struct StaticOrder {
    int nM, nN, nwg, G, c;
    __host__ __device__ void init(int M, int N, int G_, int c_, int shift = 0) { nM = M / BM; nN = N / BM; nwg = nM * nN; G = G_; c = (c_ + shift) % G_; }
    __host__ __device__ bool next(int i, Unit& u) const {
        const long L = (long)i * G + c; if (L >= nwg) return false;
        int wgid = (int)L; { const int q = nwg / NXCD, r = nwg % NXCD, xcd = wgid % NXCD, off = wgid / NXCD; wgid = (xcd < r ? xcd * (q + 1) : r * (q + 1) + (xcd - r) * q) + off; }
        const int nig = WGM * nN, gid = wgid / nig, fm = gid * WGM, gsz = (nM - fm) < WGM ? (nM - fm) : WGM;
        u.pm = fm + ((wgid % nig) % gsz); u.pn = (wgid % nig) / gsz; return true;
    }
    __device__ __forceinline__ void a_ready(const Unit&) const {}
    __device__ __forceinline__ void done(const Unit&) const {}
};

__device__ __forceinline__ unsigned cvt_pk_bf16(float lo, float hi) { typedef float f2 __attribute__((ext_vector_type(2))); typedef __bf16 b2 __attribute__((ext_vector_type(2))); f2 v = {lo, hi}; b2 b = __builtin_convertvector(v, b2); return __builtin_bit_cast(unsigned, b); }
constexpr float LOG2E = 1.4426950408889634f;
constexpr float RMS_EPS = 1e-6f;
#define EPI_STORE8(ptr, v0, v1) do { u32x4 w_; w_.x = cvt_pk_bf16((v0)[0], (v0)[1]); w_.y = cvt_pk_bf16((v0)[2], (v0)[3]); w_.z = cvt_pk_bf16((v1)[0], (v1)[1]); w_.w = cvt_pk_bf16((v1)[2], (v1)[3]); *(u32x4*)(ptr) = w_; } while (0)
struct EpiPlain {
    static constexpr bool PERM = true, AFTER_DRAIN = false;
    bf16_t* O; int ldc;
    __device__ __forceinline__ void operator()(const f32x4 (&acc)[2][2][4][2], const Unit& u, int wr, int wc, int fr, int fq) const {
        const int row0 = u.pm * BM + wr * 64 + fr, col0 = u.pn * BM + wc * 32 + 8 * fq;
#pragma unroll
        for (int ai = 0; ai < 2; ++ai)
#pragma unroll
            for (int m = 0; m < 4; ++m) { bf16_t* rowp = O + (size_t)(row0 + ai * HALF + m * 16) * ldc + col0;
#pragma unroll
                for (int bj = 0; bj < 2; ++bj) EPI_STORE8(rowp + bj * HALF, acc[ai][bj][m][0], acc[ai][bj][m][1]); }
    }
};
__device__ __forceinline__ float silu_mul(float g, float u) { return g * u * __builtin_amdgcn_rcpf(1.0f + __builtin_amdgcn_exp2f(-g * LOG2E)); }
struct EpiSwiGLU {
    static constexpr bool PERM = true, AFTER_DRAIN = false;
    bf16_t* O; int ldc;
    __device__ __forceinline__ void operator()(const f32x4 (&acc)[2][2][4][2], const Unit& u, int wr, int wc, int fr, int fq) const {
        const int row0 = u.pm * BM + wr * 64 + fr, col0 = u.pn * HALF + wc * 32 + 8 * fq;
#pragma unroll
        for (int ai = 0; ai < 2; ++ai)
#pragma unroll
            for (int m = 0; m < 4; ++m) { bf16_t* rowp = O + (size_t)(row0 + ai * HALF + m * 16) * ldc + col0;
                f32x4 v0, v1;
#pragma unroll
                for (int e = 0; e < 4; ++e) { v0[e] = silu_mul(acc[ai][0][m][0][e], acc[ai][1][m][0][e]); v1[e] = silu_mul(acc[ai][0][m][1][e], acc[ai][1][m][1][e]); }
                EPI_STORE8(rowp, v0, v1); }
    }
};
struct EpiInProj {
    static constexpr bool PERM = true, AFTER_DRAIN = false;
    bf16_t* Z; float* SSP;
    __device__ __forceinline__ void operator()(const f32x4 (&acc)[2][2][4][2], const Unit& u, int wr, int wc, int fr, int fq) const {
        const int row0 = u.pm * BM + wr * 64 + fr;
#pragma unroll
        for (int bj = 0; bj < 2; ++bj) {
            const int G = 8 * u.pn + 4 * bj + wc, col0 = 32 * G;
            if (col0 >= 2592) continue;
            const float sc = (col0 >= 768 && col0 < 1024) ? 0.125f * LOG2E : 1.0f;
            const bool doss = (G >= 48 && G < 80); const int slot = G - 48;
#pragma unroll
            for (int ai = 0; ai < 2; ++ai)
#pragma unroll
                for (int m = 0; m < 4; ++m) { const int row = row0 + ai * HALF + m * 16;
                    const f32x4 v0 = acc[ai][bj][m][0] * sc, v1 = acc[ai][bj][m][1] * sc;
                    if (doss) { float s = (v0[0] * v0[0] + v0[1] * v0[1]) + (v0[2] * v0[2] + v0[3] * v0[3]) + (v1[0] * v1[0] + v1[1] * v1[1]) + (v1[2] * v1[2] + v1[3] * v1[3]);
                        s += __shfl_xor(s, 16); s += __shfl_xor(s, 32); if (fq == 0) SSP[(size_t)row * 32 + slot] = s; }
                    EPI_STORE8(Z + (size_t)row * 2592 + col0 + 8 * fq, v0, v1); }
        }
    }
};
struct EpiRowScale {
    static constexpr bool PERM = true, AFTER_DRAIN = false;
    bf16_t* O; int ldo; const float* SSP; int slot0, nslot4; float invn, extra; int kmap; PG8_LAS float* tab;
    __device__ __forceinline__ void operator()(const f32x4 (&acc)[2][2][4][2], const Unit& u, int wr, int wc, int fr, int fq) const {
        const int row0 = u.pm * BM + wr * 64 + fr;
        __builtin_amdgcn_s_barrier();
        { const int t = threadIdx.x; if (t < 256) { const f32x4* sp = (const f32x4*)(SSP + (size_t)(u.pm * BM + t) * 32 + slot0); float s = 0.f;
            for (int k = 0; k < nslot4; ++k) { const f32x4 v = sp[k]; s += (v[0] + v[1]) + (v[2] + v[3]); }
            tab[t] = __builtin_amdgcn_rsqf(s * invn + RMS_EPS) * extra; } }
        asm volatile("s_waitcnt lgkmcnt(0)" ::: "memory"); __builtin_amdgcn_s_barrier(); asm volatile("" ::: "memory");
#pragma unroll
        for (int ai = 0; ai < 2; ++ai)
#pragma unroll
            for (int m = 0; m < 4; ++m) { const float rs = tab[ai * HALF + wr * 64 + m * 16 + fr];
#pragma unroll
                for (int bj = 0; bj < 2; ++bj) { const int c0 = u.pn * BM + bj * HALF + wc * 32; const int dc = (kmap ? 96 * (c0 >> 6) + (c0 & 63) : c0) + 8 * fq;
                    const f32x4 v0 = acc[ai][bj][m][0] * rs, v1 = acc[ai][bj][m][1] * rs;
                    EPI_STORE8(O + (size_t)(row0 + ai * HALF + m * 16) * ldo + dc, v0, v1); } }
    }
};
struct EpiColScale {
    static constexpr bool PERM = true, AFTER_DRAIN = false;
    bf16_t* O; int ldo; const float* SSP; PG8_LAS float* tab;
    __device__ __forceinline__ void operator()(const f32x4 (&acc)[2][2][4][2], const Unit& u, int wr, int wc, int fr, int fq) const {
        const int row0 = u.pm * BM + wr * 64 + fr;
        __builtin_amdgcn_s_barrier();
        { const int t = threadIdx.x; if (t < 256) { const f32x4* sp = (const f32x4*)(SSP + (size_t)(u.pn * BM + t) * 32 + 24); const f32x4 a = sp[0], b = sp[1];
            tab[t] = __builtin_amdgcn_rsqf(((a[0] + a[1]) + (a[2] + a[3]) + (b[0] + b[1]) + (b[2] + b[3])) * (1.0f / 256.0f) + RMS_EPS); } }
        asm volatile("s_waitcnt lgkmcnt(0)" ::: "memory"); __builtin_amdgcn_s_barrier(); asm volatile("" ::: "memory");
#pragma unroll
        for (int bj = 0; bj < 2; ++bj) { const int cl = bj * HALF + wc * 32 + 8 * fq, c0 = u.pn * BM + cl;
            const f32x4 s0 = *(const PG8_LAS f32x4*)(tab + cl), s1 = *(const PG8_LAS f32x4*)(tab + cl + 4);
#pragma unroll
            for (int ai = 0; ai < 2; ++ai)
#pragma unroll
                for (int m = 0; m < 4; ++m) { const f32x4 v0 = acc[ai][bj][m][0] * s0, v1 = acc[ai][bj][m][1] * s1;
                    EPI_STORE8(O + (size_t)(row0 + ai * HALF + m * 16) * ldo + c0, v0, v1); } }
    }
};
template <class Epi, class Sched, bool ALIGN_EPI = false, bool SP2 = false>
__device__ __forceinline__ void gemm_phase(PG8_LAS unsigned char* lds, const Gemm g, const Sched& S, const Epi& E) {
    int tid_l = threadIdx.x; asm volatile("" : "+v"(tid_l)); const int tid = tid_l, wid = __builtin_amdgcn_readfirstlane(tid >> 6), lane = tid & 63, wr = wid >> 2, wc = wid & 3, fr = lane & 15, fq = lane >> 4;
    int K_l = g.K; asm volatile("" : "+s"(K_l)); const int K = K_l, nt = K / BK;
    unsigned voffA[2], voffB[2];
#pragma unroll
    for (int i = 0; i < 2; ++i) { int R, C; stage_rc(tid * 16 + i * 8192, R, C); const int Rb = Epi::PERM ? ((R & ~31) + perm32(R & 31)) : R;
        voffA[i] = (unsigned)(R * g.lda + C) * 2u; voffB[i] = (unsigned)(Rb * g.ldb + C) * 2u; }
    const size_t kstep = (size_t)(BK * 2);
    const size_t hstepA = (size_t)HALF * g.lda * 2, hstepB = (size_t)HALF * g.ldb * 2;
    const size_t tstepA = 2 * hstepA, tstepB = 2 * hstepB;
    const unsigned ldsw = (unsigned)wid * 1024u;
    const int aoff = lds_byte(wr * 64 + fr, fq * 8), boff = lds_byte(wc * 32 + fr, fq * 8);
#define PG8_SA(b, h) (((b) * 2 + (h)) * HTB)
#define PG8_SB(b, h) ((4 + (b) * 2 + (h)) * HTB)
#define PG8_STAGE(bufoff, gbase, voff) do { _Pragma("unroll") for (int _i = 0; _i < 2; ++_i) \
        __builtin_amdgcn_global_load_lds((const unsigned*)((const char*)(gbase) + (voff)[_i]), (PG8_LAS unsigned*)(lds + (bufoff) + ldsw + _i * 8192), 16, 0, 0); } while (0)
#define PG8_LDA(dst, b, h) do { _Pragma("unroll") for (int m = 0; m < 4; ++m) _Pragma("unroll") for (int k = 0; k < 2; ++k) dst[m][k] = *(const PG8_LAS bf16x8*)(lds + PG8_SA(b, h) + aoff + m * 2048 + k * 1024); } while (0)
#define PG8_LDB(dst, b, h) do { _Pragma("unroll") for (int n = 0; n < 2; ++n) _Pragma("unroll") for (int k = 0; k < 2; ++k) dst[n][k] = *(const PG8_LAS bf16x8*)(lds + PG8_SB(b, h) + boff + n * 2048 + k * 1024); } while (0)
#define PG8_MMA(ai, bj, At, Bt) do { __builtin_amdgcn_s_setprio(1); _Pragma("unroll") for (int m = 0; m < 4; ++m) _Pragma("unroll") for (int n = 0; n < 2; ++n) _Pragma("unroll") for (int k = 0; k < 2; ++k) \
        acc[ai][bj][m][n] = __builtin_amdgcn_mfma_f32_16x16x32_bf16(Bt[n][k], At[m][k], acc[ai][bj][m][n], 0, 0, 0); __builtin_amdgcn_s_setprio(0); } while (0)
#define PG8_WAIT_V(n) asm volatile("s_waitcnt vmcnt(" #n ")" ::: "memory")
#define PG8_WAIT_L(n) asm volatile("s_waitcnt lgkmcnt(" #n ")" ::: "memory")
#define PG8_BAR __builtin_amdgcn_s_barrier()
#define PG8_SCHED __builtin_amdgcn_sched_barrier(0)
    Unit cur, nxt; int ui = 0;
    if (!S.next(0, cur)) return;
    f32x4 acc[2][2][4][2];
#pragma unroll
    for (int a = 0; a < 2; ++a)
#pragma unroll
        for (int b = 0; b < 2; ++b)
#pragma unroll
            for (int m = 0; m < 4; ++m)
#pragma unroll
                for (int n = 0; n < 2; ++n) acc[a][b][m][n] = (f32x4){0.f, 0.f, 0.f, 0.f};
    bf16x8 At[4][2], B0[2][2], B1[2][2];
    const char* cA = (const char*)g.A + (size_t)cur.pm * tstepA; const char* cB = (const char*)g.Bt + (size_t)cur.pn * tstepB;
    S.a_ready(cur);
    if constexpr (SP2) {
        PG8_STAGE(PG8_SB(0, 0), cB, voffB); PG8_STAGE(PG8_SB(0, 1), cB + hstepB, voffB); PG8_STAGE(PG8_SA(0, 0), cA, voffA); PG8_STAGE(PG8_SA(0, 1), cA + hstepA, voffA);
        if (wr == 1) PG8_BAR;
        PG8_WAIT_V(2); PG8_BAR;
        PG8_STAGE(PG8_SB(1, 0), cB + kstep, voffB); PG8_STAGE(PG8_SA(1, 0), cA + kstep, voffA); PG8_STAGE(PG8_SB(1, 1), cB + hstepB + kstep, voffB);
        PG8_WAIT_V(6); PG8_BAR;
    } else {
        PG8_STAGE(PG8_SB(0, 0), cB, voffB); PG8_STAGE(PG8_SA(0, 0), cA, voffA); PG8_STAGE(PG8_SB(0, 1), cB + hstepB, voffB); PG8_STAGE(PG8_SA(0, 1), cA + hstepA, voffA);
        if (wr == 1) PG8_BAR;
        PG8_WAIT_V(4); PG8_BAR;
        PG8_STAGE(PG8_SB(1, 0), cB + kstep, voffB); PG8_STAGE(PG8_SA(1, 0), cA + kstep, voffA); PG8_STAGE(PG8_SB(1, 1), cB + hstepB + kstep, voffB);
        PG8_WAIT_V(6); PG8_BAR;
    }
    for (;;) {
        const bool has_next = S.next(ui + 1, nxt);
        const char* nA = has_next ? (const char*)g.A + (size_t)nxt.pm * tstepA : cA; const char* nB = has_next ? (const char*)g.Bt + (size_t)nxt.pn * tstepB : cB;
        for (int t = 0; t < nt; t += 2) {
            const bool last = (t == nt - 2);
            const char* a1 = cA + (size_t)(t + 1) * kstep;
            const char* a2 = last ? nA : cA + (size_t)(t + 2) * kstep; const char* b2 = last ? nB : cB + (size_t)(t + 2) * kstep;
            const char* a3 = a2 + kstep; const char* b3 = b2 + kstep;
            if (last && has_next) S.a_ready(nxt);
            if constexpr (SP2) {
            PG8_LDB(B0, 0, 0); PG8_LDB(B1, 0, 1); PG8_SCHED; PG8_LDA(At, 0, 0); PG8_STAGE(PG8_SA(1, 1), a1 + hstepA, voffA);
            PG8_WAIT_V(8); PG8_WAIT_L(0); PG8_BAR; PG8_MMA(0, 0, At, B0); PG8_MMA(0, 1, At, B1); PG8_BAR; PG8_SCHED;
            PG8_LDA(At, 0, 1); PG8_STAGE(PG8_SB(0, 0), b2, voffB); PG8_STAGE(PG8_SB(0, 1), b2 + hstepB, voffB); PG8_STAGE(PG8_SA(0, 0), a2, voffA);
            PG8_WAIT_V(8); PG8_WAIT_L(0); PG8_BAR; PG8_MMA(1, 0, At, B0); PG8_MMA(1, 1, At, B1); PG8_BAR; PG8_SCHED;
            PG8_LDB(B0, 1, 0); PG8_LDB(B1, 1, 1); PG8_SCHED; PG8_LDA(At, 1, 0); PG8_STAGE(PG8_SA(0, 1), a2 + hstepA, voffA);
            PG8_WAIT_V(8); PG8_WAIT_L(0); PG8_BAR; PG8_MMA(0, 0, At, B0); PG8_MMA(0, 1, At, B1); PG8_BAR; PG8_SCHED;
            PG8_LDA(At, 1, 1); PG8_STAGE(PG8_SB(1, 0), b3, voffB); PG8_STAGE(PG8_SB(1, 1), b3 + hstepB, voffB); PG8_STAGE(PG8_SA(1, 0), a3, voffA);
            PG8_WAIT_V(8); PG8_WAIT_L(0); PG8_BAR; PG8_MMA(1, 0, At, B0); PG8_MMA(1, 1, At, B1); PG8_BAR; PG8_SCHED;
            } else {
            PG8_LDB(B0, 0, 0); PG8_SCHED; PG8_LDA(At, 0, 0); PG8_STAGE(PG8_SA(1, 1), a1 + hstepA, voffA);
            PG8_WAIT_L(8); PG8_BAR; PG8_WAIT_L(0); PG8_MMA(0, 0, At, B0); PG8_BAR; PG8_SCHED;
            PG8_LDB(B1, 0, 1); PG8_STAGE(PG8_SB(0, 0), b2, voffB);
            PG8_BAR; PG8_WAIT_L(0); PG8_MMA(0, 1, At, B1); PG8_BAR;
            PG8_LDA(At, 0, 1); PG8_STAGE(PG8_SA(0, 0), a2, voffA);
            PG8_BAR; PG8_WAIT_L(0); PG8_MMA(1, 0, At, B0); PG8_BAR; PG8_SCHED;
            PG8_STAGE(PG8_SB(0, 1), b2 + hstepB, voffB);
            PG8_WAIT_V(6); PG8_BAR; PG8_MMA(1, 1, At, B1); PG8_BAR;
            PG8_LDB(B0, 1, 0); PG8_SCHED; PG8_LDA(At, 1, 0); PG8_STAGE(PG8_SA(0, 1), a2 + hstepA, voffA);
            PG8_WAIT_L(8); PG8_BAR; PG8_WAIT_L(0); PG8_MMA(0, 0, At, B0); PG8_BAR; PG8_SCHED;
            PG8_LDB(B1, 1, 1); PG8_STAGE(PG8_SB(1, 0), b3, voffB);
            PG8_BAR; PG8_WAIT_L(0); PG8_MMA(0, 1, At, B1); PG8_BAR;
            PG8_LDA(At, 1, 1); PG8_STAGE(PG8_SA(1, 0), a3, voffA);
            PG8_BAR; PG8_WAIT_L(0); PG8_MMA(1, 0, At, B0); PG8_BAR; PG8_SCHED;
            PG8_STAGE(PG8_SB(1, 1), b3 + hstepB, voffB);
            PG8_WAIT_V(6); PG8_BAR; PG8_MMA(1, 1, At, B1); PG8_BAR;
            }
        }
        if constexpr (ALIGN_EPI) { if (wr == 0) PG8_BAR; }
        if constexpr (!Epi::AFTER_DRAIN) { E(acc, cur, wr, wc, fr, fq); S.done(cur); }
        if (!has_next) break;
#pragma unroll
        for (int a = 0; a < 2; ++a)
#pragma unroll
            for (int b = 0; b < 2; ++b)
#pragma unroll
                for (int m = 0; m < 4; ++m)
#pragma unroll
                    for (int n = 0; n < 2; ++n) acc[a][b][m][n] = (f32x4){0.f, 0.f, 0.f, 0.f};
        cur = nxt; cA = nA; cB = nB; ++ui;
        if constexpr (ALIGN_EPI) { if (wr == 1) PG8_BAR; }
    }
    PG8_WAIT_V(0);
    if constexpr (!ALIGN_EPI) { if (wr == 0) PG8_BAR; }
    PG8_BAR;
    if constexpr (Epi::AFTER_DRAIN) { E.fused(acc, cur, wr, wc, fr, fq, lds, wid, lane); S.done(cur); }
#undef PG8_SA
#undef PG8_SB
#undef PG8_STAGE
#undef PG8_LDA
#undef PG8_LDB
#undef PG8_MMA
#undef PG8_WAIT_V
#undef PG8_WAIT_L
#undef PG8_BAR
#undef PG8_SCHED
}
}
#define LAS __attribute__((address_space(3)))
typedef unsigned short bf16;
typedef unsigned u32x4 __attribute__((ext_vector_type(4)));
typedef unsigned u32x2 __attribute__((ext_vector_type(2)));
typedef float f32x4 __attribute__((ext_vector_type(4)));
typedef float f32x16 __attribute__((ext_vector_type(16)));
typedef short bf16x8 __attribute__((ext_vector_type(8)));
typedef short s16x4 __attribute__((ext_vector_type(4)));
using pg8::cvt_pk_bf16; using pg8::LOG2E; using pg8::RMS_EPS;

constexpr int NWAVES = 8, NTHR = 512;
constexpr int DM = 1024, FF = 2816, ZP = 2592, NINP = 2816, DEPTH = 4;
constexpr int MP = 67072;
constexpr int G0_ROWS = 33792, G1_ROWS = 33280;
constexpr size_t MiB = 1u << 20;
constexpr size_t WS_CTL = 0, WS_ROPE = 1 * MiB, WS_SSP = 2 * MiB, WS_METAH = 11 * MiB, WS_W = 13 * MiB, WS_XY = 61 * MiB, WS_BIG = 192 * MiB, WS_END = 553 * MiB;
constexpr size_t W_GU1 = 0, W_DN1 = 11 * MiB, W_GU2 = 33 * MiB / 2, W_DN2 = 55 * MiB / 2, W_IN = 33 * MiB, W_UQ = 77 * MiB / 2, W_UK = 40 * MiB, W_UV = 40 * MiB + MiB / 4, W_O = 40 * MiB + MiB / 2;
constexpr size_t B_Z = 0, B_K = 168 * MiB, B_VT = 218 * MiB, B_YC = 251 * MiB;
constexpr int LDS_BYTES = 147456;
constexpr int A_K = 0, A_KBUF = 64 * 208, A_V = 2 * A_KBUF, A_VBUF = 64 * 144, A_WSF = A_V + 2 * A_VBUF, A_STG = A_WSF + 8 * 256, A_TAB = A_STG + 8 * 4096, A_UW = A_TAB + 4 * 640 * 4 + 256;
static_assert(A_UW + 64 <= 131072, "attention LDS");

struct Args { const float* in[25]; float* out; unsigned char* ws; };
enum { I_XP = 0, I_XS, I_META, I_F1PRE, I_F1GU, I_F1DN, I_F1POST, I_MPRE, I_WIN, I_CONVW, I_RPB, I_MB, I_QN, I_WUQ, I_KVN, I_WUKV, I_CON, I_NON, I_MON, I_WO, I_MPOST, I_F2PRE, I_F2GU, I_F2DN, I_F2POST };

__device__ __forceinline__ float bf2f(unsigned short b) { return __uint_as_float((unsigned)b << 16); }
__device__ __forceinline__ float bflo(unsigned w) { return __uint_as_float(w << 16); }
__device__ __forceinline__ float bfhi(unsigned w) { return __uint_as_float(w & 0xffff0000u); }
__device__ __forceinline__ float wave_sum(float v) {
#pragma unroll
    for (int o = 1; o < 64; o <<= 1) v += __shfl_xor(v, o);
    return v;
}
__device__ __forceinline__ void row_decode(int row, int& s, int& i, int& T) {
    if (row < G0_ROWS) { s = row / 2112; i = row - s * 2112; T = 2048; } else { const int r = row - G0_ROWS, q = r / 4160; s = 16 + q; i = r - q * 4160; T = 4096; }
}
__device__ __forceinline__ float* hptr(float* out, float* metah, int s, int i, int T) {
    if (i < T) { const size_t ob = s < 16 ? (size_t)s * 2048 : (size_t)32768 + (size_t)(s - 16) * 4096; return out + (ob + i) * DM; }
    return metah + (size_t)(s * 16 + (i - T)) * DM;
}
__device__ __forceinline__ void wt_item(const float* W, int ldw, int K, bf16* WT, const float* gain, int k0, int srcn0, int dstn0, LAS float* scr, int lane) {
    const int c = lane & 7;
    if (srcn0 < 0) {
#pragma unroll
        for (int j = 0; j < 4; ++j) { const int n = (lane >> 3) + 8 * j; *(u32x4*)(WT + (size_t)(dstn0 + n) * K + k0 + 8 * c) = (u32x4){0u, 0u, 0u, 0u}; }
        return;
    }
#pragma unroll 8
    for (int i = 0; i < 32; ++i) { const int kk = 2 * i + (lane >> 5); float v = W[(size_t)(k0 + kk) * ldw + srcn0 + (lane & 31)]; if (gain) v *= gain[k0 + kk]; scr[kk * 33 + (lane & 31)] = v; }
    asm volatile("s_waitcnt lgkmcnt(0)" ::: "memory");
#pragma unroll
    for (int j = 0; j < 4; ++j) { const int n = (lane >> 3) + 8 * j; const LAS float* s = scr + (8 * c) * 33 + n;
        u32x4 o; o.x = cvt_pk_bf16(s[0 * 33], s[1 * 33]); o.y = cvt_pk_bf16(s[2 * 33], s[3 * 33]); o.z = cvt_pk_bf16(s[4 * 33], s[5 * 33]); o.w = cvt_pk_bf16(s[6 * 33], s[7 * 33]);
        *(u32x4*)(WT + (size_t)(dstn0 + n) * K + k0 + 8 * c) = o; }
    asm volatile("s_waitcnt lgkmcnt(0)" ::: "memory");
}
__device__ __forceinline__ void convert_layer(const Args* ap, int l, LAS float* scr, int gw, int NGW, int lane) {
    const Args& a = *ap;
    unsigned char* wb = a.ws + WS_W;
    constexpr int N_GU = 16 * 176, N_DN = 44 * 32, N_IN = 16 * 88, N_UQ = 12 * 24, N_UK = 4 * 16, N_WO = 16 * 32;
    constexpr int TOT = 2 * N_GU + 2 * N_DN + N_IN + N_UQ + 2 * N_UK + N_WO;
    for (int it = gw; it < TOT; it += NGW) {
        int r = it;
        if (r < 2 * N_GU) { const int f = r / N_GU; r -= f * N_GU; const int kb = r / 176, nb = r % 176; const int sb = ((nb >> 2) & 1) * 88 + 4 * (nb >> 3) + (nb & 3);
            wt_item(a.in[f ? I_F2GU : I_F1GU] + (size_t)l * 1024 * 5632, 5632, 1024, (bf16*)(wb + (f ? W_GU2 : W_GU1)), a.in[f ? I_F2PRE : I_F1PRE] + l * 1024, 64 * kb, 32 * sb, 32 * nb, scr, lane); continue; }
        r -= 2 * N_GU;
        if (r < 2 * N_DN) { const int f = r / N_DN; r -= f * N_DN; const int kb = r / 32, nb = r % 32;
            wt_item(a.in[f ? I_F2DN : I_F1DN] + (size_t)l * 2816 * 1024, 1024, 2816, (bf16*)(wb + (f ? W_DN2 : W_DN1)), nullptr, 64 * kb, 32 * nb, 32 * nb, scr, lane); continue; }
        r -= 2 * N_DN;
        if (r < N_IN) { const int kb = r / 88, nb = r % 88;
            wt_item(a.in[I_WIN] + (size_t)l * 1024 * 2592, 2592, 1024, (bf16*)(wb + W_IN), a.in[I_MPRE] + l * 1024, 64 * kb, nb < 81 ? 32 * nb : -1, 32 * nb, scr, lane); continue; }
        r -= N_IN;
        if (r < N_UQ) { const int kb = r / 24, nb = r % 24;
            wt_item(a.in[I_WUQ] + (size_t)l * 768 * 768, 768, 768, (bf16*)(wb + W_UQ), a.in[I_QN] + l * 768, 64 * kb, 32 * nb, 32 * nb, scr, lane); continue; }
        r -= N_UQ;
        if (r < 2 * N_UK) { const int v = r / N_UK; r -= v * N_UK; const int kb = r / 16, nb = r % 16; const int sb = (nb >> 1) * 4 + 2 * v + (nb & 1);
            wt_item(a.in[I_WUKV] + (size_t)l * 256 * 1024, 1024, 256, (bf16*)(wb + (v ? W_UV : W_UK)), a.in[I_KVN] + l * 256, 64 * kb, 32 * sb, 32 * nb, scr, lane); continue; }
        r -= 2 * N_UK;
        { const int kb = r / 32, nb = r % 32; const int k0 = 64 * kb;
            const float* gain = k0 < 256 ? a.in[I_CON] + l * 256 : (k0 < 512 ? a.in[I_NON] + l * 256 - 256 : a.in[I_MON] + l * 512 - 512);
            wt_item(a.in[I_WO] + (size_t)l * 1024 * 1024, 1024, 1024, (bf16*)(wb + W_O), gain, k0, 32 * nb, 32 * nb, scr, lane); }
    }
}
__device__ __forceinline__ void rowpass(const Args* ap, const float* gpost, float coef, bool init, bool wxn, int gw, int NGW, int lane) {
    const Args& a = *ap;
    float* metah = (float*)(a.ws + WS_METAH); bf16* XY = (bf16*)(a.ws + WS_XY);
    for (int row = gw; row < MP; row += NGW) {
        int s, i, T; row_decode(row, s, i, T);
        unsigned long long* xy8 = (unsigned long long*)(XY + (size_t)row * DM) + lane;
        if (i >= T + 16) { if (wxn) {
#pragma unroll
                for (int j = 0; j < 4; ++j) xy8[64 * j] = 0ull; }
            continue; }
        float* hp = hptr(a.out, metah, s, i, T);
        f32x4 h[4];
        if (init) {
            const float* src = (i < T) ? (s < 16 ? a.in[I_XP] + ((size_t)s * 2048 + i) * DM : a.in[I_XS] + ((size_t)(s - 16) * 4096 + i) * DM) : a.in[I_META] + (size_t)(i - T) * DM;
#pragma unroll
            for (int j = 0; j < 4; ++j) h[j] = ((const f32x4*)src)[lane + 64 * j];
        } else {
            f32x4 y[4]; float ss = 0.f;
#pragma unroll
            for (int j = 0; j < 4; ++j) { const unsigned long long w = xy8[64 * j]; const unsigned lo = (unsigned)w, hi = (unsigned)(w >> 32);
                y[j] = (f32x4){bflo(lo), bfhi(lo), bflo(hi), bfhi(hi)}; ss += (y[j][0] * y[j][0] + y[j][1] * y[j][1]) + (y[j][2] * y[j][2] + y[j][3] * y[j][3]); }
            ss = wave_sum(ss); const float ry = __builtin_amdgcn_rsqf(ss * (1.0f / DM) + RMS_EPS) * coef;
#pragma unroll
            for (int j = 0; j < 4; ++j) { const f32x4 g = ((const f32x4*)gpost)[lane + 64 * j]; const f32x4 hh = ((const f32x4*)hp)[lane + 64 * j]; h[j] = hh + y[j] * g * ry; }
        }
#pragma unroll
        for (int j = 0; j < 4; ++j) ((f32x4*)hp)[lane + 64 * j] = h[j];
        if (wxn) {
            float s2 = 0.f;
#pragma unroll
            for (int j = 0; j < 4; ++j) s2 += (h[j][0] * h[j][0] + h[j][1] * h[j][1]) + (h[j][2] * h[j][2] + h[j][3] * h[j][3]);
            s2 = wave_sum(s2); const float rh = __builtin_amdgcn_rsqf(s2 * (1.0f / DM) + RMS_EPS);
#pragma unroll
            for (int j = 0; j < 4; ++j) { const f32x4 v = h[j] * rh; xy8[64 * j] = (unsigned long long)cvt_pk_bf16(v[0], v[1]) | ((unsigned long long)cvt_pk_bf16(v[2], v[3]) << 32); }
        }
    }
}
__device__ __forceinline__ void rope_table(float* tab, int gt, int NGT) {
    for (int e = gt; e < 4112 * 16; e += NGT) { const int pos = e >> 4, j = e & 15; double f = 1.0; for (int k = 0; k < j; ++k) f *= 0.56234132519034907;
        double rev = (double)pos * f * 0.15915494309189535; rev -= __builtin_floor(rev); const float rv = (float)rev;
        tab[2 * e] = __builtin_amdgcn_cosf(rv); tab[2 * e + 1] = __builtin_amdgcn_sinf(rv); }
}
struct Grp { int row0, rows, T, Lp, nseq; };
__device__ __forceinline__ Grp grp_of(int g) { Grp r; if (g == 0) { r.row0 = 0; r.rows = G0_ROWS; r.T = 2048; r.Lp = 2112; r.nseq = 16; } else { r.row0 = G0_ROWS; r.rows = G1_ROWS; r.T = 4096; r.Lp = 4160; r.nseq = 8; } return r; }
__device__ __forceinline__ void conv_kpe_pass(const Args* ap, int l, const Grp& G, int gw, int NGW, int lane) {
    const Args& a = *ap;
    const bf16* Z = (const bf16*)(a.ws + WS_BIG + B_Z); bf16* KB = (bf16*)(a.ws + WS_BIG + B_K); bf16* YC = (bf16*)(a.ws + WS_BIG + B_YC);
    const float* cw = a.in[I_CONVW] + (size_t)l * 3 * 256; const float* rope = (const float*)(a.ws + WS_ROPE);
    const f32x4 w0 = ((const f32x4*)cw)[lane], w1 = ((const f32x4*)(cw + 256))[lane], w2 = ((const f32x4*)(cw + 512))[lane];
    for (int gr = gw; gr < G.rows; gr += NGW) {
        const int sq = gr / G.Lp, i = gr - sq * G.Lp, T = G.T;
        unsigned long long* yo = (unsigned long long*)(YC + (size_t)gr * DM) + lane;
        if (i >= T + 16) { *yo = 0ull; if (lane < 16) {
#pragma unroll
                for (int h = 0; h < 8; ++h) { KB[(size_t)gr * 768 + 96 * h + 64 + lane] = 0; KB[(size_t)gr * 768 + 96 * h + 80 + lane] = 0; } }
            continue; }
        const int p = (i < T) ? 16 + i : i - T;
        const int il = (p == 0) ? -1 : ((p - 1 >= 16) ? p - 17 : T + p - 1), ir = (p == T + 15) ? -1 : ((p + 1 >= 16) ? p - 15 : T + p + 1);
        const bf16* zr = Z + (size_t)gr * ZP;
        const unsigned long long cb = *((const unsigned long long*)zr + lane);
        f32x4 pc, pl = {0.f, 0.f, 0.f, 0.f}, pr = {0.f, 0.f, 0.f, 0.f};
        { const unsigned long long c = *((const unsigned long long*)(zr + 256) + lane), u = *((const unsigned long long*)(zr + 512) + lane);
          pc = (f32x4){bflo((unsigned)c) * bflo((unsigned)u), bfhi((unsigned)c) * bfhi((unsigned)u), bflo((unsigned)(c >> 32)) * bflo((unsigned)(u >> 32)), bfhi((unsigned)(c >> 32)) * bfhi((unsigned)(u >> 32))}; }
        if (il >= 0) { const bf16* z2 = Z + (size_t)(sq * G.Lp + il) * ZP; const unsigned long long c = *((const unsigned long long*)(z2 + 256) + lane), u = *((const unsigned long long*)(z2 + 512) + lane);
          pl = (f32x4){bflo((unsigned)c) * bflo((unsigned)u), bfhi((unsigned)c) * bfhi((unsigned)u), bflo((unsigned)(c >> 32)) * bflo((unsigned)(u >> 32)), bfhi((unsigned)(c >> 32)) * bfhi((unsigned)(u >> 32))}; }
        if (ir >= 0) { const bf16* z2 = Z + (size_t)(sq * G.Lp + ir) * ZP; const unsigned long long c = *((const unsigned long long*)(z2 + 256) + lane), u = *((const unsigned long long*)(z2 + 512) + lane);
          pr = (f32x4){bflo((unsigned)c) * bflo((unsigned)u), bfhi((unsigned)c) * bfhi((unsigned)u), bflo((unsigned)(c >> 32)) * bflo((unsigned)(u >> 32)), bfhi((unsigned)(c >> 32)) * bfhi((unsigned)(u >> 32))}; }
        const f32x4 cbv = (f32x4){bflo((unsigned)cb), bfhi((unsigned)cb), bflo((unsigned)(cb >> 32)), bfhi((unsigned)(cb >> 32))};
        const f32x4 y = cbv * (w0 * pl + w1 * pc + w2 * pr);
        float ss = (y[0] * y[0] + y[1] * y[1]) + (y[2] * y[2] + y[3] * y[3]); ss = wave_sum(ss);
        const float rn = __builtin_amdgcn_rsqf(ss * (1.0f / 256.0f) + RMS_EPS); const f32x4 o = y * rn;
        *yo = (unsigned long long)cvt_pk_bf16(o[0], o[1]) | ((unsigned long long)cvt_pk_bf16(o[2], o[3]) << 32);
        if (lane < 16) { const float x1 = bf2f(zr[2560 + lane]), x2 = bf2f(zr[2576 + lane]); const float c = rope[(size_t)p * 32 + 2 * lane], s = rope[(size_t)p * 32 + 2 * lane + 1];
            const unsigned pk = cvt_pk_bf16(x1 * c - x2 * s, x1 * s + x2 * c); const bf16 o1 = (bf16)(pk & 0xffffu), o2 = (bf16)(pk >> 16);
#pragma unroll
            for (int h = 0; h < 8; ++h) { KB[(size_t)gr * 768 + 96 * h + 64 + lane] = o1; KB[(size_t)gr * 768 + 96 * h + 80 + lane] = o2; } }
    }
}
__device__ __forceinline__ void ynorm_pass(const Args* ap, const Grp& G, int gw, int NGW, int lane) {
    const Args& a = *ap;
    bf16* YC = (bf16*)(a.ws + WS_BIG + B_YC);
    for (int gr = gw; gr < G.rows; gr += NGW) {
        const int sq = gr / G.Lp, i = gr - sq * G.Lp;
        unsigned long long* p1 = (unsigned long long*)(YC + (size_t)gr * DM + 256) + lane; u32x4* p2 = (u32x4*)(YC + (size_t)gr * DM + 512) + lane;
        if (i >= G.T + 16) { *p1 = 0ull; *p2 = (u32x4){0u, 0u, 0u, 0u}; continue; }
        const unsigned long long w = *p1; const u32x4 v = *p2;
        float y[4] = {bflo((unsigned)w), bfhi((unsigned)w), bflo((unsigned)(w >> 32)), bfhi((unsigned)(w >> 32))};
        float z[8] = {bflo(v.x), bfhi(v.x), bflo(v.y), bfhi(v.y), bflo(v.z), bfhi(v.z), bflo(v.w), bfhi(v.w)};
        float s1 = (y[0] * y[0] + y[1] * y[1]) + (y[2] * y[2] + y[3] * y[3]); float s2 = 0.f;
#pragma unroll
        for (int e = 0; e < 8; ++e) s2 += z[e] * z[e];
        s1 = wave_sum(s1); s2 = wave_sum(s2);
        const float r1 = __builtin_amdgcn_rsqf(s1 * (1.0f / 256.0f) + RMS_EPS), r2 = __builtin_amdgcn_rsqf(s2 * (1.0f / 512.0f) + RMS_EPS);
        *p1 = (unsigned long long)cvt_pk_bf16(y[0] * r1, y[1] * r1) | ((unsigned long long)cvt_pk_bf16(y[2] * r1, y[3] * r1) << 32);
        u32x4 o; o.x = cvt_pk_bf16(z[0] * r2, z[1] * r2); o.y = cvt_pk_bf16(z[2] * r2, z[3] * r2); o.z = cvt_pk_bf16(z[4] * r2, z[5] * r2); o.w = cvt_pk_bf16(z[6] * r2, z[7] * r2); *p2 = o;
    }
}
struct AttG { const bf16 *Q, *K, *VT, *Z; bf16* YC; const float* rope; int rows, T, Lp; };
__device__ __forceinline__ int crow(int r, int hi) { return (r & 3) + 8 * (r >> 2) + 4 * hi; }
#define MFMA32(a, b, c) __builtin_amdgcn_mfma_f32_32x32x16_bf16((a), (b), (c), 0, 0, 0)
template <int MODE>
__device__ __forceinline__ void attn_unit(const AttG& P, int seq, int head, int qb, LAS unsigned char* lds, int tid, int wid, int lane) {
    constexpr int DQK = MODE == 0 ? 96 : 64, NDK = DQK / 16, KP = DQK * 2 + 16, VP = 144;
    const int r32 = lane & 31, hi = lane >> 5;
    const int T = P.T, Lp = P.Lp, nqbr = T >> 8; const bool metablk = (qb == nqbr);
    const int sbase = seq * Lp;
    const int qi = qb * 256 + wid * 32 + r32; const int qic = qi < Lp - 1 ? qi : Lp - 1;
    bf16x8 qr[NDK];
    { const bf16* qsrc = MODE == 0 ? P.Q + (size_t)(sbase + qic) * 768 + 96 * head : P.Z + (size_t)(sbase + qic) * ZP + 768 + 64 * head;
#pragma unroll
      for (int d0 = 0; d0 < NDK; ++d0) qr[d0] = *(const bf16x8*)(qsrc + 16 * d0 + 8 * hi); }
    if constexpr (MODE == 0) {
        const int pos = qic < T ? 16 + qic : (qic - T < 15 ? qic - T : 15);
        const f32x4* rp = (const f32x4*)(P.rope + (size_t)pos * 32 + 16 * hi);
#pragma unroll
        for (int e2 = 0; e2 < 4; ++e2) { const f32x4 cs = rp[e2];
#pragma unroll
            for (int q = 0; q < 2; ++q) { const int e = 2 * e2 + q; const float c = cs[2 * q], s = cs[2 * q + 1];
                const float x1 = bf2f((unsigned short)qr[4][e]), x2 = bf2f((unsigned short)qr[5][e]);
                const unsigned pk = cvt_pk_bf16(x1 * c - x2 * s, x1 * s + x2 * c); qr[4][e] = (short)(pk & 0xffffu); qr[5][e] = (short)(pk >> 16); } }
    }
    int nt, kr_lo = 0; const int rows_total = T >> 6;
    int na_r = 0, na_c = 0, na_rs = 0, na_cs = 0;
    if constexpr (MODE == 0) nt = rows_total + 1;
    else {
        if (metablk) nt = 1;
        else { const int r0 = 4 * qb; int lo = r0 - 4; lo = lo < 0 ? 0 : (lo > rows_total - 8 ? rows_total - 8 : lo); int h2 = r0 - 1; h2 = h2 < 0 ? 0 : (h2 > rows_total - 8 ? rows_total - 8 : h2);
            kr_lo = lo; nt = (h2 + 7 - lo + 1) + 1; }
        na_r = 4 * qb + (wid >> 1); na_c = 32 * (wid & 1) + r32;
        na_rs = na_r - 4; na_rs = na_rs < 0 ? 0 : (na_rs > rows_total - 8 ? rows_total - 8 : na_rs);
        na_cs = na_c - 8; na_cs = na_cs < 0 ? 0 : (na_cs > 48 ? 48 : na_cs);
    }
    const LAS float* tabL = (const LAS float*)(lds + A_TAB) + head * 640 + 64;
    const LAS float* mbL = (const LAS float*)(lds + A_TAB + 4 * 640 * 4) + head * 16;
    LAS float* wsf = (LAS float*)(lds + A_WSF) + wid * 64;
    u32x4 kst0, kst1 = {0u, 0u, 0u, 0u}, vst;
    const int kc0 = tid, kc1 = 512 + tid;
#define TILE_KB(t) ((t) == nt - 1 ? T : 64 * (kr_lo + (t)))
#define GLOAD(t) do { const int kb_ = TILE_KB(t); \
      if constexpr (MODE == 0) { { const int krow = kc0 / 12, part = kc0 % 12; kst0 = *(const u32x4*)(P.K + (size_t)(sbase + kb_ + krow) * 768 + 96 * head + 8 * part); } \
          if (tid < 256) { const int krow = kc1 / 12, part = kc1 % 12; kst1 = *(const u32x4*)(P.K + (size_t)(sbase + kb_ + krow) * 768 + 96 * head + 8 * part); } \
          { const int d = tid >> 3, part = tid & 7; vst = *(const u32x4*)(P.VT + (size_t)(64 * head + d) * P.rows + sbase + kb_ + 8 * part); } } \
      else { const int krow = tid >> 3, part = tid & 7; const bf16* zr_ = P.Z + (size_t)(sbase + kb_ + krow) * ZP + 64 * head + 8 * part; kst0 = *(const u32x4*)(zr_ + 1024); vst = *(const u32x4*)(zr_ + 1280); } } while (0)
#define LSTORE(buf) do { LAS unsigned char* Kb_ = lds + A_K + (buf) * A_KBUF; LAS unsigned char* Vb_ = lds + A_V + (buf) * A_VBUF; \
      if constexpr (MODE == 0) { { const int krow = kc0 / 12, part = kc0 % 12; *(LAS u32x4*)(Kb_ + krow * KP + part * 16) = kst0; } \
          if (tid < 256) { const int krow = kc1 / 12, part = kc1 % 12; *(LAS u32x4*)(Kb_ + krow * KP + part * 16) = kst1; } \
          { const int d = tid >> 3, part = tid & 7; *(LAS u32x4*)(Vb_ + d * VP + part * 16) = vst; } } \
      else { const int krow = tid >> 3, part = tid & 7; *(LAS u32x4*)(Kb_ + krow * KP + part * 16) = kst0; \
          LAS unsigned short* vt_ = (LAS unsigned short*)(Vb_ + (8 * part) * VP + krow * 2); \
          vt_[0 * (VP / 2)] = (unsigned short)(vst.x & 0xffffu); vt_[1 * (VP / 2)] = (unsigned short)(vst.x >> 16); vt_[2 * (VP / 2)] = (unsigned short)(vst.y & 0xffffu); vt_[3 * (VP / 2)] = (unsigned short)(vst.y >> 16); \
          vt_[4 * (VP / 2)] = (unsigned short)(vst.z & 0xffffu); vt_[5 * (VP / 2)] = (unsigned short)(vst.z >> 16); vt_[6 * (VP / 2)] = (unsigned short)(vst.w & 0xffffu); vt_[7 * (VP / 2)] = (unsigned short)(vst.w >> 16); } } while (0)
    GLOAD(0); LSTORE(0);
    __syncthreads();
    float m_cur = -1e30f, l_reg = 0.f;
    f32x16 o0, o1;
#pragma unroll
    for (int r = 0; r < 16; ++r) { o0[r] = 0.f; o1[r] = 0.f; }
    for (int t = 0; t < nt; ++t) {
        const int buf = t & 1; const bool more = (t + 1 < nt);
        if (more) GLOAD(t + 1);
        const bool is_meta = (t == nt - 1);
        bool active = true;
        if constexpr (MODE == 1) { if (!is_meta) { const int kr = kr_lo + t; active = (kr >= na_rs && kr <= na_rs + 7); } }
        if (active) {
            const LAS unsigned char* Kb = lds + A_K + buf * A_KBUF; const LAS unsigned char* Vb = lds + A_V + buf * A_VBUF;
            f32x16 p0, p1;
#pragma unroll
            for (int r = 0; r < 16; ++r) { p0[r] = 0.f; p1[r] = 0.f; }
#pragma unroll
            for (int d0 = 0; d0 < NDK; ++d0) {
                const bf16x8 k0 = *(const LAS bf16x8*)(Kb + r32 * KP + d0 * 32 + hi * 16);
                const bf16x8 k1 = *(const LAS bf16x8*)(Kb + (32 + r32) * KP + d0 * 32 + hi * 16);
                p0 = MFMA32(k0, qr[d0], p0); p1 = MFMA32(k1, qr[d0], p1);
            }
            if (is_meta) {
#pragma unroll
                for (int r = 0; r < 16; ++r) { const int kv = crow(r, hi); float b = 0.f; if constexpr (MODE == 1) b = mbL[kv & 15]; p0[r] = kv < 16 ? p0[r] + b : -INFINITY; p1[r] = -INFINITY; }
            } else if constexpr (MODE == 1) {
                const int kr = kr_lo + t; const LAS float* rp = tabL + (kr - na_r + 7) * 31 + (15 - na_c);
#pragma unroll
                for (int r = 0; r < 16; ++r) { const int kc = crow(r, hi);
                    p0[r] = (kc >= na_cs && kc < na_cs + 16) ? p0[r] + rp[kc] : -INFINITY;
                    p1[r] = (kc + 32 >= na_cs && kc + 32 < na_cs + 16) ? p1[r] + rp[kc + 32] : -INFINITY; }
            }
            float mx = fmaxf(p0[0], p1[0]);
#pragma unroll
            for (int r = 1; r < 16; ++r) mx = fmaxf(mx, fmaxf(p0[r], p1[r]));
            mx = fmaxf(mx, __shfl_xor(mx, 32));
            if (__any(mx > m_cur)) {
                const float m_new = fmaxf(m_cur, mx); const float alpha = __builtin_amdgcn_exp2f(m_cur - m_new); m_cur = m_new; l_reg *= alpha;
                if (hi == 0) wsf[r32] = alpha;
                asm volatile("s_waitcnt lgkmcnt(0)" ::: "memory");
#pragma unroll
                for (int j = 0; j < 4; ++j) { const f32x4 av = *(const LAS f32x4*)(wsf + 8 * j + 4 * hi);
#pragma unroll
                    for (int e = 0; e < 4; ++e) { o0[4 * j + e] *= av[e]; o1[4 * j + e] *= av[e]; } }
                asm volatile("s_waitcnt lgkmcnt(0)" ::: "memory");
            }
            float ls = 0.f;
#pragma unroll
            for (int r = 0; r < 16; ++r) { p0[r] = __builtin_amdgcn_exp2f(p0[r] - m_cur); p1[r] = __builtin_amdgcn_exp2f(p1[r] - m_cur); ls += p0[r] + p1[r]; }
            l_reg += ls;
            bf16x8 pa[4];
#pragma unroll
            for (int ks = 0; ks < 4; ++ks) { u32x4 w;
                if (ks < 2) { w.x = cvt_pk_bf16(p0[8 * ks + 0], p0[8 * ks + 1]); w.y = cvt_pk_bf16(p0[8 * ks + 2], p0[8 * ks + 3]); w.z = cvt_pk_bf16(p0[8 * ks + 4], p0[8 * ks + 5]); w.w = cvt_pk_bf16(p0[8 * ks + 6], p0[8 * ks + 7]); }
                else { const int b = 8 * (ks - 2); w.x = cvt_pk_bf16(p1[b + 0], p1[b + 1]); w.y = cvt_pk_bf16(p1[b + 2], p1[b + 3]); w.z = cvt_pk_bf16(p1[b + 4], p1[b + 5]); w.w = cvt_pk_bf16(p1[b + 6], p1[b + 7]); }
                pa[ks] = __builtin_bit_cast(bf16x8, w); }
#pragma unroll
            for (int ks = 0; ks < 4; ++ks) {
                const LAS unsigned char* vp0 = Vb + r32 * VP + (16 * ks + 4 * hi) * 2; const LAS unsigned char* vp1 = vp0 + 32 * VP;
                const s16x4 a0 = *(const LAS s16x4*)vp0, a1 = *(const LAS s16x4*)(vp0 + 16), b0 = *(const LAS s16x4*)vp1, b1 = *(const LAS s16x4*)(vp1 + 16);
                const bf16x8 v0 = (bf16x8){a0[0], a0[1], a0[2], a0[3], a1[0], a1[1], a1[2], a1[3]}, v1 = (bf16x8){b0[0], b0[1], b0[2], b0[3], b1[0], b1[1], b1[2], b1[3]};
                o0 = MFMA32(pa[ks], v0, o0); o1 = MFMA32(pa[ks], v1, o1);
            }
        }
        if (more) LSTORE(buf ^ 1);
        __syncthreads();
    }
#undef GLOAD
#undef LSTORE
#undef TILE_KB
    l_reg += __shfl_xor(l_reg, 32);
    if (hi == 0) wsf[32 + r32] = l_reg;
    asm volatile("s_waitcnt lgkmcnt(0)" ::: "memory");
    LAS unsigned short* stg = (LAS unsigned short*)(lds + A_STG) + wid * 2048;
#pragma unroll
    for (int j = 0; j < 4; ++j) { const f32x4 lv = *(const LAS f32x4*)(wsf + 32 + 8 * j + 4 * hi);
#pragma unroll
        for (int e = 0; e < 4; ++e) { const int r = 4 * j + e; const float rl = __builtin_amdgcn_rcpf(lv[e]); const int orow = crow(r, hi);
            const unsigned pk = cvt_pk_bf16(o0[r] * rl, o1[r] * rl); stg[orow * 64 + r32] = (unsigned short)(pk & 0xffffu); stg[orow * 64 + 32 + r32] = (unsigned short)(pk >> 16); } }
    asm volatile("s_waitcnt lgkmcnt(0)" ::: "memory");
    { const int coloff = (MODE == 0 ? 512 : 256) + 64 * head;
#pragma unroll
      for (int i = 0; i < 4; ++i) { const int row = i * 8 + (lane >> 3), ch = lane & 7; const u32x4 v = *(const LAS u32x4*)(stg + row * 64 + ch * 8);
          const int qrow = qb * 256 + wid * 32 + row; const bool valid = metablk ? (wid == 0 && row < 16) : true;
          if (valid) *(u32x4*)(P.YC + (size_t)(sbase + qrow) * DM + coloff + ch * 8) = v; } }
    asm volatile("s_waitcnt lgkmcnt(0)" ::: "memory");
}
__device__ __forceinline__ void attn_phase(const Args* ap, int l, const Grp& G, unsigned* ctr, LAS unsigned char* lds, int tid, int wid, int lane) {
    const Args& a = *ap;
    AttG P; P.Q = (const bf16*)(a.ws + WS_XY) + (size_t)G.row0 * DM; P.K = (const bf16*)(a.ws + WS_BIG + B_K); P.VT = (const bf16*)(a.ws + WS_BIG + B_VT); P.Z = (const bf16*)(a.ws + WS_BIG + B_Z);
    P.YC = (bf16*)(a.ws + WS_BIG + B_YC); P.rope = (const float*)(a.ws + WS_ROPE); P.rows = G.rows; P.T = G.T; P.Lp = G.Lp;
    { LAS float* tab = (LAS float*)(lds + A_TAB); const float* rpb = a.in[I_RPB] + (size_t)l * 4 * 465; const float* mb = a.in[I_MB] + (size_t)l * 64;
      for (int e = tid; e < 4 * 640; e += NTHR) { const int h = e / 640, j = e - h * 640 - 64; tab[e] = (j >= 0 && j < 465) ? rpb[h * 465 + j] * LOG2E : 0.f; }
      if (tid < 64) tab[4 * 640 + tid] = mb[tid] * LOG2E; }
    const int nqb = (G.T >> 8) + 1; const int nMLA = G.nseq * 8 * nqb, nNA = G.nseq * 4 * nqb, total = nMLA + nNA;
    LAS volatile unsigned* uw = (LAS volatile unsigned*)(lds + A_UW);
    for (;;) {
        __syncthreads();
        if (tid == 0) *uw = atomicAdd(ctr, 1u);
        __syncthreads();
        const int u = (int)*uw;
        if (u >= total) break;
        if (u < nMLA) { const int qb = u % nqb, r = u / nqb; attn_unit<0>(P, r >> 3, r & 7, qb, lds, tid, wid, lane); }
        else { const int v = u - nMLA; const int qb = v % nqb, r = v / nqb; attn_unit<1>(P, r >> 2, r & 3, qb, lds, tid, wid, lane); }
    }
}
#define GEMM_CALL(EpiT, gobj, sobj, eobj) pg8::gemm_phase<EpiT, pg8::StaticOrder, true, true>(L, gobj, sobj, eobj)
#define KA() ({ const Args* p_ = (const Args*)__builtin_amdgcn_kernarg_segment_ptr(); asm volatile("" : "+s"(p_)); p_; })
__global__ void __launch_bounds__(NTHR, 2) mk_fwd(Args a_unused) {
    extern __shared__ __attribute__((aligned(16))) unsigned char lds_raw[];
    cg::grid_group grid = cg::this_grid();
    LAS unsigned char* L = (LAS unsigned char*)lds_raw;
#define TID ({ int t_ = (int)threadIdx.x; asm volatile("" : "+v"(t_)); t_; })
#define LANE (TID & 63)
#define WID (__builtin_amdgcn_readfirstlane(TID >> 6))
#define NG ((int)gridDim.x)
#define BX ((int)blockIdx.x)
#define GW (BX * NWAVES + WID)
#define NGW (NG * NWAVES)
#define SCR ((LAS float*)(L + WID * 8448))
    { const Args* A = KA(); rope_table((float*)(A->ws + WS_ROPE), BX * NTHR + TID, NG * NTHR); }
    { const Args* A = KA(); convert_layer(A, 0, SCR, GW, NGW, LANE); }
    { const Args* A = KA(); rowpass(A, nullptr, 0.f, true, true, GW, NGW, LANE); }
    grid.sync();
    for (int st = 0; st < 3 * DEPTH; ++st) {
        const int l = st / 3, k = st - 3 * l;
        if (k != 1) {
            const int f = k >> 1;
            { const Args* A = KA(); unsigned char* ws = A->ws; pg8::Gemm g{(const bf16*)(ws + WS_XY), (const bf16*)(ws + WS_W + (f ? W_GU2 : W_GU1)), MP, 2 * FF, DM, DM, DM}; pg8::StaticOrder S; S.init(MP, 2 * FF, NG, BX);
              pg8::EpiSwiGLU E{(bf16*)(ws + WS_BIG), FF}; GEMM_CALL(pg8::EpiSwiGLU, g, S, E); }
            grid.sync();
            { const Args* A = KA(); unsigned char* ws = A->ws; pg8::Gemm g{(const bf16*)(ws + WS_BIG), (const bf16*)(ws + WS_W + (f ? W_DN2 : W_DN1)), MP, DM, FF, FF, FF}; pg8::StaticOrder S; S.init(MP, DM, NG, BX);
              pg8::EpiPlain E{(bf16*)(ws + WS_XY), DM}; GEMM_CALL(pg8::EpiPlain, g, S, E); }
            grid.sync();
            const bool last = (l == DEPTH - 1 && f == 1);
            { const Args* A = KA(); rowpass(A, A->in[f ? I_F2POST : I_F1POST] + l * DM, 0.5f, false, !last, GW, NGW, LANE); }
            if (f == 1 && !last) { const Args* A = KA(); convert_layer(A, l + 1, SCR, GW, NGW, LANE); }
            if (!last) grid.sync();
        } else {
            for (int gi = 0; gi < 2; ++gi) {
                { const Args* A = KA(); unsigned char* ws = A->ws; const Grp G = grp_of(gi);
                  pg8::Gemm g{(const bf16*)(ws + WS_XY) + (size_t)G.row0 * DM, (const bf16*)(ws + WS_W + W_IN), G.rows, NINP, DM, DM, DM}; pg8::StaticOrder S; S.init(G.rows, NINP, NG, BX);
                  pg8::EpiInProj E{(bf16*)(ws + WS_BIG + B_Z), (float*)(ws + WS_SSP) + (size_t)G.row0 * 32}; GEMM_CALL(pg8::EpiInProj, g, S, E); }
                grid.sync();
                { const Args* A = KA(); unsigned char* ws = A->ws; const Grp G = grp_of(gi);
                  pg8::Gemm g{(const bf16*)(ws + WS_BIG + B_Z) + 1536, (const bf16*)(ws + WS_W + W_UQ), G.rows, 768, 768, ZP, 768}; pg8::StaticOrder S; S.init(G.rows, 768, NG, BX);
                  pg8::EpiRowScale E{(bf16*)(ws + WS_XY) + (size_t)G.row0 * DM, 768, (const float*)(ws + WS_SSP) + (size_t)G.row0 * 32, 0, 6, 1.0f / 768.0f, 0.10206207261596575f * LOG2E, 0, (LAS float*)(L + 132096)}; GEMM_CALL(pg8::EpiRowScale, g, S, E); }
                { const Args* A = KA(); unsigned char* ws = A->ws; const Grp G = grp_of(gi);
                  pg8::Gemm g{(const bf16*)(ws + WS_BIG + B_Z) + 2304, (const bf16*)(ws + WS_W + W_UK), G.rows, 512, 256, ZP, 256}; pg8::StaticOrder S; S.init(G.rows, 512, NG, BX, NG - 140 % NG);
                  pg8::EpiRowScale E{(bf16*)(ws + WS_BIG + B_K), 768, (const float*)(ws + WS_SSP) + (size_t)G.row0 * 32, 24, 2, 1.0f / 256.0f, 1.0f, 1, (LAS float*)(L + 132096)}; GEMM_CALL(pg8::EpiRowScale, g, S, E); }
                { const Args* A = KA(); unsigned char* ws = A->ws; const Grp G = grp_of(gi);
                  pg8::Gemm g{(const bf16*)(ws + WS_W + W_UV), (const bf16*)(ws + WS_BIG + B_Z) + 2304, 512, G.rows, 256, 256, ZP}; pg8::StaticOrder S; S.init(512, G.rows, NG, BX, NG - 148 % NG);
                  pg8::EpiColScale E{(bf16*)(ws + WS_BIG + B_VT), G.rows, (const float*)(ws + WS_SSP) + (size_t)G.row0 * 32, (LAS float*)(L + 132096)}; GEMM_CALL(pg8::EpiColScale, g, S, E); }
                { const Args* A = KA(); const Grp G = grp_of(gi); conv_kpe_pass(A, l, G, GW, NGW, LANE); }
                grid.sync();
                { const Args* A = KA(); const Grp G = grp_of(gi); attn_phase(A, l, G, (unsigned*)(A->ws + WS_CTL) + 64 * (l * 2 + gi), L, TID, WID, LANE); }
                grid.sync();
                { const Args* A = KA(); const Grp G = grp_of(gi); ynorm_pass(A, G, GW, NGW, LANE); }
                grid.sync();
                { const Args* A = KA(); unsigned char* ws = A->ws; const Grp G = grp_of(gi);
                  pg8::Gemm g{(const bf16*)(ws + WS_BIG + B_YC), (const bf16*)(ws + WS_W + W_O), G.rows, DM, DM, DM, DM}; pg8::StaticOrder S; S.init(G.rows, DM, NG, BX);
                  pg8::EpiPlain E{(bf16*)(ws + WS_XY) + (size_t)G.row0 * DM, DM}; GEMM_CALL(pg8::EpiPlain, g, S, E); }
                grid.sync();
            }
            { const Args* A = KA(); rowpass(A, A->in[I_MPOST] + l * DM, 1.0f, false, true, GW, NGW, LANE); }
            grid.sync();
        }
    }
}

extern "C" void kernel_launch(void* const* d_in, const int* in_sizes, int n_in, void* d_out, int out_size, void* d_ws, size_t ws_size, hipStream_t stream) {
    static int grid = 0;
    if (grid == 0) {
        if (n_in != 25 || ws_size < WS_END) { fprintf(stderr, "kernel_launch: need 25 inputs and %zu B of workspace (got %d, %zu)\n", (size_t)WS_END, n_in, ws_size); grid = -1; return; }
        int dev = 0, cus = 0, per_cu = 0;
        if (hipGetDevice(&dev) != hipSuccess || hipDeviceGetAttribute(&cus, hipDeviceAttributeMultiprocessorCount, dev) != hipSuccess) { grid = -1; return; }
        if (hipFuncSetAttribute((const void*)mk_fwd, hipFuncAttributeMaxDynamicSharedMemorySize, LDS_BYTES) != hipSuccess) { fprintf(stderr, "kernel_launch: hipFuncSetAttribute failed\n"); grid = -1; return; }
        if (hipOccupancyMaxActiveBlocksPerMultiprocessor(&per_cu, (const void*)mk_fwd, NTHR, LDS_BYTES) != hipSuccess || per_cu < 1) { fprintf(stderr, "kernel_launch: occupancy query says %d\n", per_cu); }
        (void)hipGetLastError();
        grid = cus;
    }
    if (grid < 0) return;
    if (hipMemsetAsync((char*)d_ws + WS_CTL, 0, 4096, stream) != hipSuccess) return;
    Args a{};
    for (int i = 0; i < 25; ++i) a.in[i] = (const float*)d_in[i];
    a.out = (float*)d_out; a.ws = (unsigned char*)d_ws;
    void* args[] = {&a};
    hipError_t e = hipLaunchCooperativeKernel((const void*)mk_fwd, dim3(grid), dim3(NTHR), args, LDS_BYTES, stream);
    if (e != hipSuccess) fprintf(stderr, "kernel_launch: cooperative launch failed: %s\n", hipGetErrorString(e));
}
```

```cpp
#include <hip/hip_runtime.h>
#include <hip/hip_cooperative_groups.h>
#include <cstdio>
#include <cstdint>
namespace cg = cooperative_groups;
namespace pg8 {
#define PG8_LAS __attribute__((address_space(3)))
typedef unsigned short bf16_t;
typedef short bf16x8 __attribute__((ext_vector_type(8)));
typedef float f32x4 __attribute__((ext_vector_type(4)));
typedef unsigned u32x4 __attribute__((ext_vector_type(4)));
constexpr int BM = 256, BK = 64, HALF = 128, HTB = HALF * BK * 2  , STAGE_BYTES = 8 * HTB, NXCD = 8, WGM = 8;

__host__ __device__ __forceinline__ int lds_byte(int r, int c) { const int st = (r >> 4) * 2 + (c >> 5), rr = r & 15, cc = c & 31, ob = rr * 64 + cc * 2; return st * 1024 + (ob ^ (((ob >> 9) & 1) << 5)); }
__host__ __device__ __forceinline__ void stage_rc(int b, int& R, int& C) { const int st = b / 1024, sb = b % 1024, swz = sb ^ (((sb >> 9) & 1) << 5); R = (st >> 1) * 16 + swz / 64; C = (st & 1) * 32 + (swz % 64) / 2; }
__host__ __device__ __forceinline__ int perm32(int rho) { const int n = rho >> 4, i = rho & 15; return 8 * (i >> 2) + 4 * n + (i & 3); }

struct Unit { int pm, pn; };
struct Gemm { const bf16_t* A; const bf16_t* Bt; int M, N, K, lda, ldb; };

struct StaticOrder {
    int nM, nN, nwg, G, c;
    __host__ __device__ void init(int M, int N, int G_, int c_, int shift = 0) { nM = M / BM; nN = N / BM; nwg = nM * nN; G = G_; c = (c_ + shift) % G_; }
    __host__ __device__ bool next(int i, Unit& u) const {
        const long L = (long)i * G + c; if (L >= nwg) return false;
        int wgid = (int)L; { const int q = nwg / NXCD, r = nwg % NXCD, xcd = wgid % NXCD, off = wgid / NXCD; wgid = (xcd < r ? xcd * (q + 1) : r * (q + 1) + (xcd - r) * q) + off; }
        const int nig = WGM * nN, gid = wgid / nig, fm = gid * WGM, gsz = (nM - fm) < WGM ? (nM - fm) : WGM;
        u.pm = fm + ((wgid % nig) % gsz); u.pn = (wgid % nig) / gsz; return true;
    }
    __device__ __forceinline__ void a_ready(const Unit&) const {}
    __device__ __forceinline__ void done(const Unit&) const {}
};

__device__ __forceinline__ unsigned cvt_pk_bf16(float lo, float hi) { typedef float f2 __attribute__((ext_vector_type(2))); typedef __bf16 b2 __attribute__((ext_vector_type(2))); f2 v = {lo, hi}; b2 b = __builtin_convertvector(v, b2); return __builtin_bit_cast(unsigned, b); }
constexpr float LOG2E = 1.4426950408889634f;
constexpr float RMS_EPS = 1e-6f;
#define EPI_STORE8(ptr, v0, v1) do { u32x4 w_; w_.x = cvt_pk_bf16((v0)[0], (v0)[1]); w_.y = cvt_pk_bf16((v0)[2], (v0)[3]); w_.z = cvt_pk_bf16((v1)[0], (v1)[1]); w_.w = cvt_pk_bf16((v1)[2], (v1)[3]); *(u32x4*)(ptr) = w_; } while (0)
struct EpiPlain {
    static constexpr bool PERM = true, AFTER_DRAIN = false;
    bf16_t* O; int ldc;
    __device__ __forceinline__ void operator()(const f32x4 (&acc)[2][2][4][2], const Unit& u, int wr, int wc, int fr, int fq) const {
        const int row0 = u.pm * BM + wr * 64 + fr, col0 = u.pn * BM + wc * 32 + 8 * fq;
#pragma unroll
        for (int ai = 0; ai < 2; ++ai)
#pragma unroll
            for (int m = 0; m < 4; ++m) { bf16_t* rowp = O + (size_t)(row0 + ai * HALF + m * 16) * ldc + col0;
#pragma unroll
                for (int bj = 0; bj < 2; ++bj) EPI_STORE8(rowp + bj * HALF, acc[ai][bj][m][0], acc[ai][bj][m][1]); }
    }
};
__device__ __forceinline__ float silu_mul(float g, float u) { return g * u * __builtin_amdgcn_rcpf(1.0f + __builtin_amdgcn_exp2f(-g * LOG2E)); }
struct EpiSwiGLU {
    static constexpr bool PERM = true, AFTER_DRAIN = false;
    bf16_t* O; int ldc;
    __device__ __forceinline__ void operator()(const f32x4 (&acc)[2][2][4][2], const Unit& u, int wr, int wc, int fr, int fq) const {
        const int row0 = u.pm * BM + wr * 64 + fr, col0 = u.pn * HALF + wc * 32 + 8 * fq;
#pragma unroll
        for (int ai = 0; ai < 2; ++ai)
#pragma unroll
            for (int m = 0; m < 4; ++m) { bf16_t* rowp = O + (size_t)(row0 + ai * HALF + m * 16) * ldc + col0;
                f32x4 v0, v1;
#pragma unroll
                for (int e = 0; e < 4; ++e) { v0[e] = silu_mul(acc[ai][0][m][0][e], acc[ai][1][m][0][e]); v1[e] = silu_mul(acc[ai][0][m][1][e], acc[ai][1][m][1][e]); }
                EPI_STORE8(rowp, v0, v1); }
    }
};
struct EpiInProj {
    static constexpr bool PERM = true, AFTER_DRAIN = false;
    bf16_t* Z; float* SSP;
    __device__ __forceinline__ void operator()(const f32x4 (&acc)[2][2][4][2], const Unit& u, int wr, int wc, int fr, int fq) const {
        const int row0 = u.pm * BM + wr * 64 + fr;
#pragma unroll
        for (int bj = 0; bj < 2; ++bj) {
            const int G = 8 * u.pn + 4 * bj + wc, col0 = 32 * G;
            if (col0 >= 2592) continue;
            const float sc = (col0 >= 768 && col0 < 1024) ? 0.125f * LOG2E : 1.0f;
            const bool doss = (G >= 48 && G < 80); const int slot = G - 48;
#pragma unroll
            for (int ai = 0; ai < 2; ++ai)
#pragma unroll
                for (int m = 0; m < 4; ++m) { const int row = row0 + ai * HALF + m * 16;
                    const f32x4 v0 = acc[ai][bj][m][0] * sc, v1 = acc[ai][bj][m][1] * sc;
                    if (doss) { float s = (v0[0] * v0[0] + v0[1] * v0[1]) + (v0[2] * v0[2] + v0[3] * v0[3]) + (v1[0] * v1[0] + v1[1] * v1[1]) + (v1[2] * v1[2] + v1[3] * v1[3]);
                        s += __shfl_xor(s, 16); s += __shfl_xor(s, 32); if (fq == 0) SSP[(size_t)row * 32 + slot] = s; }
                    EPI_STORE8(Z + (size_t)row * 2592 + col0 + 8 * fq, v0, v1); }
        }
    }
};
struct EpiRowScale {
    static constexpr bool PERM = true, AFTER_DRAIN = false;
    bf16_t* O; int ldo; const float* SSP; int slot0, nslot4; float invn, extra; int kmap; PG8_LAS float* tab;
    __device__ __forceinline__ void operator()(const f32x4 (&acc)[2][2][4][2], const Unit& u, int wr, int wc, int fr, int fq) const {
        const int row0 = u.pm * BM + wr * 64 + fr;
        __builtin_amdgcn_s_barrier();
        { const int t = threadIdx.x; if (t < 256) { const f32x4* sp = (const f32x4*)(SSP + (size_t)(u.pm * BM + t) * 32 + slot0); float s = 0.f;
            for (int k = 0; k < nslot4; ++k) { const f32x4 v = sp[k]; s += (v[0] + v[1]) + (v[2] + v[3]); }
            tab[t] = __builtin_amdgcn_rsqf(s * invn + RMS_EPS) * extra; } }
        asm volatile("s_waitcnt lgkmcnt(0)" ::: "memory"); __builtin_amdgcn_s_barrier(); asm volatile("" ::: "memory");
#pragma unroll
        for (int ai = 0; ai < 2; ++ai)
#pragma unroll
            for (int m = 0; m < 4; ++m) { const float rs = tab[ai * HALF + wr * 64 + m * 16 + fr];
#pragma unroll
                for (int bj = 0; bj < 2; ++bj) { const int c0 = u.pn * BM + bj * HALF + wc * 32; const int dc = (kmap ? 96 * (c0 >> 6) + (c0 & 63) : c0) + 8 * fq;
                    const f32x4 v0 = acc[ai][bj][m][0] * rs, v1 = acc[ai][bj][m][1] * rs;
                    EPI_STORE8(O + (size_t)(row0 + ai * HALF + m * 16) * ldo + dc, v0, v1); } }
    }
};
struct EpiColScale {
    static constexpr bool PERM = true, AFTER_DRAIN = false;
    bf16_t* O; int ldo; const float* SSP; PG8_LAS float* tab;
    __device__ __forceinline__ void operator()(const f32x4 (&acc)[2][2][4][2], const Unit& u, int wr, int wc, int fr, int fq) const {
        const int row0 = u.pm * BM + wr * 64 + fr;
        __builtin_amdgcn_s_barrier();
        { const int t = threadIdx.x; if (t < 256) { const f32x4* sp = (const f32x4*)(SSP + (size_t)(u.pn * BM + t) * 32 + 24); const f32x4 a = sp[0], b = sp[1];
            tab[t] = __builtin_amdgcn_rsqf(((a[0] + a[1]) + (a[2] + a[3]) + (b[0] + b[1]) + (b[2] + b[3])) * (1.0f / 256.0f) + RMS_EPS); } }
        asm volatile("s_waitcnt lgkmcnt(0)" ::: "memory"); __builtin_amdgcn_s_barrier(); asm volatile("" ::: "memory");
#pragma unroll
        for (int bj = 0; bj < 2; ++bj) { const int cl = bj * HALF + wc * 32 + 8 * fq, c0 = u.pn * BM + cl;
            const f32x4 s0 = *(const PG8_LAS f32x4*)(tab + cl), s1 = *(const PG8_LAS f32x4*)(tab + cl + 4);
#pragma unroll
            for (int ai = 0; ai < 2; ++ai)
#pragma unroll
                for (int m = 0; m < 4; ++m) { const f32x4 v0 = acc[ai][bj][m][0] * s0, v1 = acc[ai][bj][m][1] * s1;
                    EPI_STORE8(O + (size_t)(row0 + ai * HALF + m * 16) * ldo + c0, v0, v1); } }
    }
};
template <class Epi, class Sched, bool ALIGN_EPI = false, bool SP2 = false>
__device__ __forceinline__ void gemm_phase(PG8_LAS unsigned char* lds, const Gemm g, const Sched& S, const Epi& E) {
    int tid_l = threadIdx.x; asm volatile("" : "+v"(tid_l)); const int tid = tid_l, wid = __builtin_amdgcn_readfirstlane(tid >> 6), lane = tid & 63, wr = wid >> 2, wc = wid & 3, fr = lane & 15, fq = lane >> 4;
    int K_l = g.K; asm volatile("" : "+s"(K_l)); const int K = K_l, nt = K / BK;
    unsigned voffA[2], voffB[2];
#pragma unroll
    for (int i = 0; i < 2; ++i) { int R, C; stage_rc(tid * 16 + i * 8192, R, C); const int Rb = Epi::PERM ? ((R & ~31) + perm32(R & 31)) : R;
        voffA[i] = (unsigned)(R * g.lda + C) * 2u; voffB[i] = (unsigned)(Rb * g.ldb + C) * 2u; }
    const size_t kstep = (size_t)(BK * 2);
    const size_t hstepA = (size_t)HALF * g.lda * 2, hstepB = (size_t)HALF * g.ldb * 2;
    const size_t tstepA = 2 * hstepA, tstepB = 2 * hstepB;
    const unsigned ldsw = (unsigned)wid * 1024u;
    const int aoff = lds_byte(wr * 64 + fr, fq * 8), boff = lds_byte(wc * 32 + fr, fq * 8);
#define PG8_SA(b, h) (((b) * 2 + (h)) * HTB)
#define PG8_SB(b, h) ((4 + (b) * 2 + (h)) * HTB)
#define PG8_STAGE(bufoff, gbase, voff) do { _Pragma("unroll") for (int _i = 0; _i < 2; ++_i) \
        __builtin_amdgcn_global_load_lds((const unsigned*)((const char*)(gbase) + (voff)[_i]), (PG8_LAS unsigned*)(lds + (bufoff) + ldsw + _i * 8192), 16, 0, 0); } while (0)
#define PG8_LDA(dst, b, h) do { _Pragma("unroll") for (int m = 0; m < 4; ++m) _Pragma("unroll") for (int k = 0; k < 2; ++k) dst[m][k] = *(const PG8_LAS bf16x8*)(lds + PG8_SA(b, h) + aoff + m * 2048 + k * 1024); } while (0)
#define PG8_LDB(dst, b, h) do { _Pragma("unroll") for (int n = 0; n < 2; ++n) _Pragma("unroll") for (int k = 0; k < 2; ++k) dst[n][k] = *(const PG8_LAS bf16x8*)(lds + PG8_SB(b, h) + boff + n * 2048 + k * 1024); } while (0)
#define PG8_MMA(ai, bj, At, Bt) do { __builtin_amdgcn_s_setprio(1); _Pragma("unroll") for (int m = 0; m < 4; ++m) _Pragma("unroll") for (int n = 0; n < 2; ++n) _Pragma("unroll") for (int k = 0; k < 2; ++k) \
        acc[ai][bj][m][n] = __builtin_amdgcn_mfma_f32_16x16x32_bf16(Bt[n][k], At[m][k], acc[ai][bj][m][n], 0, 0, 0); __builtin_amdgcn_s_setprio(0); } while (0)
#define PG8_WAIT_V(n) asm volatile("s_waitcnt vmcnt(" #n ")" ::: "memory")
#define PG8_WAIT_L(n) asm volatile("s_waitcnt lgkmcnt(" #n ")" ::: "memory")
#define PG8_BAR __builtin_amdgcn_s_barrier()
#define PG8_SCHED __builtin_amdgcn_sched_barrier(0)
    Unit cur, nxt; int ui = 0;
    if (!S.next(0, cur)) return;
    f32x4 acc[2][2][4][2];
#pragma unroll
    for (int a = 0; a < 2; ++a)
#pragma unroll
        for (int b = 0; b < 2; ++b)
#pragma unroll
            for (int m = 0; m < 4; ++m)
#pragma unroll
                for (int n = 0; n < 2; ++n) acc[a][b][m][n] = (f32x4){0.f, 0.f, 0.f, 0.f};
    bf16x8 At[4][2], B0[2][2], B1[2][2];
    const char* cA = (const char*)g.A + (size_t)cur.pm * tstepA; const char* cB = (const char*)g.Bt + (size_t)cur.pn * tstepB;
    S.a_ready(cur);
    if constexpr (SP2) {
        PG8_STAGE(PG8_SB(0, 0), cB, voffB); PG8_STAGE(PG8_SB(0, 1), cB + hstepB, voffB); PG8_STAGE(PG8_SA(0, 0), cA, voffA); PG8_STAGE(PG8_SA(0, 1), cA + hstepA, voffA);
        if (wr == 1) PG8_BAR;
        PG8_WAIT_V(2); PG8_BAR;
        PG8_STAGE(PG8_SB(1, 0), cB + kstep, voffB); PG8_STAGE(PG8_SA(1, 0), cA + kstep, voffA); PG8_STAGE(PG8_SB(1, 1), cB + hstepB + kstep, voffB);
        PG8_WAIT_V(6); PG8_BAR;
    } else {
        PG8_STAGE(PG8_SB(0, 0), cB, voffB); PG8_STAGE(PG8_SA(0, 0), cA, voffA); PG8_STAGE(PG8_SB(0, 1), cB + hstepB, voffB); PG8_STAGE(PG8_SA(0, 1), cA + hstepA, voffA);
        if (wr == 1) PG8_BAR;
        PG8_WAIT_V(4); PG8_BAR;
        PG8_STAGE(PG8_SB(1, 0), cB + kstep, voffB); PG8_STAGE(PG8_SA(1, 0), cA + kstep, voffA); PG8_STAGE(PG8_SB(1, 1), cB + hstepB + kstep, voffB);
        PG8_WAIT_V(6); PG8_BAR;
    }
    for (;;) {
        const bool has_next = S.next(ui + 1, nxt);
        const char* nA = has_next ? (const char*)g.A + (size_t)nxt.pm * tstepA : cA; const char* nB = has_next ? (const char*)g.Bt + (size_t)nxt.pn * tstepB : cB;
        for (int t = 0; t < nt; t += 2) {
            const bool last = (t == nt - 2);
            const char* a1 = cA + (size_t)(t + 1) * kstep;
            const char* a2 = last ? nA : cA + (size_t)(t + 2) * kstep; const char* b2 = last ? nB : cB + (size_t)(t + 2) * kstep;
            const char* a3 = a2 + kstep; const char* b3 = b2 + kstep;
            if (last && has_next) S.a_ready(nxt);
            if constexpr (SP2) {
            PG8_LDB(B0, 0, 0); PG8_LDB(B1, 0, 1); PG8_SCHED; PG8_LDA(At, 0, 0); PG8_STAGE(PG8_SA(1, 1), a1 + hstepA, voffA);
            PG8_WAIT_V(8); PG8_WAIT_L(0); PG8_BAR; PG8_MMA(0, 0, At, B0); PG8_MMA(0, 1, At, B1); PG8_BAR; PG8_SCHED;
            PG8_LDA(At, 0, 1); PG8_STAGE(PG8_SB(0, 0), b2, voffB); PG8_STAGE(PG8_SB(0, 1), b2 + hstepB, voffB); PG8_STAGE(PG8_SA(0, 0), a2, voffA);
            PG8_WAIT_V(8); PG8_WAIT_L(0); PG8_BAR; PG8_MMA(1, 0, At, B0); PG8_MMA(1, 1, At, B1); PG8_BAR; PG8_SCHED;
            PG8_LDB(B0, 1, 0); PG8_LDB(B1, 1, 1); PG8_SCHED; PG8_LDA(At, 1, 0); PG8_STAGE(PG8_SA(0, 1), a2 + hstepA, voffA);
            PG8_WAIT_V(8); PG8_WAIT_L(0); PG8_BAR; PG8_MMA(0, 0, At, B0); PG8_MMA(0, 1, At, B1); PG8_BAR; PG8_SCHED;
            PG8_LDA(At, 1, 1); PG8_STAGE(PG8_SB(1, 0), b3, voffB); PG8_STAGE(PG8_SB(1, 1), b3 + hstepB, voffB); PG8_STAGE(PG8_SA(1, 0), a3, voffA);
            PG8_WAIT_V(8); PG8_WAIT_L(0); PG8_BAR; PG8_MMA(1, 0, At, B0); PG8_MMA(1, 1, At, B1); PG8_BAR; PG8_SCHED;
            } else {
            PG8_LDB(B0, 0, 0); PG8_SCHED; PG8_LDA(At, 0, 0); PG8_STAGE(PG8_SA(1, 1), a1 + hstepA, voffA);
            PG8_WAIT_L(8); PG8_BAR; PG8_WAIT_L(0); PG8_MMA(0, 0, At, B0); PG8_BAR; PG8_SCHED;
            PG8_LDB(B1, 0, 1); PG8_STAGE(PG8_SB(0, 0), b2, voffB);
            PG8_BAR; PG8_WAIT_L(0); PG8_MMA(0, 1, At, B1); PG8_BAR;
            PG8_LDA(At, 0, 1); PG8_STAGE(PG8_SA(0, 0), a2, voffA);
            PG8_BAR; PG8_WAIT_L(0); PG8_MMA(1, 0, At, B0); PG8_BAR; PG8_SCHED;
            PG8_STAGE(PG8_SB(0, 1), b2 + hstepB, voffB);
            PG8_WAIT_V(6); PG8_BAR; PG8_MMA(1, 1, At, B1); PG8_BAR;
            PG8_LDB(B0, 1, 0); PG8_SCHED; PG8_LDA(At, 1, 0); PG8_STAGE(PG8_SA(0, 1), a2 + hstepA, voffA);
            PG8_WAIT_L(8); PG8_BAR; PG8_WAIT_L(0); PG8_MMA(0, 0, At, B0); PG8_BAR; PG8_SCHED;
            PG8_LDB(B1, 1, 1); PG8_STAGE(PG8_SB(1, 0), b3, voffB);
            PG8_BAR; PG8_WAIT_L(0); PG8_MMA(0, 1, At, B1); PG8_BAR;
            PG8_LDA(At, 1, 1); PG8_STAGE(PG8_SA(1, 0), a3, voffA);
            PG8_BAR; PG8_WAIT_L(0); PG8_MMA(1, 0, At, B0); PG8_BAR; PG8_SCHED;
            PG8_STAGE(PG8_SB(1, 1), b3 + hstepB, voffB);
            PG8_WAIT_V(6); PG8_BAR; PG8_MMA(1, 1, At, B1); PG8_BAR;
            }
        }
        if constexpr (ALIGN_EPI) { if (wr == 0) PG8_BAR; }
        if constexpr (!Epi::AFTER_DRAIN) { E(acc, cur, wr, wc, fr, fq); S.done(cur); }
        if (!has_next) break;
#pragma unroll
        for (int a = 0; a < 2; ++a)
#pragma unroll
            for (int b = 0; b < 2; ++b)
#pragma unroll
                for (int m = 0; m < 4; ++m)
#pragma unroll
                    for (int n = 0; n < 2; ++n) acc[a][b][m][n] = (f32x4){0.f, 0.f, 0.f, 0.f};
        cur = nxt; cA = nA; cB = nB; ++ui;
        if constexpr (ALIGN_EPI) { if (wr == 1) PG8_BAR; }
    }
    PG8_WAIT_V(0);
    if constexpr (!ALIGN_EPI) { if (wr == 0) PG8_BAR; }
    PG8_BAR;
    if constexpr (Epi::AFTER_DRAIN) { E.fused(acc, cur, wr, wc, fr, fq, lds, wid, lane); S.done(cur); }
#undef PG8_SA
#undef PG8_SB
#undef PG8_STAGE
#undef PG8_LDA
#undef PG8_LDB
#undef PG8_MMA
#undef PG8_WAIT_V
#undef PG8_WAIT_L
#undef PG8_BAR
#undef PG8_SCHED
}
}
#define LAS __attribute__((address_space(3)))
typedef unsigned short bf16;
typedef unsigned u32x4 __attribute__((ext_vector_type(4)));
typedef unsigned u32x2 __attribute__((ext_vector_type(2)));
typedef float f32x4 __attribute__((ext_vector_type(4)));
typedef float f32x16 __attribute__((ext_vector_type(16)));
typedef short bf16x8 __attribute__((ext_vector_type(8)));
typedef short s16x4 __attribute__((ext_vector_type(4)));
using pg8::cvt_pk_bf16; using pg8::LOG2E; using pg8::RMS_EPS;

constexpr int NWAVES = 8, NTHR = 512;
constexpr int DM = 1024, FF = 2816, ZP = 2592, NINP = 2816, DEPTH = 4;
constexpr int MP = 67072;
constexpr int G0_ROWS = 33792, G1_ROWS = 33280;
constexpr size_t MiB = 1u << 20;
constexpr size_t WS_CTL = 0, WS_ROPE = 1 * MiB, WS_SSP = 2 * MiB, WS_METAH = 11 * MiB, WS_W = 13 * MiB, WS_XY = 61 * MiB, WS_BIG = 192 * MiB, WS_END = 553 * MiB;
constexpr size_t W_GU1 = 0, W_DN1 = 11 * MiB, W_GU2 = 33 * MiB / 2, W_DN2 = 55 * MiB / 2, W_IN = 33 * MiB, W_UQ = 77 * MiB / 2, W_UK = 40 * MiB, W_UV = 40 * MiB + MiB / 4, W_O = 40 * MiB + MiB / 2;
constexpr size_t B_Z = 0, B_K = 168 * MiB, B_VT = 218 * MiB, B_YC = 251 * MiB;
constexpr int LDS_BYTES = 147456;
constexpr int A_K = 0, A_KBUF = 64 * 208, A_V = 2 * A_KBUF, A_VBUF = 64 * 144, A_WSF = A_V + 2 * A_VBUF, A_STG = A_WSF + 8 * 256, A_TAB = A_STG + 8 * 4096, A_UW = A_TAB + 4 * 640 * 4 + 256;
static_assert(A_UW + 64 <= 131072, "attention LDS");

struct Args { const float* in[25]; float* out; unsigned char* ws; };
enum { I_XP = 0, I_XS, I_META, I_F1PRE, I_F1GU, I_F1DN, I_F1POST, I_MPRE, I_WIN, I_CONVW, I_RPB, I_MB, I_QN, I_WUQ, I_KVN, I_WUKV, I_CON, I_NON, I_MON, I_WO, I_MPOST, I_F2PRE, I_F2GU, I_F2DN, I_F2POST };

__device__ __forceinline__ float bf2f(unsigned short b) { return __uint_as_float((unsigned)b << 16); }
__device__ __forceinline__ float bflo(unsigned w) { return __uint_as_float(w << 16); }
__device__ __forceinline__ float bfhi(unsigned w) { return __uint_as_float(w & 0xffff0000u); }
__device__ __forceinline__ float wave_sum(float v) {
#pragma unroll
    for (int o = 1; o < 64; o <<= 1) v += __shfl_xor(v, o);
    return v;
}
__device__ __forceinline__ void row_decode(int row, int& s, int& i, int& T) {
    if (row < G0_ROWS) { s = row / 2112; i = row - s * 2112; T = 2048; } else { const int r = row - G0_ROWS, q = r / 4160; s = 16 + q; i = r - q * 4160; T = 4096; }
}
__device__ __forceinline__ float* hptr(float* out, float* metah, int s, int i, int T) {
    if (i < T) { const size_t ob = s < 16 ? (size_t)s * 2048 : (size_t)32768 + (size_t)(s - 16) * 4096; return out + (ob + i) * DM; }
    return metah + (size_t)(s * 16 + (i - T)) * DM;
}
__device__ __forceinline__ void wt_item(const float* W, int ldw, int K, bf16* WT, const float* gain, int k0, int srcn0, int dstn0, LAS float* scr, int lane) {
    const int c = lane & 7;
    if (srcn0 < 0) {
#pragma unroll
        for (int j = 0; j < 4; ++j) { const int n = (lane >> 3) + 8 * j; *(u32x4*)(WT + (size_t)(dstn0 + n) * K + k0 + 8 * c) = (u32x4){0u, 0u, 0u, 0u}; }
        return;
    }
#pragma unroll 8
    for (int i = 0; i < 32; ++i) { const int kk = 2 * i + (lane >> 5); float v = W[(size_t)(k0 + kk) * ldw + srcn0 + (lane & 31)]; if (gain) v *= gain[k0 + kk]; scr[kk * 33 + (lane & 31)] = v; }
    asm volatile("s_waitcnt lgkmcnt(0)" ::: "memory");
#pragma unroll
    for (int j = 0; j < 4; ++j) { const int n = (lane >> 3) + 8 * j; const LAS float* s = scr + (8 * c) * 33 + n;
        u32x4 o; o.x = cvt_pk_bf16(s[0 * 33], s[1 * 33]); o.y = cvt_pk_bf16(s[2 * 33], s[3 * 33]); o.z = cvt_pk_bf16(s[4 * 33], s[5 * 33]); o.w = cvt_pk_bf16(s[6 * 33], s[7 * 33]);
        *(u32x4*)(WT + (size_t)(dstn0 + n) * K + k0 + 8 * c) = o; }
    asm volatile("s_waitcnt lgkmcnt(0)" ::: "memory");
}
__device__ __forceinline__ void convert_layer(const Args* ap, int l, LAS float* scr, int gw, int NGW, int lane) {
    const Args& a = *ap;
    unsigned char* wb = a.ws + WS_W;
    constexpr int N_GU = 16 * 176, N_DN = 44 * 32, N_IN = 16 * 88, N_UQ = 12 * 24, N_UK = 4 * 16, N_WO = 16 * 32;
    constexpr int TOT = 2 * N_GU + 2 * N_DN + N_IN + N_UQ + 2 * N_UK + N_WO;
    for (int it = gw; it < TOT; it += NGW) {
        int r = it;
        if (r < 2 * N_GU) { const int f = r / N_GU; r -= f * N_GU; const int kb = r / 176, nb = r % 176; const int sb = ((nb >> 2) & 1) * 88 + 4 * (nb >> 3) + (nb & 3);
            wt_item(a.in[f ? I_F2GU : I_F1GU] + (size_t)l * 1024 * 5632, 5632, 1024, (bf16*)(wb + (f ? W_GU2 : W_GU1)), a.in[f ? I_F2PRE : I_F1PRE] + l * 1024, 64 * kb, 32 * sb, 32 * nb, scr, lane); continue; }
        r -= 2 * N_GU;
        if (r < 2 * N_DN) { const int f = r / N_DN; r -= f * N_DN; const int kb = r / 32, nb = r % 32;
            wt_item(a.in[f ? I_F2DN : I_F1DN] + (size_t)l * 2816 * 1024, 1024, 2816, (bf16*)(wb + (f ? W_DN2 : W_DN1)), nullptr, 64 * kb, 32 * nb, 32 * nb, scr, lane); continue; }
        r -= 2 * N_DN;
        if (r < N_IN) { const int kb = r / 88, nb = r % 88;
            wt_item(a.in[I_WIN] + (size_t)l * 1024 * 2592, 2592, 1024, (bf16*)(wb + W_IN), a.in[I_MPRE] + l * 1024, 64 * kb, nb < 81 ? 32 * nb : -1, 32 * nb, scr, lane); continue; }
        r -= N_IN;
        if (r < N_UQ) { const int kb = r / 24, nb = r % 24;
            wt_item(a.in[I_WUQ] + (size_t)l * 768 * 768, 768, 768, (bf16*)(wb + W_UQ), a.in[I_QN] + l * 768, 64 * kb, 32 * nb, 32 * nb, scr, lane); continue; }
        r -= N_UQ;
        if (r < 2 * N_UK) { const int v = r / N_UK; r -= v * N_UK; const int kb = r / 16, nb = r % 16; const int sb = (nb >> 1) * 4 + 2 * v + (nb & 1);
            wt_item(a.in[I_WUKV] + (size_t)l * 256 * 1024, 1024, 256, (bf16*)(wb + (v ? W_UV : W_UK)), a.in[I_KVN] + l * 256, 64 * kb, 32 * sb, 32 * nb, scr, lane); continue; }
        r -= 2 * N_UK;
        { const int kb = r / 32, nb = r % 32; const int k0 = 64 * kb;
            const float* gain = k0 < 256 ? a.in[I_CON] + l * 256 : (k0 < 512 ? a.in[I_NON] + l * 256 - 256 : a.in[I_MON] + l * 512 - 512);
            wt_item(a.in[I_WO] + (size_t)l * 1024 * 1024, 1024, 1024, (bf16*)(wb + W_O), gain, k0, 32 * nb, 32 * nb, scr, lane); }
    }
}
__device__ __forceinline__ void rowpass(const Args* ap, const float* gpost, float coef, bool init, bool wxn, int gw, int NGW, int lane) {
    const Args& a = *ap;
    float* metah = (float*)(a.ws + WS_METAH); bf16* XY = (bf16*)(a.ws + WS_XY);
    for (int row = gw; row < MP; row += NGW) {
        int s, i, T; row_decode(row, s, i, T);
        unsigned long long* xy8 = (unsigned long long*)(XY + (size_t)row * DM) + lane;
        if (i >= T + 16) { if (wxn) {
#pragma unroll
                for (int j = 0; j < 4; ++j) xy8[64 * j] = 0ull; }
            continue; }
        float* hp = hptr(a.out, metah, s, i, T);
        f32x4 h[4];
        if (init) {
            const float* src = (i < T) ? (s < 16 ? a.in[I_XP] + ((size_t)s * 2048 + i) * DM : a.in[I_XS] + ((size_t)(s - 16) * 4096 + i) * DM) : a.in[I_META] + (size_t)(i - T) * DM;
#pragma unroll
            for (int j = 0; j < 4; ++j) h[j] = ((const f32x4*)src)[lane + 64 * j];
        } else {
            f32x4 y[4]; float ss = 0.f;
#pragma unroll
            for (int j = 0; j < 4; ++j) { const unsigned long long w = xy8[64 * j]; const unsigned lo = (unsigned)w, hi = (unsigned)(w >> 32);
                y[j] = (f32x4){bflo(lo), bfhi(lo), bflo(hi), bfhi(hi)}; ss += (y[j][0] * y[j][0] + y[j][1] * y[j][1]) + (y[j][2] * y[j][2] + y[j][3] * y[j][3]); }
            ss = wave_sum(ss); const float ry = __builtin_amdgcn_rsqf(ss * (1.0f / DM) + RMS_EPS) * coef;
#pragma unroll
            for (int j = 0; j < 4; ++j) { const f32x4 g = ((const f32x4*)gpost)[lane + 64 * j]; const f32x4 hh = ((const f32x4*)hp)[lane + 64 * j]; h[j] = hh + y[j] * g * ry; }
        }
#pragma unroll
        for (int j = 0; j < 4; ++j) ((f32x4*)hp)[lane + 64 * j] = h[j];
        if (wxn) {
            float s2 = 0.f;
#pragma unroll
            for (int j = 0; j < 4; ++j) s2 += (h[j][0] * h[j][0] + h[j][1] * h[j][1]) + (h[j][2] * h[j][2] + h[j][3] * h[j][3]);
            s2 = wave_sum(s2); const float rh = __builtin_amdgcn_rsqf(s2 * (1.0f / DM) + RMS_EPS);
#pragma unroll
            for (int j = 0; j < 4; ++j) { const f32x4 v = h[j] * rh; xy8[64 * j] = (unsigned long long)cvt_pk_bf16(v[0], v[1]) | ((unsigned long long)cvt_pk_bf16(v[2], v[3]) << 32); }
        }
    }
}
__device__ __forceinline__ void rope_table(float* tab, int gt, int NGT) {
    for (int e = gt; e < 4112 * 16; e += NGT) { const int pos = e >> 4, j = e & 15; double f = 1.0; for (int k = 0; k < j; ++k) f *= 0.56234132519034907;
        double rev = (double)pos * f * 0.15915494309189535; rev -= __builtin_floor(rev); const float rv = (float)rev;
        tab[2 * e] = __builtin_amdgcn_cosf(rv); tab[2 * e + 1] = __builtin_amdgcn_sinf(rv); }
}
struct Grp { int row0, rows, T, Lp, nseq; };
__device__ __forceinline__ Grp grp_of(int g) { Grp r; if (g == 0) { r.row0 = 0; r.rows = G0_ROWS; r.T = 2048; r.Lp = 2112; r.nseq = 16; } else { r.row0 = G0_ROWS; r.rows = G1_ROWS; r.T = 4096; r.Lp = 4160; r.nseq = 8; } return r; }
__device__ __forceinline__ void conv_kpe_pass(const Args* ap, int l, const Grp& G, int gw, int NGW, int lane) {
    const Args& a = *ap;
    const bf16* Z = (const bf16*)(a.ws + WS_BIG + B_Z); bf16* KB = (bf16*)(a.ws + WS_BIG + B_K); bf16* YC = (bf16*)(a.ws + WS_BIG + B_YC);
    const float* cw = a.in[I_CONVW] + (size_t)l * 3 * 256; const float* rope = (const float*)(a.ws + WS_ROPE);
    const f32x4 w0 = ((const f32x4*)cw)[lane], w1 = ((const f32x4*)(cw + 256))[lane], w2 = ((const f32x4*)(cw + 512))[lane];
    for (int gr = gw; gr < G.rows; gr += NGW) {
        const int sq = gr / G.Lp, i = gr - sq * G.Lp, T = G.T;
        unsigned long long* yo = (unsigned long long*)(YC + (size_t)gr * DM) + lane;
        if (i >= T + 16) { *yo = 0ull; if (lane < 16) {
#pragma unroll
                for (int h = 0; h < 8; ++h) { KB[(size_t)gr * 768 + 96 * h + 64 + lane] = 0; KB[(size_t)gr * 768 + 96 * h + 80 + lane] = 0; } }
            continue; }
        const int p = (i < T) ? 16 + i : i - T;
        const int il = (p == 0) ? -1 : ((p - 1 >= 16) ? p - 17 : T + p - 1), ir = (p == T + 15) ? -1 : ((p + 1 >= 16) ? p - 15 : T + p + 1);
        const bf16* zr = Z + (size_t)gr * ZP;
        const unsigned long long cb = *((const unsigned long long*)zr + lane);
        f32x4 pc, pl = {0.f, 0.f, 0.f, 0.f}, pr = {0.f, 0.f, 0.f, 0.f};
        { const unsigned long long c = *((const unsigned long long*)(zr + 256) + lane), u = *((const unsigned long long*)(zr + 512) + lane);
          pc = (f32x4){bflo((unsigned)c) * bflo((unsigned)u), bfhi((unsigned)c) * bfhi((unsigned)u), bflo((unsigned)(c >> 32)) * bflo((unsigned)(u >> 32)), bfhi((unsigned)(c >> 32)) * bfhi((unsigned)(u >> 32))}; }
        if (il >= 0) { const bf16* z2 = Z + (size_t)(sq * G.Lp + il) * ZP; const unsigned long long c = *((const unsigned long long*)(z2 + 256) + lane), u = *((const unsigned long long*)(z2 + 512) + lane);
          pl = (f32x4){bflo((unsigned)c) * bflo((unsigned)u), bfhi((unsigned)c) * bfhi((unsigned)u), bflo((unsigned)(c >> 32)) * bflo((unsigned)(u >> 32)), bfhi((unsigned)(c >> 32)) * bfhi((unsigned)(u >> 32))}; }
        if (ir >= 0) { const bf16* z2 = Z + (size_t)(sq * G.Lp + ir) * ZP; const unsigned long long c = *((const unsigned long long*)(z2 + 256) + lane), u = *((const unsigned long long*)(z2 + 512) + lane);
          pr = (f32x4){bflo((unsigned)c) * bflo((unsigned)u), bfhi((unsigned)c) * bfhi((unsigned)u), bflo((unsigned)(c >> 32)) * bflo((unsigned)(u >> 32)), bfhi((unsigned)(c >> 32)) * bfhi((unsigned)(u >> 32))}; }
        const f32x4 cbv = (f32x4){bflo((unsigned)cb), bfhi((unsigned)cb), bflo((unsigned)(cb >> 32)), bfhi((unsigned)(cb >> 32))};
        const f32x4 y = cbv * (w0 * pl + w1 * pc + w2 * pr);
        float ss = (y[0] * y[0] + y[1] * y[1]) + (y[2] * y[2] + y[3] * y[3]); ss = wave_sum(ss);
        const float rn = __builtin_amdgcn_rsqf(ss * (1.0f / 256.0f) + RMS_EPS); const f32x4 o = y * rn;
        *yo = (unsigned long long)cvt_pk_bf16(o[0], o[1]) | ((unsigned long long)cvt_pk_bf16(o[2], o[3]) << 32);
        if (lane < 16) { const float x1 = bf2f(zr[2560 + lane]), x2 = bf2f(zr[2576 + lane]); const float c = rope[(size_t)p * 32 + 2 * lane], s = rope[(size_t)p * 32 + 2 * lane + 1];
            const unsigned pk = cvt_pk_bf16(x1 * c - x2 * s, x1 * s + x2 * c); const bf16 o1 = (bf16)(pk & 0xffffu), o2 = (bf16)(pk >> 16);
#pragma unroll
            for (int h = 0; h < 8; ++h) { KB[(size_t)gr * 768 + 96 * h + 64 + lane] = o1; KB[(size_t)gr * 768 + 96 * h + 80 + lane] = o2; } }
    }
}
__device__ __forceinline__ void ynorm_pass(const Args* ap, const Grp& G, int gw, int NGW, int lane) {
    const Args& a = *ap;
    bf16* YC = (bf16*)(a.ws + WS_BIG + B_YC);
    for (int gr = gw; gr < G.rows; gr += NGW) {
        const int sq = gr / G.Lp, i = gr - sq * G.Lp;
        unsigned long long* p1 = (unsigned long long*)(YC + (size_t)gr * DM + 256) + lane; u32x4* p2 = (u32x4*)(YC + (size_t)gr * DM + 512) + lane;
        if (i >= G.T + 16) { *p1 = 0ull; *p2 = (u32x4){0u, 0u, 0u, 0u}; continue; }
        const unsigned long long w = *p1; const u32x4 v = *p2;
        float y[4] = {bflo((unsigned)w), bfhi((unsigned)w), bflo((unsigned)(w >> 32)), bfhi((unsigned)(w >> 32))};
        float z[8] = {bflo(v.x), bfhi(v.x), bflo(v.y), bfhi(v.y), bflo(v.z), bfhi(v.z), bflo(v.w), bfhi(v.w)};
        float s1 = (y[0] * y[0] + y[1] * y[1]) + (y[2] * y[2] + y[3] * y[3]); float s2 = 0.f;
#pragma unroll
        for (int e = 0; e < 8; ++e) s2 += z[e] * z[e];
        s1 = wave_sum(s1); s2 = wave_sum(s2);
        const float r1 = __builtin_amdgcn_rsqf(s1 * (1.0f / 256.0f) + RMS_EPS), r2 = __builtin_amdgcn_rsqf(s2 * (1.0f / 512.0f) + RMS_EPS);
        *p1 = (unsigned long long)cvt_pk_bf16(y[0] * r1, y[1] * r1) | ((unsigned long long)cvt_pk_bf16(y[2] * r1, y[3] * r1) << 32);
        u32x4 o; o.x = cvt_pk_bf16(z[0] * r2, z[1] * r2); o.y = cvt_pk_bf16(z[2] * r2, z[3] * r2); o.z = cvt_pk_bf16(z[4] * r2, z[5] * r2); o.w = cvt_pk_bf16(z[6] * r2, z[7] * r2); *p2 = o;
    }
}
struct AttG { const bf16 *Q, *K, *VT, *Z; bf16* YC; const float* rope; int rows, T, Lp; };
__device__ __forceinline__ int crow(int r, int hi) { return (r & 3) + 8 * (r >> 2) + 4 * hi; }
#define MFMA32(a, b, c) __builtin_amdgcn_mfma_f32_32x32x16_bf16((a), (b), (c), 0, 0, 0)
template <int MODE>
__device__ __forceinline__ void attn_unit(const AttG& P, int seq, int head, int qb, LAS unsigned char* lds, int tid, int wid, int lane) {
    constexpr int DQK = MODE == 0 ? 96 : 64, NDK = DQK / 16, KP = DQK * 2 + 16, VP = 144;
    const int r32 = lane & 31, hi = lane >> 5;
    const int T = P.T, Lp = P.Lp, nqbr = T >> 8; const bool metablk = (qb == nqbr);
    const int sbase = seq * Lp;
    const int qi = qb * 256 + wid * 32 + r32; const int qic = qi < Lp - 1 ? qi : Lp - 1;
    bf16x8 qr[NDK];
    { const bf16* qsrc = MODE == 0 ? P.Q + (size_t)(sbase + qic) * 768 + 96 * head : P.Z + (size_t)(sbase + qic) * ZP + 768 + 64 * head;
#pragma unroll
      for (int d0 = 0; d0 < NDK; ++d0) qr[d0] = *(const bf16x8*)(qsrc + 16 * d0 + 8 * hi); }
    if constexpr (MODE == 0) {
        const int pos = qic < T ? 16 + qic : (qic - T < 15 ? qic - T : 15);
        const f32x4* rp = (const f32x4*)(P.rope + (size_t)pos * 32 + 16 * hi);
#pragma unroll
        for (int e2 = 0; e2 < 4; ++e2) { const f32x4 cs = rp[e2];
#pragma unroll
            for (int q = 0; q < 2; ++q) { const int e = 2 * e2 + q; const float c = cs[2 * q], s = cs[2 * q + 1];
                const float x1 = bf2f((unsigned short)qr[4][e]), x2 = bf2f((unsigned short)qr[5][e]);
                const unsigned pk = cvt_pk_bf16(x1 * c - x2 * s, x1 * s + x2 * c); qr[4][e] = (short)(pk & 0xffffu); qr[5][e] = (short)(pk >> 16); } }
    }
    int nt, kr_lo = 0; const int rows_total = T >> 6;
    int na_r = 0, na_c = 0, na_rs = 0, na_cs = 0;
    if constexpr (MODE == 0) nt = rows_total + 1;
    else {
        if (metablk) nt = 1;
        else { const int r0 = 4 * qb; int lo = r0 - 4; lo = lo < 0 ? 0 : (lo > rows_total - 8 ? rows_total - 8 : lo); int h2 = r0 - 1; h2 = h2 < 0 ? 0 : (h2 > rows_total - 8 ? rows_total - 8 : h2);
            kr_lo = lo; nt = (h2 + 7 - lo + 1) + 1; }
        na_r = 4 * qb + (wid >> 1); na_c = 32 * (wid & 1) + r32;
        na_rs = na_r - 4; na_rs = na_rs < 0 ? 0 : (na_rs > rows_total - 8 ? rows_total - 8 : na_rs);
        na_cs = na_c - 8; na_cs = na_cs < 0 ? 0 : (na_cs > 48 ? 48 : na_cs);
    }
    const LAS float* tabL = (const LAS float*)(lds + A_TAB) + head * 640 + 64;
    const LAS float* mbL = (const LAS float*)(lds + A_TAB + 4 * 640 * 4) + head * 16;
    LAS float* wsf = (LAS float*)(lds + A_WSF) + wid * 64;
    u32x4 kst0, kst1 = {0u, 0u, 0u, 0u}, vst;
    const int kc0 = tid, kc1 = 512 + tid;
#define TILE_KB(t) ((t) == nt - 1 ? T : 64 * (kr_lo + (t)))
#define GLOAD(t) do { const int kb_ = TILE_KB(t); \
      if constexpr (MODE == 0) { { const int krow = kc0 / 12, part = kc0 % 12; kst0 = *(const u32x4*)(P.K + (size_t)(sbase + kb_ + krow) * 768 + 96 * head + 8 * part); } \
          if (tid < 256) { const int krow = kc1 / 12, part = kc1 % 12; kst1 = *(const u32x4*)(P.K + (size_t)(sbase + kb_ + krow) * 768 + 96 * head + 8 * part); } \
          { const int d = tid >> 3, part = tid & 7; vst = *(const u32x4*)(P.VT + (size_t)(64 * head + d) * P.rows + sbase + kb_ + 8 * part); } } \
      else { const int krow = tid >> 3, part = tid & 7; const bf16* zr_ = P.Z + (size_t)(sbase + kb_ + krow) * ZP + 64 * head + 8 * part; kst0 = *(const u32x4*)(zr_ + 1024); vst = *(const u32x4*)(zr_ + 1280); } } while (0)
#define LSTORE(buf) do { LAS unsigned char* Kb_ = lds + A_K + (buf) * A_KBUF; LAS unsigned char* Vb_ = lds + A_V + (buf) * A_VBUF; \
      if constexpr (MODE == 0) { { const int krow = kc0 / 12, part = kc0 % 12; *(LAS u32x4*)(Kb_ + krow * KP + part * 16) = kst0; } \
          if (tid < 256) { const int krow = kc1 / 12, part = kc1 % 12; *(LAS u32x4*)(Kb_ + krow * KP + part * 16) = kst1; } \
          { const int d = tid >> 3, part = tid & 7; *(LAS u32x4*)(Vb_ + d * VP + part * 16) = vst; } } \
      else { const int krow = tid >> 3, part = tid & 7; *(LAS u32x4*)(Kb_ + krow * KP + part * 16) = kst0; \
          LAS unsigned short* vt_ = (LAS unsigned short*)(Vb_ + (8 * part) * VP + krow * 2); \
          vt_[0 * (VP / 2)] = (unsigned short)(vst.x & 0xffffu); vt_[1 * (VP / 2)] = (unsigned short)(vst.x >> 16); vt_[2 * (VP / 2)] = (unsigned short)(vst.y & 0xffffu); vt_[3 * (VP / 2)] = (unsigned short)(vst.y >> 16); \
          vt_[4 * (VP / 2)] = (unsigned short)(vst.z & 0xffffu); vt_[5 * (VP / 2)] = (unsigned short)(vst.z >> 16); vt_[6 * (VP / 2)] = (unsigned short)(vst.w & 0xffffu); vt_[7 * (VP / 2)] = (unsigned short)(vst.w >> 16); } } while (0)
    GLOAD(0); LSTORE(0);
    __syncthreads();
    float m_cur = -1e30f, l_reg = 0.f;
    f32x16 o0, o1;
#pragma unroll
    for (int r = 0; r < 16; ++r) { o0[r] = 0.f; o1[r] = 0.f; }
    for (int t = 0; t < nt; ++t) {
        const int buf = t & 1; const bool more = (t + 1 < nt);
        if (more) GLOAD(t + 1);
        const bool is_meta = (t == nt - 1);
        bool active = true;
        if constexpr (MODE == 1) { if (!is_meta) { const int kr = kr_lo + t; active = (kr >= na_rs && kr <= na_rs + 7); } }
        if (active) {
            const LAS unsigned char* Kb = lds + A_K + buf * A_KBUF; const LAS unsigned char* Vb = lds + A_V + buf * A_VBUF;
            f32x16 p0, p1;
#pragma unroll
            for (int r = 0; r < 16; ++r) { p0[r] = 0.f; p1[r] = 0.f; }
#pragma unroll
            for (int d0 = 0; d0 < NDK; ++d0) {
                const bf16x8 k0 = *(const LAS bf16x8*)(Kb + r32 * KP + d0 * 32 + hi * 16);
                const bf16x8 k1 = *(const LAS bf16x8*)(Kb + (32 + r32) * KP + d0 * 32 + hi * 16);
                p0 = MFMA32(k0, qr[d0], p0); p1 = MFMA32(k1, qr[d0], p1);
            }
            if (is_meta) {
#pragma unroll
                for (int r = 0; r < 16; ++r) { const int kv = crow(r, hi); float b = 0.f; if constexpr (MODE == 1) b = mbL[kv & 15]; p0[r] = kv < 16 ? p0[r] + b : -INFINITY; p1[r] = -INFINITY; }
            } else if constexpr (MODE == 1) {
                const int kr = kr_lo + t; const LAS float* rp = tabL + (kr - na_r + 7) * 31 + (15 - na_c);
#pragma unroll
                for (int r = 0; r < 16; ++r) { const int kc = crow(r, hi);
                    p0[r] = (kc >= na_cs && kc < na_cs + 16) ? p0[r] + rp[kc] : -INFINITY;
                    p1[r] = (kc + 32 >= na_cs && kc + 32 < na_cs + 16) ? p1[r] + rp[kc + 32] : -INFINITY; }
            }
            float mx = fmaxf(p0[0], p1[0]);
#pragma unroll
            for (int r = 1; r < 16; ++r) mx = fmaxf(mx, fmaxf(p0[r], p1[r]));
            mx = fmaxf(mx, __shfl_xor(mx, 32));
            if (__any(mx > m_cur)) {
                const float m_new = fmaxf(m_cur, mx); const float alpha = __builtin_amdgcn_exp2f(m_cur - m_new); m_cur = m_new; l_reg *= alpha;
                if (hi == 0) wsf[r32] = alpha;
                asm volatile("s_waitcnt lgkmcnt(0)" ::: "memory");
#pragma unroll
                for (int j = 0; j < 4; ++j) { const f32x4 av = *(const LAS f32x4*)(wsf + 8 * j + 4 * hi);
#pragma unroll
                    for (int e = 0; e < 4; ++e) { o0[4 * j + e] *= av[e]; o1[4 * j + e] *= av[e]; } }
                asm volatile("s_waitcnt lgkmcnt(0)" ::: "memory");
            }
            float ls = 0.f;
#pragma unroll
            for (int r = 0; r < 16; ++r) { p0[r] = __builtin_amdgcn_exp2f(p0[r] - m_cur); p1[r] = __builtin_amdgcn_exp2f(p1[r] - m_cur); ls += p0[r] + p1[r]; }
            l_reg += ls;
            bf16x8 pa[4];
#pragma unroll
            for (int ks = 0; ks < 4; ++ks) { u32x4 w;
                if (ks < 2) { w.x = cvt_pk_bf16(p0[8 * ks + 0], p0[8 * ks + 1]); w.y = cvt_pk_bf16(p0[8 * ks + 2], p0[8 * ks + 3]); w.z = cvt_pk_bf16(p0[8 * ks + 4], p0[8 * ks + 5]); w.w = cvt_pk_bf16(p0[8 * ks + 6], p0[8 * ks + 7]); }
                else { const int b = 8 * (ks - 2); w.x = cvt_pk_bf16(p1[b + 0], p1[b + 1]); w.y = cvt_pk_bf16(p1[b + 2], p1[b + 3]); w.z = cvt_pk_bf16(p1[b + 4], p1[b + 5]); w.w = cvt_pk_bf16(p1[b + 6], p1[b + 7]); }
                pa[ks] = __builtin_bit_cast(bf16x8, w); }
#pragma unroll
            for (int ks = 0; ks < 4; ++ks) {
                const LAS unsigned char* vp0 = Vb + r32 * VP + (16 * ks + 4 * hi) * 2; const LAS unsigned char* vp1 = vp0 + 32 * VP;
                const s16x4 a0 = *(const LAS s16x4*)vp0, a1 = *(const LAS s16x4*)(vp0 + 16), b0 = *(const LAS s16x4*)vp1, b1 = *(const LAS s16x4*)(vp1 + 16);
                const bf16x8 v0 = (bf16x8){a0[0], a0[1], a0[2], a0[3], a1[0], a1[1], a1[2], a1[3]}, v1 = (bf16x8){b0[0], b0[1], b0[2], b0[3], b1[0], b1[1], b1[2], b1[3]};
                o0 = MFMA32(pa[ks], v0, o0); o1 = MFMA32(pa[ks], v1, o1);
            }
        }
        if (more) LSTORE(buf ^ 1);
        __syncthreads();
    }
#undef GLOAD
#undef LSTORE
#undef TILE_KB
    l_reg += __shfl_xor(l_reg, 32);
    if (hi == 0) wsf[32 + r32] = l_reg;
    asm volatile("s_waitcnt lgkmcnt(0)" ::: "memory");
    LAS unsigned short* stg = (LAS unsigned short*)(lds + A_STG) + wid * 2048;
#pragma unroll
    for (int j = 0; j < 4; ++j) { const f32x4 lv = *(const LAS f32x4*)(wsf + 32 + 8 * j + 4 * hi);
#pragma unroll
        for (int e = 0; e < 4; ++e) { const int r = 4 * j + e; const float rl = __builtin_amdgcn_rcpf(lv[e]); const int orow = crow(r, hi);
            const unsigned pk = cvt_pk_bf16(o0[r] * rl, o1[r] * rl); stg[orow * 64 + r32] = (unsigned short)(pk & 0xffffu); stg[orow * 64 + 32 + r32] = (unsigned short)(pk >> 16); } }
    asm volatile("s_waitcnt lgkmcnt(0)" ::: "memory");
    { const int coloff = (MODE == 0 ? 512 : 256) + 64 * head;
#pragma unroll
      for (int i = 0; i < 4; ++i) { const int row = i * 8 + (lane >> 3), ch = lane & 7; const u32x4 v = *(const LAS u32x4*)(stg + row * 64 + ch * 8);
          const int qrow = qb * 256 + wid * 32 + row; const bool valid = metablk ? (wid == 0 && row < 16) : true;
          if (valid) *(u32x4*)(P.YC + (size_t)(sbase + qrow) * DM + coloff + ch * 8) = v; } }
    asm volatile("s_waitcnt lgkmcnt(0)" ::: "memory");
}
__device__ __forceinline__ void attn_phase(const Args* ap, int l, const Grp& G, unsigned* ctr, LAS unsigned char* lds, int tid, int wid, int lane) {
    const Args& a = *ap;
    AttG P; P.Q = (const bf16*)(a.ws + WS_XY) + (size_t)G.row0 * DM; P.K = (const bf16*)(a.ws + WS_BIG + B_K); P.VT = (const bf16*)(a.ws + WS_BIG + B_VT); P.Z = (const bf16*)(a.ws + WS_BIG + B_Z);
    P.YC = (bf16*)(a.ws + WS_BIG + B_YC); P.rope = (const float*)(a.ws + WS_ROPE); P.rows = G.rows; P.T = G.T; P.Lp = G.Lp;
    { LAS float* tab = (LAS float*)(lds + A_TAB); const float* rpb = a.in[I_RPB] + (size_t)l * 4 * 465; const float* mb = a.in[I_MB] + (size_t)l * 64;
      for (int e = tid; e < 4 * 640; e += NTHR) { const int h = e / 640, j = e - h * 640 - 64; tab[e] = (j >= 0 && j < 465) ? rpb[h * 465 + j] * LOG2E : 0.f; }
      if (tid < 64) tab[4 * 640 + tid] = mb[tid] * LOG2E; }
    const int nqb = (G.T >> 8) + 1; const int nMLA = G.nseq * 8 * nqb, nNA = G.nseq * 4 * nqb, total = nMLA + nNA;
    LAS volatile unsigned* uw = (LAS volatile unsigned*)(lds + A_UW);
    for (;;) {
        __syncthreads();
        if (tid == 0) *uw = atomicAdd(ctr, 1u);
        __syncthreads();
        const int u = (int)*uw;
        if (u >= total) break;
        if (u < nMLA) { const int qb = u % nqb, r = u / nqb; attn_unit<0>(P, r >> 3, r & 7, qb, lds, tid, wid, lane); }
        else { const int v = u - nMLA; const int qb = v % nqb, r = v / nqb; attn_unit<1>(P, r >> 2, r & 3, qb, lds, tid, wid, lane); }
    }
}
#define XB_TMO      128
#define XB_XCNT(j)  (256  + 64 * (j))
#define XB_XSUB(j)  (1280 + 64 * (j))
#define XB_XGEN(j)  (2304 + 64 * (j))
#define XB_TOP      3328
#define XB_TOPGEN   3392
#define XCD_BAR_WORDS 3456
#define XB_SPIN_CAP (1u << 18)

__device__ __forceinline__ unsigned xb_ld(unsigned* p)              { return __hip_atomic_load(p, __ATOMIC_RELAXED, __HIP_MEMORY_SCOPE_AGENT); }
__device__ __forceinline__ unsigned xb_add(unsigned* p, unsigned v) { return __hip_atomic_fetch_add(p, v, __ATOMIC_RELAXED, __HIP_MEMORY_SCOPE_AGENT); }
__device__ __forceinline__ unsigned xb_xcc_id() { return (unsigned)__builtin_amdgcn_s_getreg((3 << 11) | 20) & 0xFu; }
#define XB_SPIN(cond, bar) do { unsigned _sp = 0; while (cond) { __builtin_amdgcn_s_sleep(1); \
    if ((++_sp & 255u) == 0u) { if (xb_ld(&(bar)[XB_TMO])) break; if (_sp > XB_SPIN_CAP) { atomicAdd(&(bar)[XB_TMO], 1u); break; } } } } while (0)

struct XcdBarrier {
    unsigned* bar; unsigned x;
    volatile LAS unsigned* st;
};

__device__ __forceinline__ XcdBarrier xcd_barrier_post(unsigned* bar, volatile LAS unsigned* st) {
    XcdBarrier b; b.bar = bar; b.x = xb_xcc_id(); b.st = st;
    if (threadIdx.x == 0) (void)xb_add(&bar[XB_XCNT(b.x)], 1u);
    return b;
}
__device__ __forceinline__ void xcd_barrier_complete(unsigned* bar, unsigned x, unsigned& nloc, unsigned& nx) {
    const unsigned G = gridDim.x * gridDim.y * gridDim.z;
    unsigned sum, cnt, mine, sp = 0u;
    for (;;) {
        sum = 0u; cnt = 0u; mine = 0u;
#pragma unroll
        for (unsigned j = 0; j < 16; ++j) { const unsigned c = xb_ld(&bar[XB_XCNT(j)]); sum += c; cnt += (c > 0u) ? 1u : 0u; mine = (j == x) ? c : mine; }
        if (sum == G) break;
        __builtin_amdgcn_s_sleep(1);
        if ((++sp & 255u) == 0u) { if (xb_ld(&bar[XB_TMO])) break; if (sp > XB_SPIN_CAP) { atomicAdd(&bar[XB_TMO], 1u); break; } }
    }
    nloc = mine > 0u ? mine : 1u; nx = cnt > 0u ? cnt : 1u;
}

__device__ __forceinline__ void xcd_barrier(const XcdBarrier& b) {
    asm volatile("s_waitcnt vmcnt(0)" ::: "memory");
    __syncthreads();
    if (threadIdx.x == 0) {
        unsigned* bar = b.bar;
        __builtin_amdgcn_s_waitcnt(0);
        unsigned nloc = b.st[0], nx = b.st[1];
        if (nloc == 0u) { xcd_barrier_complete(bar, b.x, nloc, nx); b.st[0] = nloc; b.st[1] = nx; }
        const unsigned old = xb_add(&bar[XB_XSUB(b.x)], 1u);
        const unsigned gen = old / nloc;
        if (old + 1u == (gen + 1u) * nloc) {
            __builtin_amdgcn_fence(__ATOMIC_RELEASE, "agent");
            asm volatile("s_waitcnt vmcnt(0)" ::: "memory");
            const unsigned og = xb_add(&bar[XB_TOP], 1u);
            const unsigned tg = og / nx;
            if (og + 1u == (tg + 1u) * nx) xb_add(&bar[XB_TOPGEN], 1u);
            else XB_SPIN(xb_ld(&bar[XB_TOPGEN]) == tg, bar);
            __builtin_amdgcn_fence(__ATOMIC_ACQUIRE, "agent");
            xb_add(&bar[XB_XGEN(b.x)], 1u);
            asm volatile("s_waitcnt vmcnt(0)" ::: "memory");
        } else {
            XB_SPIN(xb_ld(&bar[XB_XGEN(b.x)]) == gen, bar);
            __builtin_amdgcn_fence(__ATOMIC_ACQUIRE, "agent");
            asm volatile("s_waitcnt vmcnt(0)" ::: "memory");
        }
    }
    __syncthreads();
}

constexpr int CW_BAR = 1024;
#define XBAR() do { const Args* A_ = KA(); XcdBarrier b_; b_.bar = (unsigned*)(A_->ws + WS_CTL) + CW_BAR; b_.x = xb_xcc_id(); b_.st = (volatile LAS unsigned*)(L + 133120); xcd_barrier(b_); } while (0)

#ifndef REP_GEMM
#define REP_GEMM 1
#endif
#ifndef REP_ATT
#define REP_ATT 1
#endif
#ifndef REP_FFN
#define REP_FFN 1
#endif
#define GEMM_CALL1(EpiT, gobj, sobj, eobj) pg8::gemm_phase<EpiT, pg8::StaticOrder, true, true>(L, gobj, sobj, eobj)
#define GEMM_CALL2(EpiT, gobj, sobj, eobj) do { GEMM_CALL1(EpiT, gobj, sobj, eobj); asm volatile("" ::: "memory"); GEMM_CALL1(EpiT, gobj, sobj, eobj); } while (0)
#if REP_FFN == 1
#define GEMM_CALL_F GEMM_CALL1
#else
#define GEMM_CALL_F GEMM_CALL2
#endif
#if REP_GEMM == 1
#define GEMM_CALL(EpiT, gobj, sobj, eobj) pg8::gemm_phase<EpiT, pg8::StaticOrder, true, true>(L, gobj, sobj, eobj)
#else
#define GEMM_CALL(EpiT, gobj, sobj, eobj) do { pg8::gemm_phase<EpiT, pg8::StaticOrder, true, true>(L, gobj, sobj, eobj); asm volatile("" ::: "memory"); pg8::gemm_phase<EpiT, pg8::StaticOrder, true, true>(L, gobj, sobj, eobj); } while (0)
#endif
#define KA() ({ const Args* p_ = (const Args*)__builtin_amdgcn_kernarg_segment_ptr(); asm volatile("" : "+s"(p_)); p_; })
__global__ void __launch_bounds__(NTHR, 2) mk_fwd(Args a_unused) {
    extern __shared__ __attribute__((aligned(16))) unsigned char lds_raw[];
    cg::grid_group grid = cg::this_grid();
    LAS unsigned char* L = (LAS unsigned char*)lds_raw;
#define TID ({ int t_ = (int)threadIdx.x; asm volatile("" : "+v"(t_)); t_; })
#define LANE (TID & 63)
#define WID (__builtin_amdgcn_readfirstlane(TID >> 6))
#define NG ((int)gridDim.x)
#define BX ((int)blockIdx.x)
#define GW (BX * NWAVES + WID)
#define NGW (NG * NWAVES)
#define SCR ((LAS float*)(L + WID * 8448))
    if (threadIdx.x < 2) ((volatile LAS unsigned*)(L + 133120))[threadIdx.x] = 0u;
    __syncthreads();
    { const Args* A = KA(); (void)xcd_barrier_post((unsigned*)(A->ws + WS_CTL) + CW_BAR, (volatile LAS unsigned*)(L + 133120)); }
    { const Args* A = KA(); rope_table((float*)(A->ws + WS_ROPE), BX * NTHR + TID, NG * NTHR); }
    { const Args* A = KA(); convert_layer(A, 0, SCR, GW, NGW, LANE); }
    { const Args* A = KA(); rowpass(A, nullptr, 0.f, true, true, GW, NGW, LANE); }
    grid.sync();
    for (int st = 0; st < 3 * DEPTH; ++st) {
        const int l = st / 3, k = st - 3 * l;
        if (k != 1) {
            const int f = k >> 1;
            { const Args* A = KA(); unsigned char* ws = A->ws; pg8::Gemm g{(const bf16*)(ws + WS_XY), (const bf16*)(ws + WS_W + (f ? W_GU2 : W_GU1)), MP, 2 * FF, DM, DM, DM}; pg8::StaticOrder S; S.init(MP, 2 * FF, NG, BX);
              pg8::EpiSwiGLU E{(bf16*)(ws + WS_BIG), FF}; GEMM_CALL_F(pg8::EpiSwiGLU, g, S, E); }
            XBAR();
            { const Args* A = KA(); unsigned char* ws = A->ws; pg8::Gemm g{(const bf16*)(ws + WS_BIG), (const bf16*)(ws + WS_W + (f ? W_DN2 : W_DN1)), MP, DM, FF, FF, FF}; pg8::StaticOrder S; S.init(MP, DM, NG, BX);
              pg8::EpiPlain E{(bf16*)(ws + WS_XY), DM}; GEMM_CALL_F(pg8::EpiPlain, g, S, E); }
            XBAR();
            const bool last = (l == DEPTH - 1 && f == 1);
            { const Args* A = KA(); rowpass(A, A->in[f ? I_F2POST : I_F1POST] + l * DM, 0.5f, false, !last, GW, NGW, LANE); }
            if (f == 1 && !last) { const Args* A = KA(); convert_layer(A, l + 1, SCR, GW, NGW, LANE); }
            if (!last) XBAR();
        } else {
            for (int gi = 0; gi < 2; ++gi) {
                { const Args* A = KA(); unsigned char* ws = A->ws; const Grp G = grp_of(gi);
                  pg8::Gemm g{(const bf16*)(ws + WS_XY) + (size_t)G.row0 * DM, (const bf16*)(ws + WS_W + W_IN), G.rows, NINP, DM, DM, DM}; pg8::StaticOrder S; S.init(G.rows, NINP, NG, BX);
                  pg8::EpiInProj E{(bf16*)(ws + WS_BIG + B_Z), (float*)(ws + WS_SSP) + (size_t)G.row0 * 32}; GEMM_CALL(pg8::EpiInProj, g, S, E); }
                XBAR();
                { const Args* A = KA(); unsigned char* ws = A->ws; const Grp G = grp_of(gi);
                  pg8::Gemm g{(const bf16*)(ws + WS_BIG + B_Z) + 1536, (const bf16*)(ws + WS_W + W_UQ), G.rows, 768, 768, ZP, 768}; pg8::StaticOrder S; S.init(G.rows, 768, NG, BX);
                  pg8::EpiRowScale E{(bf16*)(ws + WS_XY) + (size_t)G.row0 * DM, 768, (const float*)(ws + WS_SSP) + (size_t)G.row0 * 32, 0, 6, 1.0f / 768.0f, 0.10206207261596575f * LOG2E, 0, (LAS float*)(L + 132096)}; GEMM_CALL(pg8::EpiRowScale, g, S, E); }
                { const Args* A = KA(); unsigned char* ws = A->ws; const Grp G = grp_of(gi);
                  pg8::Gemm g{(const bf16*)(ws + WS_BIG + B_Z) + 2304, (const bf16*)(ws + WS_W + W_UK), G.rows, 512, 256, ZP, 256}; pg8::StaticOrder S; S.init(G.rows, 512, NG, BX, NG - 140 % NG);
                  pg8::EpiRowScale E{(bf16*)(ws + WS_BIG + B_K), 768, (const float*)(ws + WS_SSP) + (size_t)G.row0 * 32, 24, 2, 1.0f / 256.0f, 1.0f, 1, (LAS float*)(L + 132096)}; GEMM_CALL(pg8::EpiRowScale, g, S, E); }
                { const Args* A = KA(); unsigned char* ws = A->ws; const Grp G = grp_of(gi);
                  pg8::Gemm g{(const bf16*)(ws + WS_W + W_UV), (const bf16*)(ws + WS_BIG + B_Z) + 2304, 512, G.rows, 256, 256, ZP}; pg8::StaticOrder S; S.init(512, G.rows, NG, BX, NG - 148 % NG);
                  pg8::EpiColScale E{(bf16*)(ws + WS_BIG + B_VT), G.rows, (const float*)(ws + WS_SSP) + (size_t)G.row0 * 32, (LAS float*)(L + 132096)}; GEMM_CALL(pg8::EpiColScale, g, S, E); }
                { const Args* A = KA(); const Grp G = grp_of(gi); conv_kpe_pass(A, l, G, GW, NGW, LANE); }
                XBAR();
                { const Args* A = KA(); const Grp G = grp_of(gi); for (int rep_ = 0; rep_ < REP_ATT; ++rep_) attn_phase(A, l, G, (unsigned*)(A->ws + WS_CTL) + 64 * (l * 2 + gi) + 32 * rep_, L, TID, WID, LANE); }
                XBAR();
                { const Args* A = KA(); const Grp G = grp_of(gi); ynorm_pass(A, G, GW, NGW, LANE); }
                XBAR();
                { const Args* A = KA(); unsigned char* ws = A->ws; const Grp G = grp_of(gi);
                  pg8::Gemm g{(const bf16*)(ws + WS_BIG + B_YC), (const bf16*)(ws + WS_W + W_O), G.rows, DM, DM, DM, DM}; pg8::StaticOrder S; S.init(G.rows, DM, NG, BX);
                  pg8::EpiPlain E{(bf16*)(ws + WS_XY) + (size_t)G.row0 * DM, DM}; GEMM_CALL(pg8::EpiPlain, g, S, E); }
                XBAR();
            }
            { const Args* A = KA(); rowpass(A, A->in[I_MPOST] + l * DM, 1.0f, false, true, GW, NGW, LANE); }
            XBAR();
        }
    }
}

extern "C" void kernel_launch(void* const* d_in, const int* in_sizes, int n_in, void* d_out, int out_size, void* d_ws, size_t ws_size, hipStream_t stream) {
    static int grid = 0;
    if (grid == 0) {
        if (n_in != 25 || ws_size < WS_END) { fprintf(stderr, "kernel_launch: need 25 inputs and %zu B of workspace (got %d, %zu)\n", (size_t)WS_END, n_in, ws_size); grid = -1; return; }
        int dev = 0, cus = 0, per_cu = 0;
        if (hipGetDevice(&dev) != hipSuccess || hipDeviceGetAttribute(&cus, hipDeviceAttributeMultiprocessorCount, dev) != hipSuccess) { grid = -1; return; }
        if (hipFuncSetAttribute((const void*)mk_fwd, hipFuncAttributeMaxDynamicSharedMemorySize, LDS_BYTES) != hipSuccess) { fprintf(stderr, "kernel_launch: hipFuncSetAttribute failed\n"); grid = -1; return; }
        if (hipOccupancyMaxActiveBlocksPerMultiprocessor(&per_cu, (const void*)mk_fwd, NTHR, LDS_BYTES) != hipSuccess || per_cu < 1) { fprintf(stderr, "kernel_launch: occupancy query says %d\n", per_cu); }
        (void)hipGetLastError();
        grid = cus;
    }
    if (grid < 0) return;
    if (hipMemsetAsync((char*)d_ws + WS_CTL, 0, 32768, stream) != hipSuccess) return;
    Args a{};
    for (int i = 0; i < 25; ++i) a.in[i] = (const float*)d_in[i];
    a.out = (float*)d_out; a.ws = (unsigned char*)d_ws;
    void* args[] = {&a};
    hipError_t e = hipLaunchCooperativeKernel((const void*)mk_fwd, dim3(grid), dim3(NTHR), args, LDS_BYTES, stream);
    if (e != hipSuccess) fprintf(stderr, "kernel_launch: cooperative launch failed: %s\n", hipGetErrorString(e));
}
```

```cpp
#include <hip/hip_runtime.h>
#include <hip/hip_cooperative_groups.h>
#include <cstdio>
#include <cstdint>
namespace cg = cooperative_groups;
#define GAS __attribute__((address_space(1)))
namespace pg8 {
#define PG8_LAS __attribute__((address_space(3)))
typedef unsigned short bf16_t;
typedef short bf16x8 __attribute__((ext_vector_type(8)));
typedef float f32x4 __attribute__((ext_vector_type(4)));
typedef unsigned u32x4 __attribute__((ext_vector_type(4)));
constexpr int BM = 256, BK = 64, HALF = 128, HTB = HALF * BK * 2  , STAGE_BYTES = 8 * HTB, NXCD = 8, WGM = 8;

__host__ __device__ __forceinline__ int lds_byte(int r, int c) { const int st = (r >> 4) * 2 + (c >> 5), rr = r & 15, cc = c & 31, ob = rr * 64 + cc * 2; return st * 1024 + (ob ^ (((ob >> 9) & 1) << 5)); }
__host__ __device__ __forceinline__ void stage_rc(int b, int& R, int& C) { const int st = b / 1024, sb = b % 1024, swz = sb ^ (((sb >> 9) & 1) << 5); R = (st >> 1) * 16 + swz / 64; C = (st & 1) * 32 + (swz % 64) / 2; }
__host__ __device__ __forceinline__ int perm32(int rho) { const int n = rho >> 4, i = rho & 15; return 8 * (i >> 2) + 4 * n + (i & 3); }

struct Unit { int pm, pn; };
struct Gemm { const bf16_t* A; const bf16_t* Bt; int M, N, K, lda, ldb; };

struct StaticOrder {
    int nM, nN, nwg, G, c;
    __host__ __device__ void init(int M, int N, int G_, int c_, int shift = 0) { nM = M / BM; nN = N / BM; nwg = nM * nN; G = G_; c = (c_ + shift) % G_; }
    __host__ __device__ bool next(int i, Unit& u) const {
        const long L = (long)i * G + c; if (L >= nwg) return false;
        int wgid = (int)L; { const int q = nwg / NXCD, r = nwg % NXCD, xcd = wgid % NXCD, off = wgid / NXCD; wgid = (xcd < r ? xcd * (q + 1) : r * (q + 1) + (xcd - r) * q) + off; }
        const int nig = WGM * nN, gid = wgid / nig, fm = gid * WGM, gsz = (nM - fm) < WGM ? (nM - fm) : WGM;
        u.pm = fm + ((wgid % nig) % gsz); u.pn = (wgid % nig) / gsz; return true;
    }
    __device__ __forceinline__ void a_ready(const Unit&) const {}
    __device__ __forceinline__ void done(const Unit&) const {}
};

__device__ __forceinline__ unsigned cvt_pk_bf16(float lo, float hi) { typedef float f2 __attribute__((ext_vector_type(2))); typedef __bf16 b2 __attribute__((ext_vector_type(2))); f2 v = {lo, hi}; b2 b = __builtin_convertvector(v, b2); return __builtin_bit_cast(unsigned, b); }
constexpr float LOG2E = 1.4426950408889634f;
constexpr float RMS_EPS = 1e-6f;
#define EPI_STORE8(ptr, v0, v1) do { u32x4 w_; w_.x = cvt_pk_bf16((v0)[0], (v0)[1]); w_.y = cvt_pk_bf16((v0)[2], (v0)[3]); w_.z = cvt_pk_bf16((v1)[0], (v1)[1]); w_.w = cvt_pk_bf16((v1)[2], (v1)[3]); *(GAS u32x4*)(ptr) = w_; } while (0)
struct EpiPlain {
    static constexpr bool PERM = true, AFTER_DRAIN = false;
    GAS bf16_t* O; int ldc;
    __device__ __forceinline__ void operator()(const f32x4 (&acc)[2][2][4][2], const Unit& u, int wr, int wc, int fr, int fq) const {
        const int row0 = u.pm * BM + wr * 64 + fr, col0 = u.pn * BM + wc * 32 + 8 * fq;
#pragma unroll
        for (int ai = 0; ai < 2; ++ai)
#pragma unroll
            for (int m = 0; m < 4; ++m) { GAS bf16_t* rowp = O + (size_t)(row0 + ai * HALF + m * 16) * ldc + col0;
#pragma unroll
                for (int bj = 0; bj < 2; ++bj) EPI_STORE8(rowp + bj * HALF, acc[ai][bj][m][0], acc[ai][bj][m][1]); }
    }
};
__device__ __forceinline__ float silu_mul(float g, float u) { return g * u * __builtin_amdgcn_rcpf(1.0f + __builtin_amdgcn_exp2f(-g * LOG2E)); }
struct EpiSwiGLU {
    static constexpr bool PERM = true, AFTER_DRAIN = false;
    GAS bf16_t* O; int ldc;
    __device__ __forceinline__ void operator()(const f32x4 (&acc)[2][2][4][2], const Unit& u, int wr, int wc, int fr, int fq) const {
        const int row0 = u.pm * BM + wr * 64 + fr, col0 = u.pn * HALF + wc * 32 + 8 * fq;
#pragma unroll
        for (int ai = 0; ai < 2; ++ai)
#pragma unroll
            for (int m = 0; m < 4; ++m) { GAS bf16_t* rowp = O + (size_t)(row0 + ai * HALF + m * 16) * ldc + col0;
                f32x4 v0, v1;
#pragma unroll
                for (int e = 0; e < 4; ++e) { v0[e] = silu_mul(acc[ai][0][m][0][e], acc[ai][1][m][0][e]); v1[e] = silu_mul(acc[ai][0][m][1][e], acc[ai][1][m][1][e]); }
                EPI_STORE8(rowp, v0, v1); }
    }
};
struct EpiInProj {
    static constexpr bool PERM = true, AFTER_DRAIN = false;
    GAS bf16_t* Z; GAS float* SSP;
    __device__ __forceinline__ void operator()(const f32x4 (&acc)[2][2][4][2], const Unit& u, int wr, int wc, int fr, int fq) const {
        const int row0 = u.pm * BM + wr * 64 + fr;
#pragma unroll
        for (int bj = 0; bj < 2; ++bj) {
            const int G = 8 * u.pn + 4 * bj + wc, col0 = 32 * G;
            if (col0 >= 2592) continue;
            const float sc = (col0 >= 768 && col0 < 1024) ? 0.125f * LOG2E : 1.0f;
            const bool doss = (G >= 48 && G < 80); const int slot = G - 48;
#pragma unroll
            for (int ai = 0; ai < 2; ++ai)
#pragma unroll
                for (int m = 0; m < 4; ++m) { const int row = row0 + ai * HALF + m * 16;
                    const f32x4 v0 = acc[ai][bj][m][0] * sc, v1 = acc[ai][bj][m][1] * sc;
                    if (doss) { float s = (v0[0] * v0[0] + v0[1] * v0[1]) + (v0[2] * v0[2] + v0[3] * v0[3]) + (v1[0] * v1[0] + v1[1] * v1[1]) + (v1[2] * v1[2] + v1[3] * v1[3]);
                        s += __shfl_xor(s, 16); s += __shfl_xor(s, 32); if (fq == 0) SSP[(size_t)row * 32 + slot] = s; }
                    EPI_STORE8(Z + (size_t)row * 2592 + col0 + 8 * fq, v0, v1); }
        }
    }
};
struct EpiRowScale {
    static constexpr bool PERM = true, AFTER_DRAIN = false;
    GAS bf16_t* O; int ldo; const GAS float* SSP; int slot0, nslot4; float invn, extra; int kmap; PG8_LAS float* tab;
    __device__ __forceinline__ void operator()(const f32x4 (&acc)[2][2][4][2], const Unit& u, int wr, int wc, int fr, int fq) const {
        const int row0 = u.pm * BM + wr * 64 + fr;
        __builtin_amdgcn_s_barrier();
        { const int t = threadIdx.x; if (t < 256) { const GAS f32x4* sp = (const GAS f32x4*)(SSP + (size_t)(u.pm * BM + t) * 32 + slot0); float s = 0.f;
            for (int k = 0; k < nslot4; ++k) { const f32x4 v = sp[k]; s += (v[0] + v[1]) + (v[2] + v[3]); }
            tab[t] = __builtin_amdgcn_rsqf(s * invn + RMS_EPS) * extra; } }
        asm volatile("s_waitcnt lgkmcnt(0)" ::: "memory"); __builtin_amdgcn_s_barrier(); asm volatile("" ::: "memory");
#pragma unroll
        for (int ai = 0; ai < 2; ++ai)
#pragma unroll
            for (int m = 0; m < 4; ++m) { const float rs = tab[ai * HALF + wr * 64 + m * 16 + fr];
#pragma unroll
                for (int bj = 0; bj < 2; ++bj) { const int c0 = u.pn * BM + bj * HALF + wc * 32; const int dc = (kmap ? 96 * (c0 >> 6) + (c0 & 63) : c0) + 8 * fq;
                    const f32x4 v0 = acc[ai][bj][m][0] * rs, v1 = acc[ai][bj][m][1] * rs;
                    EPI_STORE8(O + (size_t)(row0 + ai * HALF + m * 16) * ldo + dc, v0, v1); } }
    }
};
struct EpiColScale {
    static constexpr bool PERM = true, AFTER_DRAIN = false;
    GAS bf16_t* O; int ldo; const GAS float* SSP; PG8_LAS float* tab;
    __device__ __forceinline__ void operator()(const f32x4 (&acc)[2][2][4][2], const Unit& u, int wr, int wc, int fr, int fq) const {
        const int row0 = u.pm * BM + wr * 64 + fr;
        __builtin_amdgcn_s_barrier();
        { const int t = threadIdx.x; if (t < 256) { const GAS f32x4* sp = (const GAS f32x4*)(SSP + (size_t)(u.pn * BM + t) * 32 + 24); const f32x4 a = sp[0], b = sp[1];
            tab[t] = __builtin_amdgcn_rsqf(((a[0] + a[1]) + (a[2] + a[3]) + (b[0] + b[1]) + (b[2] + b[3])) * (1.0f / 256.0f) + RMS_EPS); } }
        asm volatile("s_waitcnt lgkmcnt(0)" ::: "memory"); __builtin_amdgcn_s_barrier(); asm volatile("" ::: "memory");
#pragma unroll
        for (int bj = 0; bj < 2; ++bj) { const int cl = bj * HALF + wc * 32 + 8 * fq, c0 = u.pn * BM + cl;
            const f32x4 s0 = *(const PG8_LAS f32x4*)(tab + cl), s1 = *(const PG8_LAS f32x4*)(tab + cl + 4);
#pragma unroll
            for (int ai = 0; ai < 2; ++ai)
#pragma unroll
                for (int m = 0; m < 4; ++m) { const f32x4 v0 = acc[ai][bj][m][0] * s0, v1 = acc[ai][bj][m][1] * s1;
                    EPI_STORE8(O + (size_t)(row0 + ai * HALF + m * 16) * ldo + c0, v0, v1); } }
    }
};
template <class Epi, class Sched, bool ALIGN_EPI = false, bool SP2 = false>
__device__ __forceinline__ void gemm_phase(PG8_LAS unsigned char* lds, const Gemm g, const Sched& S, const Epi& E) {
    int tid_l = threadIdx.x; asm volatile("" : "+v"(tid_l)); const int tid = tid_l, wid = __builtin_amdgcn_readfirstlane(tid >> 6), lane = tid & 63, wr = wid >> 2, wc = wid & 3, fr = lane & 15, fq = lane >> 4;
    int K_l = g.K; asm volatile("" : "+s"(K_l)); const int K = K_l, nt = K / BK;
    unsigned voffA[2], voffB[2];
#pragma unroll
    for (int i = 0; i < 2; ++i) { int R, C; stage_rc(tid * 16 + i * 8192, R, C); const int Rb = Epi::PERM ? ((R & ~31) + perm32(R & 31)) : R;
        voffA[i] = (unsigned)(R * g.lda + C) * 2u; voffB[i] = (unsigned)(Rb * g.ldb + C) * 2u; }
    const size_t kstep = (size_t)(BK * 2);
    const size_t hstepA = (size_t)HALF * g.lda * 2, hstepB = (size_t)HALF * g.ldb * 2;
    const size_t tstepA = 2 * hstepA, tstepB = 2 * hstepB;
    const unsigned ldsw = (unsigned)wid * 1024u;
    const int aoff = lds_byte(wr * 64 + fr, fq * 8), boff = lds_byte(wc * 32 + fr, fq * 8);
#define PG8_SA(b, h) (((b) * 2 + (h)) * HTB)
#define PG8_SB(b, h) ((4 + (b) * 2 + (h)) * HTB)
#define PG8_STAGE(bufoff, gbase, voff) do { _Pragma("unroll") for (int _i = 0; _i < 2; ++_i) \
        __builtin_amdgcn_global_load_lds((const unsigned*)((const char*)(gbase) + (voff)[_i]), (PG8_LAS unsigned*)(lds + (bufoff) + ldsw + _i * 8192), 16, 0, 0); } while (0)
#define PG8_LDA(dst, b, h) do { _Pragma("unroll") for (int m = 0; m < 4; ++m) _Pragma("unroll") for (int k = 0; k < 2; ++k) dst[m][k] = *(const PG8_LAS bf16x8*)(lds + PG8_SA(b, h) + aoff + m * 2048 + k * 1024); } while (0)
#define PG8_LDB(dst, b, h) do { _Pragma("unroll") for (int n = 0; n < 2; ++n) _Pragma("unroll") for (int k = 0; k < 2; ++k) dst[n][k] = *(const PG8_LAS bf16x8*)(lds + PG8_SB(b, h) + boff + n * 2048 + k * 1024); } while (0)
#define PG8_MMA(ai, bj, At, Bt) do { __builtin_amdgcn_s_setprio(1); _Pragma("unroll") for (int m = 0; m < 4; ++m) _Pragma("unroll") for (int n = 0; n < 2; ++n) _Pragma("unroll") for (int k = 0; k < 2; ++k) \
        acc[ai][bj][m][n] = __builtin_amdgcn_mfma_f32_16x16x32_bf16(Bt[n][k], At[m][k], acc[ai][bj][m][n], 0, 0, 0); __builtin_amdgcn_s_setprio(0); } while (0)
#define PG8_WAIT_V(n) asm volatile("s_waitcnt vmcnt(" #n ")" ::: "memory")
#define PG8_WAIT_L(n) asm volatile("s_waitcnt lgkmcnt(" #n ")" ::: "memory")
#define PG8_BAR __builtin_amdgcn_s_barrier()
#define PG8_SCHED __builtin_amdgcn_sched_barrier(0)
    Unit cur, nxt; int ui = 0;
    if (!S.next(0, cur)) return;
    f32x4 acc[2][2][4][2];
#pragma unroll
    for (int a = 0; a < 2; ++a)
#pragma unroll
        for (int b = 0; b < 2; ++b)
#pragma unroll
            for (int m = 0; m < 4; ++m)
#pragma unroll
                for (int n = 0; n < 2; ++n) acc[a][b][m][n] = (f32x4){0.f, 0.f, 0.f, 0.f};
    bf16x8 At[4][2], B0[2][2], B1[2][2];
    const char* cA = (const char*)g.A + (size_t)cur.pm * tstepA; const char* cB = (const char*)g.Bt + (size_t)cur.pn * tstepB;
    S.a_ready(cur);
    if constexpr (SP2) {
        PG8_STAGE(PG8_SB(0, 0), cB, voffB); PG8_STAGE(PG8_SB(0, 1), cB + hstepB, voffB); PG8_STAGE(PG8_SA(0, 0), cA, voffA); PG8_STAGE(PG8_SA(0, 1), cA + hstepA, voffA);
        if (wr == 1) PG8_BAR;
        PG8_WAIT_V(2); PG8_BAR;
        PG8_STAGE(PG8_SB(1, 0), cB + kstep, voffB); PG8_STAGE(PG8_SA(1, 0), cA + kstep, voffA); PG8_STAGE(PG8_SB(1, 1), cB + hstepB + kstep, voffB);
        PG8_WAIT_V(6); PG8_BAR;
    } else {
        PG8_STAGE(PG8_SB(0, 0), cB, voffB); PG8_STAGE(PG8_SA(0, 0), cA, voffA); PG8_STAGE(PG8_SB(0, 1), cB + hstepB, voffB); PG8_STAGE(PG8_SA(0, 1), cA + hstepA, voffA);
        if (wr == 1) PG8_BAR;
        PG8_WAIT_V(4); PG8_BAR;
        PG8_STAGE(PG8_SB(1, 0), cB + kstep, voffB); PG8_STAGE(PG8_SA(1, 0), cA + kstep, voffA); PG8_STAGE(PG8_SB(1, 1), cB + hstepB + kstep, voffB);
        PG8_WAIT_V(6); PG8_BAR;
    }
    for (;;) {
        const bool has_next = S.next(ui + 1, nxt);
        const char* nA = has_next ? (const char*)g.A + (size_t)nxt.pm * tstepA : cA; const char* nB = has_next ? (const char*)g.Bt + (size_t)nxt.pn * tstepB : cB;
        for (int t = 0; t < nt; t += 2) {
            const bool last = (t == nt - 2);
            const char* a1 = cA + (size_t)(t + 1) * kstep;
            const char* a2 = last ? nA : cA + (size_t)(t + 2) * kstep; const char* b2 = last ? nB : cB + (size_t)(t + 2) * kstep;
            const char* a3 = a2 + kstep; const char* b3 = b2 + kstep;
            if (last && has_next) S.a_ready(nxt);
            if constexpr (SP2) {
            PG8_LDB(B0, 0, 0); PG8_LDB(B1, 0, 1); PG8_SCHED; PG8_LDA(At, 0, 0); PG8_STAGE(PG8_SA(1, 1), a1 + hstepA, voffA);
            PG8_WAIT_V(8); PG8_WAIT_L(0); PG8_BAR; PG8_MMA(0, 0, At, B0); PG8_MMA(0, 1, At, B1); PG8_BAR; PG8_SCHED;
            PG8_LDA(At, 0, 1); PG8_STAGE(PG8_SB(0, 0), b2, voffB); PG8_STAGE(PG8_SB(0, 1), b2 + hstepB, voffB); PG8_STAGE(PG8_SA(0, 0), a2, voffA);
            PG8_WAIT_V(8); PG8_WAIT_L(0); PG8_BAR; PG8_MMA(1, 0, At, B0); PG8_MMA(1, 1, At, B1); PG8_BAR; PG8_SCHED;
            PG8_LDB(B0, 1, 0); PG8_LDB(B1, 1, 1); PG8_SCHED; PG8_LDA(At, 1, 0); PG8_STAGE(PG8_SA(0, 1), a2 + hstepA, voffA);
            PG8_WAIT_V(8); PG8_WAIT_L(0); PG8_BAR; PG8_MMA(0, 0, At, B0); PG8_MMA(0, 1, At, B1); PG8_BAR; PG8_SCHED;
            PG8_LDA(At, 1, 1); PG8_STAGE(PG8_SB(1, 0), b3, voffB); PG8_STAGE(PG8_SB(1, 1), b3 + hstepB, voffB); PG8_STAGE(PG8_SA(1, 0), a3, voffA);
            PG8_WAIT_V(8); PG8_WAIT_L(0); PG8_BAR; PG8_MMA(1, 0, At, B0); PG8_MMA(1, 1, At, B1); PG8_BAR; PG8_SCHED;
            } else {
            PG8_LDB(B0, 0, 0); PG8_SCHED; PG8_LDA(At, 0, 0); PG8_STAGE(PG8_SA(1, 1), a1 + hstepA, voffA);
            PG8_WAIT_L(8); PG8_BAR; PG8_WAIT_L(0); PG8_MMA(0, 0, At, B0); PG8_BAR; PG8_SCHED;
            PG8_LDB(B1, 0, 1); PG8_STAGE(PG8_SB(0, 0), b2, voffB);
            PG8_BAR; PG8_WAIT_L(0); PG8_MMA(0, 1, At, B1); PG8_BAR;
            PG8_LDA(At, 0, 1); PG8_STAGE(PG8_SA(0, 0), a2, voffA);
            PG8_BAR; PG8_WAIT_L(0); PG8_MMA(1, 0, At, B0); PG8_BAR; PG8_SCHED;
            PG8_STAGE(PG8_SB(0, 1), b2 + hstepB, voffB);
            PG8_WAIT_V(6); PG8_BAR; PG8_MMA(1, 1, At, B1); PG8_BAR;
            PG8_LDB(B0, 1, 0); PG8_SCHED; PG8_LDA(At, 1, 0); PG8_STAGE(PG8_SA(0, 1), a2 + hstepA, voffA);
            PG8_WAIT_L(8); PG8_BAR; PG8_WAIT_L(0); PG8_MMA(0, 0, At, B0); PG8_BAR; PG8_SCHED;
            PG8_LDB(B1, 1, 1); PG8_STAGE(PG8_SB(1, 0), b3, voffB);
            PG8_BAR; PG8_WAIT_L(0); PG8_MMA(0, 1, At, B1); PG8_BAR;
            PG8_LDA(At, 1, 1); PG8_STAGE(PG8_SA(1, 0), a3, voffA);
            PG8_BAR; PG8_WAIT_L(0); PG8_MMA(1, 0, At, B0); PG8_BAR; PG8_SCHED;
            PG8_STAGE(PG8_SB(1, 1), b3 + hstepB, voffB);
            PG8_WAIT_V(6); PG8_BAR; PG8_MMA(1, 1, At, B1); PG8_BAR;
            }
        }
        if constexpr (ALIGN_EPI) { if (wr == 0) PG8_BAR; }
        if constexpr (!Epi::AFTER_DRAIN) { E(acc, cur, wr, wc, fr, fq); S.done(cur); }
        if (!has_next) break;
#pragma unroll
        for (int a = 0; a < 2; ++a)
#pragma unroll
            for (int b = 0; b < 2; ++b)
#pragma unroll
                for (int m = 0; m < 4; ++m)
#pragma unroll
                    for (int n = 0; n < 2; ++n) acc[a][b][m][n] = (f32x4){0.f, 0.f, 0.f, 0.f};
        cur = nxt; cA = nA; cB = nB; ++ui;
        if constexpr (ALIGN_EPI) { if (wr == 1) PG8_BAR; }
    }
    PG8_WAIT_V(0);
    if constexpr (!ALIGN_EPI) { if (wr == 0) PG8_BAR; }
    PG8_BAR;
    if constexpr (Epi::AFTER_DRAIN) { E.fused(acc, cur, wr, wc, fr, fq, lds, wid, lane); S.done(cur); }
#undef PG8_SA
#undef PG8_SB
#undef PG8_STAGE
#undef PG8_LDA
#undef PG8_LDB
#undef PG8_MMA
#undef PG8_WAIT_V
#undef PG8_WAIT_L
#undef PG8_BAR
#undef PG8_SCHED
}
}
#define LAS __attribute__((address_space(3)))
typedef unsigned short bf16;
typedef unsigned u32x4 __attribute__((ext_vector_type(4)));
typedef unsigned u32x2 __attribute__((ext_vector_type(2)));
typedef float f32x4 __attribute__((ext_vector_type(4)));
typedef float f32x16 __attribute__((ext_vector_type(16)));
typedef short bf16x8 __attribute__((ext_vector_type(8)));
typedef short s16x4 __attribute__((ext_vector_type(4)));
using pg8::cvt_pk_bf16; using pg8::LOG2E; using pg8::RMS_EPS;

constexpr int NWAVES = 8, NTHR = 512;
constexpr int DM = 1024, FF = 2816, ZP = 2592, NINP = 2816, DEPTH = 4;
constexpr int MP = 67072;
constexpr int G0_ROWS = 33792, G1_ROWS = 33280;
constexpr size_t MiB = 1u << 20;
constexpr size_t WS_CTL = 0, WS_ROPE = 1 * MiB, WS_SSP = 2 * MiB, WS_METAH = 11 * MiB, WS_W = 13 * MiB, WS_XY = 61 * MiB, WS_BIG = 192 * MiB, WS_END = 553 * MiB;
constexpr size_t W_GU1 = 0, W_DN1 = 11 * MiB, W_GU2 = 33 * MiB / 2, W_DN2 = 55 * MiB / 2, W_IN = 33 * MiB, W_UQ = 77 * MiB / 2, W_UK = 40 * MiB, W_UV = 40 * MiB + MiB / 4, W_O = 40 * MiB + MiB / 2;
constexpr size_t B_Z = 0, B_K = 168 * MiB, B_VT = 218 * MiB, B_YC = 251 * MiB;
constexpr int LDS_BYTES = 147456;
constexpr int A_K = 0, A_KBUF = 64 * 208, A_V = 2 * A_KBUF, A_VBUF = 64 * 144, A_WSF = A_V + 2 * A_VBUF, A_STG = A_WSF + 8 * 256, A_TAB = A_STG + 8 * 4096, A_UW = A_TAB + 4 * 640 * 4 + 256;
static_assert(A_UW + 64 <= 131072, "attention LDS");

struct Args { const float* in[25]; float* out; unsigned char* ws; };
typedef const __attribute__((address_space(4))) Args KArgs;
typedef KArgs* KArgsP;
enum { I_XP = 0, I_XS, I_META, I_F1PRE, I_F1GU, I_F1DN, I_F1POST, I_MPRE, I_WIN, I_CONVW, I_RPB, I_MB, I_QN, I_WUQ, I_KVN, I_WUKV, I_CON, I_NON, I_MON, I_WO, I_MPOST, I_F2PRE, I_F2GU, I_F2DN, I_F2POST };

__device__ __forceinline__ float bf2f(unsigned short b) { return __uint_as_float((unsigned)b << 16); }
__device__ __forceinline__ float bflo(unsigned w) { return __uint_as_float(w << 16); }
__device__ __forceinline__ float bfhi(unsigned w) { return __uint_as_float(w & 0xffff0000u); }
__device__ __forceinline__ float wave_sum(float v) {
#pragma unroll
    for (int o = 1; o < 64; o <<= 1) v += __shfl_xor(v, o);
    return v;
}
__device__ __forceinline__ void row_decode(int row, int& s, int& i, int& T) {
    if (row < G0_ROWS) { s = row / 2112; i = row - s * 2112; T = 2048; } else { const int r = row - G0_ROWS, q = r / 4160; s = 16 + q; i = r - q * 4160; T = 4096; }
}
__device__ __forceinline__ GAS float* hptr(GAS float* out, GAS float* metah, int s, int i, int T) {
    if (i < T) { const size_t ob = s < 16 ? (size_t)s * 2048 : (size_t)32768 + (size_t)(s - 16) * 4096; return out + (ob + i) * DM; }
    return metah + (size_t)(s * 16 + (i - T)) * DM;
}
__device__ __forceinline__ void wt_item(const GAS float* W, int ldw, int K, GAS bf16* WT, const GAS float* gain, int k0, int srcn0, int dstn0, LAS float* scr, int lane) {
    const int c = lane & 7;
    if (srcn0 < 0) {
#pragma unroll
        for (int j = 0; j < 4; ++j) { const int n = (lane >> 3) + 8 * j; *(GAS u32x4*)(WT + (size_t)(dstn0 + n) * K + k0 + 8 * c) = (u32x4){0u, 0u, 0u, 0u}; }
        return;
    }
#pragma unroll 8
    for (int i = 0; i < 32; ++i) { const int kk = 2 * i + (lane >> 5); float v = W[(size_t)(k0 + kk) * ldw + srcn0 + (lane & 31)]; if (gain) v *= gain[k0 + kk]; scr[kk * 33 + (lane & 31)] = v; }
    asm volatile("s_waitcnt lgkmcnt(0)" ::: "memory");
#pragma unroll
    for (int j = 0; j < 4; ++j) { const int n = (lane >> 3) + 8 * j; const LAS float* s = scr + (8 * c) * 33 + n;
        u32x4 o; o.x = cvt_pk_bf16(s[0 * 33], s[1 * 33]); o.y = cvt_pk_bf16(s[2 * 33], s[3 * 33]); o.z = cvt_pk_bf16(s[4 * 33], s[5 * 33]); o.w = cvt_pk_bf16(s[6 * 33], s[7 * 33]);
        *(GAS u32x4*)(WT + (size_t)(dstn0 + n) * K + k0 + 8 * c) = o; }
    asm volatile("s_waitcnt lgkmcnt(0)" ::: "memory");
}
__device__ __forceinline__ void convert_layer(KArgsP ap, int l, LAS float* scr, int gw, int NGW, int lane) {
    const KArgs& a = *ap;
    GAS unsigned char* wb = (GAS unsigned char*)(a.ws + WS_W);
    constexpr int N_GU = 16 * 176, N_DN = 44 * 32, N_IN = 16 * 88, N_UQ = 12 * 24, N_UK = 4 * 16, N_WO = 16 * 32;
    constexpr int TOT = 2 * N_GU + 2 * N_DN + N_IN + N_UQ + 2 * N_UK + N_WO;
    for (int it = gw; it < TOT; it += NGW) {
        int r = it;
        if (r < 2 * N_GU) { const int f = r / N_GU; r -= f * N_GU; const int kb = r / 176, nb = r % 176; const int sb = ((nb >> 2) & 1) * 88 + 4 * (nb >> 3) + (nb & 3);
            wt_item((const GAS float*)a.in[f ? I_F2GU : I_F1GU] + (size_t)l * 1024 * 5632, 5632, 1024, (GAS bf16*)(wb + (f ? W_GU2 : W_GU1)), (const GAS float*)a.in[f ? I_F2PRE : I_F1PRE] + l * 1024, 64 * kb, 32 * sb, 32 * nb, scr, lane); continue; }
        r -= 2 * N_GU;
        if (r < 2 * N_DN) { const int f = r / N_DN; r -= f * N_DN; const int kb = r / 32, nb = r % 32;
            wt_item((const GAS float*)a.in[f ? I_F2DN : I_F1DN] + (size_t)l * 2816 * 1024, 1024, 2816, (GAS bf16*)(wb + (f ? W_DN2 : W_DN1)), nullptr, 64 * kb, 32 * nb, 32 * nb, scr, lane); continue; }
        r -= 2 * N_DN;
        if (r < N_IN) { const int kb = r / 88, nb = r % 88;
            wt_item((const GAS float*)a.in[I_WIN] + (size_t)l * 1024 * 2592, 2592, 1024, (GAS bf16*)(wb + W_IN), (const GAS float*)a.in[I_MPRE] + l * 1024, 64 * kb, nb < 81 ? 32 * nb : -1, 32 * nb, scr, lane); continue; }
        r -= N_IN;
        if (r < N_UQ) { const int kb = r / 24, nb = r % 24;
            wt_item((const GAS float*)a.in[I_WUQ] + (size_t)l * 768 * 768, 768, 768, (GAS bf16*)(wb + W_UQ), (const GAS float*)a.in[I_QN] + l * 768, 64 * kb, 32 * nb, 32 * nb, scr, lane); continue; }
        r -= N_UQ;
        if (r < 2 * N_UK) { const int v = r / N_UK; r -= v * N_UK; const int kb = r / 16, nb = r % 16; const int sb = (nb >> 1) * 4 + 2 * v + (nb & 1);
            wt_item((const GAS float*)a.in[I_WUKV] + (size_t)l * 256 * 1024, 1024, 256, (GAS bf16*)(wb + (v ? W_UV : W_UK)), (const GAS float*)a.in[I_KVN] + l * 256, 64 * kb, 32 * sb, 32 * nb, scr, lane); continue; }
        r -= 2 * N_UK;
        { const int kb = r / 32, nb = r % 32; const int k0 = 64 * kb;
            const GAS float* gain = k0 < 256 ? (const GAS float*)a.in[I_CON] + l * 256 : (k0 < 512 ? (const GAS float*)a.in[I_NON] + l * 256 - 256 : (const GAS float*)a.in[I_MON] + l * 512 - 512);
            wt_item((const GAS float*)a.in[I_WO] + (size_t)l * 1024 * 1024, 1024, 1024, (GAS bf16*)(wb + W_O), gain, k0, 32 * nb, 32 * nb, scr, lane); }
    }
}
__device__ __forceinline__ void rowpass(KArgsP ap, const GAS float* gpost, float coef, bool init, bool wxn, int gw, int NGW, int lane) {
    const KArgs& a = *ap;
    GAS float* metah = (GAS float*)(a.ws + WS_METAH); GAS bf16* XY = (GAS bf16*)(a.ws + WS_XY);
    for (int row = gw; row < MP; row += NGW) {
        int s, i, T; row_decode(row, s, i, T);
        GAS unsigned long long* xy8 = (GAS unsigned long long*)(XY + (size_t)row * DM) + lane;
        if (i >= T + 16) { if (wxn) {
#pragma unroll
                for (int j = 0; j < 4; ++j) xy8[64 * j] = 0ull; }
            continue; }
        GAS float* hp = hptr((GAS float*)a.out, metah, s, i, T);
        f32x4 h[4];
        if (init) {
            const GAS float* src = (i < T) ? (s < 16 ? (const GAS float*)a.in[I_XP] + ((size_t)s * 2048 + i) * DM : (const GAS float*)a.in[I_XS] + ((size_t)(s - 16) * 4096 + i) * DM) : (const GAS float*)a.in[I_META] + (size_t)(i - T) * DM;
#pragma unroll
            for (int j = 0; j < 4; ++j) h[j] = ((const GAS f32x4*)src)[lane + 64 * j];
        } else {
            f32x4 y[4]; float ss = 0.f;
#pragma unroll
            for (int j = 0; j < 4; ++j) { const unsigned long long w = xy8[64 * j]; const unsigned lo = (unsigned)w, hi = (unsigned)(w >> 32);
                y[j] = (f32x4){bflo(lo), bfhi(lo), bflo(hi), bfhi(hi)}; ss += (y[j][0] * y[j][0] + y[j][1] * y[j][1]) + (y[j][2] * y[j][2] + y[j][3] * y[j][3]); }
            ss = wave_sum(ss); const float ry = __builtin_amdgcn_rsqf(ss * (1.0f / DM) + RMS_EPS) * coef;
#pragma unroll
            for (int j = 0; j < 4; ++j) { const f32x4 g = ((const GAS f32x4*)gpost)[lane + 64 * j]; const f32x4 hh = ((const GAS f32x4*)hp)[lane + 64 * j]; h[j] = hh + y[j] * g * ry; }
        }
#pragma unroll
        for (int j = 0; j < 4; ++j) ((GAS f32x4*)hp)[lane + 64 * j] = h[j];
        if (wxn) {
            float s2 = 0.f;
#pragma unroll
            for (int j = 0; j < 4; ++j) s2 += (h[j][0] * h[j][0] + h[j][1] * h[j][1]) + (h[j][2] * h[j][2] + h[j][3] * h[j][3]);
            s2 = wave_sum(s2); const float rh = __builtin_amdgcn_rsqf(s2 * (1.0f / DM) + RMS_EPS);
#pragma unroll
            for (int j = 0; j < 4; ++j) { const f32x4 v = h[j] * rh; xy8[64 * j] = (unsigned long long)cvt_pk_bf16(v[0], v[1]) | ((unsigned long long)cvt_pk_bf16(v[2], v[3]) << 32); }
        }
    }
}
__device__ __forceinline__ void rope_table(GAS float* tab, int gt, int NGT) {
    for (int e = gt; e < 4112 * 16; e += NGT) { const int pos = e >> 4, j = e & 15; double f = 1.0; for (int k = 0; k < j; ++k) f *= 0.56234132519034907;
        double rev = (double)pos * f * 0.15915494309189535; rev -= __builtin_floor(rev); const float rv = (float)rev;
        tab[2 * e] = __builtin_amdgcn_cosf(rv); tab[2 * e + 1] = __builtin_amdgcn_sinf(rv); }
}
struct Grp { int row0, rows, T, Lp, nseq; };
__device__ __forceinline__ Grp grp_of(int g) { Grp r; if (g == 0) { r.row0 = 0; r.rows = G0_ROWS; r.T = 2048; r.Lp = 2112; r.nseq = 16; } else { r.row0 = G0_ROWS; r.rows = G1_ROWS; r.T = 4096; r.Lp = 4160; r.nseq = 8; } return r; }
__device__ __forceinline__ void conv_kpe_pass(KArgsP ap, int l, const Grp& G, int gw, int NGW, int lane) {
    const KArgs& a = *ap;
    const GAS bf16* Z = (const GAS bf16*)(a.ws + WS_BIG + B_Z); GAS bf16* KB = (GAS bf16*)(a.ws + WS_BIG + B_K); GAS bf16* YC = (GAS bf16*)(a.ws + WS_BIG + B_YC);
    const GAS float* cw = (const GAS float*)a.in[I_CONVW] + (size_t)l * 3 * 256; const GAS float* rope = (const GAS float*)(a.ws + WS_ROPE);
    const f32x4 w0 = ((const GAS f32x4*)cw)[lane], w1 = ((const GAS f32x4*)(cw + 256))[lane], w2 = ((const GAS f32x4*)(cw + 512))[lane];
    for (int gr = gw; gr < G.rows; gr += NGW) {
        const int sq = gr / G.Lp, i = gr - sq * G.Lp, T = G.T;
        GAS unsigned long long* yo = (GAS unsigned long long*)(YC + (size_t)gr * DM) + lane;
        if (i >= T + 16) { *yo = 0ull; if (lane < 16) {
#pragma unroll
                for (int h = 0; h < 8; ++h) { KB[(size_t)gr * 768 + 96 * h + 64 + lane] = 0; KB[(size_t)gr * 768 + 96 * h + 80 + lane] = 0; } }
            continue; }
        const int p = (i < T) ? 16 + i : i - T;
        const int il = (p == 0) ? -1 : ((p - 1 >= 16) ? p - 17 : T + p - 1), ir = (p == T + 15) ? -1 : ((p + 1 >= 16) ? p - 15 : T + p + 1);
        const GAS bf16* zr = Z + (size_t)gr * ZP;
        const unsigned long long cb = *((const GAS unsigned long long*)zr + lane);
        f32x4 pc, pl = {0.f, 0.f, 0.f, 0.f}, pr = {0.f, 0.f, 0.f, 0.f};
        { const unsigned long long c = *((const GAS unsigned long long*)(zr + 256) + lane), u = *((const GAS unsigned long long*)(zr + 512) + lane);
          pc = (f32x4){bflo((unsigned)c) * bflo((unsigned)u), bfhi((unsigned)c) * bfhi((unsigned)u), bflo((unsigned)(c >> 32)) * bflo((unsigned)(u >> 32)), bfhi((unsigned)(c >> 32)) * bfhi((unsigned)(u >> 32))}; }
        if (il >= 0) { const GAS bf16* z2 = Z + (size_t)(sq * G.Lp + il) * ZP; const unsigned long long c = *((const GAS unsigned long long*)(z2 + 256) + lane), u = *((const GAS unsigned long long*)(z2 + 512) + lane);
          pl = (f32x4){bflo((unsigned)c) * bflo((unsigned)u), bfhi((unsigned)c) * bfhi((unsigned)u), bflo((unsigned)(c >> 32)) * bflo((unsigned)(u >> 32)), bfhi((unsigned)(c >> 32)) * bfhi((unsigned)(u >> 32))}; }
        if (ir >= 0) { const GAS bf16* z2 = Z + (size_t)(sq * G.Lp + ir) * ZP; const unsigned long long c = *((const GAS unsigned long long*)(z2 + 256) + lane), u = *((const GAS unsigned long long*)(z2 + 512) + lane);
          pr = (f32x4){bflo((unsigned)c) * bflo((unsigned)u), bfhi((unsigned)c) * bfhi((unsigned)u), bflo((unsigned)(c >> 32)) * bflo((unsigned)(u >> 32)), bfhi((unsigned)(c >> 32)) * bfhi((unsigned)(u >> 32))}; }
        const f32x4 cbv = (f32x4){bflo((unsigned)cb), bfhi((unsigned)cb), bflo((unsigned)(cb >> 32)), bfhi((unsigned)(cb >> 32))};
        const f32x4 y = cbv * (w0 * pl + w1 * pc + w2 * pr);
        float ss = (y[0] * y[0] + y[1] * y[1]) + (y[2] * y[2] + y[3] * y[3]); ss = wave_sum(ss);
        const float rn = __builtin_amdgcn_rsqf(ss * (1.0f / 256.0f) + RMS_EPS); const f32x4 o = y * rn;
        *yo = (unsigned long long)cvt_pk_bf16(o[0], o[1]) | ((unsigned long long)cvt_pk_bf16(o[2], o[3]) << 32);
        if (lane < 16) { const float x1 = bf2f(zr[2560 + lane]), x2 = bf2f(zr[2576 + lane]); const float c = rope[(size_t)p * 32 + 2 * lane], s = rope[(size_t)p * 32 + 2 * lane + 1];
            const unsigned pk = cvt_pk_bf16(x1 * c - x2 * s, x1 * s + x2 * c); const bf16 o1 = (bf16)(pk & 0xffffu), o2 = (bf16)(pk >> 16);
#pragma unroll
            for (int h = 0; h < 8; ++h) { KB[(size_t)gr * 768 + 96 * h + 64 + lane] = o1; KB[(size_t)gr * 768 + 96 * h + 80 + lane] = o2; } }
    }
}
__device__ __forceinline__ void ynorm_pass(KArgsP ap, const Grp& G, int gw, int NGW, int lane) {
    const KArgs& a = *ap;
    GAS bf16* YC = (GAS bf16*)(a.ws + WS_BIG + B_YC);
    for (int gr = gw; gr < G.rows; gr += NGW) {
        const int sq = gr / G.Lp, i = gr - sq * G.Lp;
        GAS unsigned long long* p1 = (GAS unsigned long long*)(YC + (size_t)gr * DM + 256) + lane; GAS u32x4* p2 = (GAS u32x4*)(YC + (size_t)gr * DM + 512) + lane;
        if (i >= G.T + 16) { *p1 = 0ull; *p2 = (u32x4){0u, 0u, 0u, 0u}; continue; }
        const unsigned long long w = *p1; const u32x4 v = *p2;
        float y[4] = {bflo((unsigned)w), bfhi((unsigned)w), bflo((unsigned)(w >> 32)), bfhi((unsigned)(w >> 32))};
        float z[8] = {bflo(v.x), bfhi(v.x), bflo(v.y), bfhi(v.y), bflo(v.z), bfhi(v.z), bflo(v.w), bfhi(v.w)};
        float s1 = (y[0] * y[0] + y[1] * y[1]) + (y[2] * y[2] + y[3] * y[3]); float s2 = 0.f;
#pragma unroll
        for (int e = 0; e < 8; ++e) s2 += z[e] * z[e];
        s1 = wave_sum(s1); s2 = wave_sum(s2);
        const float r1 = __builtin_amdgcn_rsqf(s1 * (1.0f / 256.0f) + RMS_EPS), r2 = __builtin_amdgcn_rsqf(s2 * (1.0f / 512.0f) + RMS_EPS);
        *p1 = (unsigned long long)cvt_pk_bf16(y[0] * r1, y[1] * r1) | ((unsigned long long)cvt_pk_bf16(y[2] * r1, y[3] * r1) << 32);
        u32x4 o; o.x = cvt_pk_bf16(z[0] * r2, z[1] * r2); o.y = cvt_pk_bf16(z[2] * r2, z[3] * r2); o.z = cvt_pk_bf16(z[4] * r2, z[5] * r2); o.w = cvt_pk_bf16(z[6] * r2, z[7] * r2); *p2 = o;
    }
}
struct AttG { const GAS bf16 *Q, *K, *VT, *Z; GAS bf16* YC; const GAS float* rope; int rows, T, Lp; };
__device__ __forceinline__ int crow(int r, int hi) { return (r & 3) + 8 * (r >> 2) + 4 * hi; }
#define MFMA32(a, b, c) __builtin_amdgcn_mfma_f32_32x32x16_bf16((a), (b), (c), 0, 0, 0)
template <int MODE>
__device__ __forceinline__ void attn_unit(const AttG& P, int seq, int head, int qb, LAS unsigned char* lds, int tid, int wid, int lane) {
    constexpr int DQK = MODE == 0 ? 96 : 64, NDK = DQK / 16, KP = DQK * 2 + 16, VP = 144;
    const int r32 = lane & 31, hi = lane >> 5;
    const int T = P.T, Lp = P.Lp, nqbr = T >> 8; const bool metablk = (qb == nqbr);
    const int sbase = seq * Lp;
    const int qi = qb * 256 + wid * 32 + r32; const int qic = qi < Lp - 1 ? qi : Lp - 1;
    bf16x8 qr[NDK];
    { const GAS bf16* qsrc = MODE == 0 ? P.Q + (size_t)(sbase + qic) * 768 + 96 * head : P.Z + (size_t)(sbase + qic) * ZP + 768 + 64 * head;
#pragma unroll
      for (int d0 = 0; d0 < NDK; ++d0) qr[d0] = *(const GAS bf16x8*)(qsrc + 16 * d0 + 8 * hi); }
    if constexpr (MODE == 0) {
        const int pos = qic < T ? 16 + qic : (qic - T < 15 ? qic - T : 15);
        const GAS f32x4* rp = (const GAS f32x4*)(P.rope + (size_t)pos * 32 + 16 * hi);
#pragma unroll
        for (int e2 = 0; e2 < 4; ++e2) { const f32x4 cs = rp[e2];
#pragma unroll
            for (int q = 0; q < 2; ++q) { const int e = 2 * e2 + q; const float c = cs[2 * q], s = cs[2 * q + 1];
                const float x1 = bf2f((unsigned short)qr[4][e]), x2 = bf2f((unsigned short)qr[5][e]);
                const unsigned pk = cvt_pk_bf16(x1 * c - x2 * s, x1 * s + x2 * c); qr[4][e] = (short)(pk & 0xffffu); qr[5][e] = (short)(pk >> 16); } }
    }
    int nt, kr_lo = 0; const int rows_total = T >> 6;
    int na_r = 0, na_c = 0, na_rs = 0, na_cs = 0;
    if constexpr (MODE == 0) nt = rows_total + 1;
    else {
        if (metablk) nt = 1;
        else { const int r0 = 4 * qb; int lo = r0 - 4; lo = lo < 0 ? 0 : (lo > rows_total - 8 ? rows_total - 8 : lo); int h2 = r0 - 1; h2 = h2 < 0 ? 0 : (h2 > rows_total - 8 ? rows_total - 8 : h2);
            kr_lo = lo; nt = (h2 + 7 - lo + 1) + 1; }
        na_r = 4 * qb + (wid >> 1); na_c = 32 * (wid & 1) + r32;
        na_rs = na_r - 4; na_rs = na_rs < 0 ? 0 : (na_rs > rows_total - 8 ? rows_total - 8 : na_rs);
        na_cs = na_c - 8; na_cs = na_cs < 0 ? 0 : (na_cs > 48 ? 48 : na_cs);
    }
    const LAS float* tabL = (const LAS float*)(lds + A_TAB) + head * 640 + 64;
    const LAS float* mbL = (const LAS float*)(lds + A_TAB + 4 * 640 * 4) + head * 16;
    LAS float* wsf = (LAS float*)(lds + A_WSF) + wid * 64;
    u32x4 kst0, kst1 = {0u, 0u, 0u, 0u}, vst;
    const int kc0 = tid, kc1 = 512 + tid;
#define TILE_KB(t) ((t) == nt - 1 ? T : 64 * (kr_lo + (t)))
#define GLOAD(t) do { const int kb_ = TILE_KB(t); \
      if constexpr (MODE == 0) { { const int krow = kc0 / 12, part = kc0 % 12; kst0 = *(const GAS u32x4*)(P.K + (size_t)(sbase + kb_ + krow) * 768 + 96 * head + 8 * part); } \
          if (tid < 256) { const int krow = kc1 / 12, part = kc1 % 12; kst1 = *(const GAS u32x4*)(P.K + (size_t)(sbase + kb_ + krow) * 768 + 96 * head + 8 * part); } \
          { const int d = tid >> 3, part = tid & 7; vst = *(const GAS u32x4*)(P.VT + (size_t)(64 * head + d) * P.rows + sbase + kb_ + 8 * part); } } \
      else { const int krow = tid >> 3, part = tid & 7; const GAS bf16* zr_ = P.Z + (size_t)(sbase + kb_ + krow) * ZP + 64 * head + 8 * part; kst0 = *(const GAS u32x4*)(zr_ + 1024); vst = *(const GAS u32x4*)(zr_ + 1280); } } while (0)
#define LSTORE(buf) do { LAS unsigned char* Kb_ = lds + A_K + (buf) * A_KBUF; LAS unsigned char* Vb_ = lds + A_V + (buf) * A_VBUF; \
      if constexpr (MODE == 0) { { const int krow = kc0 / 12, part = kc0 % 12; *(LAS u32x4*)(Kb_ + krow * KP + part * 16) = kst0; } \
          if (tid < 256) { const int krow = kc1 / 12, part = kc1 % 12; *(LAS u32x4*)(Kb_ + krow * KP + part * 16) = kst1; } \
          { const int d = tid >> 3, part = tid & 7; *(LAS u32x4*)(Vb_ + d * VP + part * 16) = vst; } } \
      else { const int krow = tid >> 3, part = tid & 7; *(LAS u32x4*)(Kb_ + krow * KP + part * 16) = kst0; \
          LAS unsigned short* vt_ = (LAS unsigned short*)(Vb_ + (8 * part) * VP + krow * 2); \
          vt_[0 * (VP / 2)] = (unsigned short)(vst.x & 0xffffu); vt_[1 * (VP / 2)] = (unsigned short)(vst.x >> 16); vt_[2 * (VP / 2)] = (unsigned short)(vst.y & 0xffffu); vt_[3 * (VP / 2)] = (unsigned short)(vst.y >> 16); \
          vt_[4 * (VP / 2)] = (unsigned short)(vst.z & 0xffffu); vt_[5 * (VP / 2)] = (unsigned short)(vst.z >> 16); vt_[6 * (VP / 2)] = (unsigned short)(vst.w & 0xffffu); vt_[7 * (VP / 2)] = (unsigned short)(vst.w >> 16); } } while (0)
    GLOAD(0); LSTORE(0);
    __syncthreads();
    float m_cur = -1e30f, l_reg = 0.f;
    f32x16 o0, o1;
#pragma unroll
    for (int r = 0; r < 16; ++r) { o0[r] = 0.f; o1[r] = 0.f; }
    for (int t = 0; t < nt; ++t) {
        const int buf = t & 1; const bool more = (t + 1 < nt);
        if (more) GLOAD(t + 1);
        const bool is_meta = (t == nt - 1);
        bool active = true;
        if constexpr (MODE == 1) { if (!is_meta) { const int kr = kr_lo + t; active = (kr >= na_rs && kr <= na_rs + 7); } }
        if (active) {
            const LAS unsigned char* Kb = lds + A_K + buf * A_KBUF; const LAS unsigned char* Vb = lds + A_V + buf * A_VBUF;
            f32x16 p0, p1;
#pragma unroll
            for (int r = 0; r < 16; ++r) { p0[r] = 0.f; p1[r] = 0.f; }
#pragma unroll
            for (int d0 = 0; d0 < NDK; ++d0) {
                const bf16x8 k0 = *(const LAS bf16x8*)(Kb + r32 * KP + d0 * 32 + hi * 16);
                const bf16x8 k1 = *(const LAS bf16x8*)(Kb + (32 + r32) * KP + d0 * 32 + hi * 16);
                p0 = MFMA32(k0, qr[d0], p0); p1 = MFMA32(k1, qr[d0], p1);
            }
            if (is_meta) {
#pragma unroll
                for (int r = 0; r < 16; ++r) { const int kv = crow(r, hi); float b = 0.f; if constexpr (MODE == 1) b = mbL[kv & 15]; p0[r] = kv < 16 ? p0[r] + b : -INFINITY; p1[r] = -INFINITY; }
            } else if constexpr (MODE == 1) {
                const int kr = kr_lo + t; const LAS float* rp = tabL + (kr - na_r + 7) * 31 + (15 - na_c);
#pragma unroll
                for (int r = 0; r < 16; ++r) { const int kc = crow(r, hi);
                    p0[r] = (kc >= na_cs && kc < na_cs + 16) ? p0[r] + rp[kc] : -INFINITY;
                    p1[r] = (kc + 32 >= na_cs && kc + 32 < na_cs + 16) ? p1[r] + rp[kc + 32] : -INFINITY; }
            }
            float mx = fmaxf(p0[0], p1[0]);
#pragma unroll
            for (int r = 1; r < 16; ++r) mx = fmaxf(mx, fmaxf(p0[r], p1[r]));
            mx = fmaxf(mx, __shfl_xor(mx, 32));
            if (__any(mx > m_cur)) {
                const float m_new = fmaxf(m_cur, mx); const float alpha = __builtin_amdgcn_exp2f(m_cur - m_new); m_cur = m_new; l_reg *= alpha;
                if (hi == 0) wsf[r32] = alpha;
                asm volatile("s_waitcnt lgkmcnt(0)" ::: "memory");
#pragma unroll
                for (int j = 0; j < 4; ++j) { const f32x4 av = *(const LAS f32x4*)(wsf + 8 * j + 4 * hi);
#pragma unroll
                    for (int e = 0; e < 4; ++e) { o0[4 * j + e] *= av[e]; o1[4 * j + e] *= av[e]; } }
                asm volatile("s_waitcnt lgkmcnt(0)" ::: "memory");
            }
            float ls = 0.f;
#pragma unroll
            for (int r = 0; r < 16; ++r) { p0[r] = __builtin_amdgcn_exp2f(p0[r] - m_cur); p1[r] = __builtin_amdgcn_exp2f(p1[r] - m_cur); ls += p0[r] + p1[r]; }
            l_reg += ls;
            bf16x8 pa[4];
#pragma unroll
            for (int ks = 0; ks < 4; ++ks) { u32x4 w;
                if (ks < 2) { w.x = cvt_pk_bf16(p0[8 * ks + 0], p0[8 * ks + 1]); w.y = cvt_pk_bf16(p0[8 * ks + 2], p0[8 * ks + 3]); w.z = cvt_pk_bf16(p0[8 * ks + 4], p0[8 * ks + 5]); w.w = cvt_pk_bf16(p0[8 * ks + 6], p0[8 * ks + 7]); }
                else { const int b = 8 * (ks - 2); w.x = cvt_pk_bf16(p1[b + 0], p1[b + 1]); w.y = cvt_pk_bf16(p1[b + 2], p1[b + 3]); w.z = cvt_pk_bf16(p1[b + 4], p1[b + 5]); w.w = cvt_pk_bf16(p1[b + 6], p1[b + 7]); }
                pa[ks] = __builtin_bit_cast(bf16x8, w); }
#pragma unroll
            for (int ks = 0; ks < 4; ++ks) {
                const LAS unsigned char* vp0 = Vb + r32 * VP + (16 * ks + 4 * hi) * 2; const LAS unsigned char* vp1 = vp0 + 32 * VP;
                const s16x4 a0 = *(const LAS s16x4*)vp0, a1 = *(const LAS s16x4*)(vp0 + 16), b0 = *(const LAS s16x4*)vp1, b1 = *(const LAS s16x4*)(vp1 + 16);
                const bf16x8 v0 = (bf16x8){a0[0], a0[1], a0[2], a0[3], a1[0], a1[1], a1[2], a1[3]}, v1 = (bf16x8){b0[0], b0[1], b0[2], b0[3], b1[0], b1[1], b1[2], b1[3]};
                o0 = MFMA32(pa[ks], v0, o0); o1 = MFMA32(pa[ks], v1, o1);
            }
        }
        if (more) LSTORE(buf ^ 1);
        __syncthreads();
    }
#undef GLOAD
#undef LSTORE
#undef TILE_KB
    l_reg += __shfl_xor(l_reg, 32);
    if (hi == 0) wsf[32 + r32] = l_reg;
    asm volatile("s_waitcnt lgkmcnt(0)" ::: "memory");
    LAS unsigned short* stg = (LAS unsigned short*)(lds + A_STG) + wid * 2048;
#pragma unroll
    for (int j = 0; j < 4; ++j) { const f32x4 lv = *(const LAS f32x4*)(wsf + 32 + 8 * j + 4 * hi);
#pragma unroll
        for (int e = 0; e < 4; ++e) { const int r = 4 * j + e; const float rl = __builtin_amdgcn_rcpf(lv[e]); const int orow = crow(r, hi);
            const unsigned pk = cvt_pk_bf16(o0[r] * rl, o1[r] * rl); stg[orow * 64 + r32] = (unsigned short)(pk & 0xffffu); stg[orow * 64 + 32 + r32] = (unsigned short)(pk >> 16); } }
    asm volatile("s_waitcnt lgkmcnt(0)" ::: "memory");
    { const int coloff = (MODE == 0 ? 512 : 256) + 64 * head;
#pragma unroll
      for (int i = 0; i < 4; ++i) { const int row = i * 8 + (lane >> 3), ch = lane & 7; const u32x4 v = *(const LAS u32x4*)(stg + row * 64 + ch * 8);
          const int qrow = qb * 256 + wid * 32 + row; const bool valid = metablk ? (wid == 0 && row < 16) : true;
          if (valid) *(GAS u32x4*)(P.YC + (size_t)(sbase + qrow) * DM + coloff + ch * 8) = v; } }
    asm volatile("s_waitcnt lgkmcnt(0)" ::: "memory");
}
__device__ __forceinline__ void attn_phase(KArgsP ap, int l, const Grp& G, unsigned* ctr, LAS unsigned char* lds, int tid, int wid, int lane) {
    const KArgs& a = *ap;
    AttG P; P.Q = (const GAS bf16*)(a.ws + WS_XY) + (size_t)G.row0 * DM; P.K = (const GAS bf16*)(a.ws + WS_BIG + B_K); P.VT = (const GAS bf16*)(a.ws + WS_BIG + B_VT); P.Z = (const GAS bf16*)(a.ws + WS_BIG + B_Z);
    P.YC = (GAS bf16*)(a.ws + WS_BIG + B_YC); P.rope = (const GAS float*)(a.ws + WS_ROPE); P.rows = G.rows; P.T = G.T; P.Lp = G.Lp;
    { LAS float* tab = (LAS float*)(lds + A_TAB); const GAS float* rpb = (const GAS float*)a.in[I_RPB] + (size_t)l * 4 * 465; const GAS float* mb = (const GAS float*)a.in[I_MB] + (size_t)l * 64;
      for (int e = tid; e < 4 * 640; e += NTHR) { const int h = e / 640, j = e - h * 640 - 64; tab[e] = (j >= 0 && j < 465) ? rpb[h * 465 + j] * LOG2E : 0.f; }
      if (tid < 64) tab[4 * 640 + tid] = mb[tid] * LOG2E; }
    const int nqb = (G.T >> 8) + 1; const int nMLA = G.nseq * 8 * nqb, nNA = G.nseq * 4 * nqb, total = nMLA + nNA;
    LAS volatile unsigned* uw = (LAS volatile unsigned*)(lds + A_UW);
    for (;;) {
        __syncthreads();
        if (tid == 0) *uw = atomicAdd(ctr, 1u);
        __syncthreads();
        const int u = (int)*uw;
        if (u >= total) break;
        if (u < nMLA) { const int qb = u % nqb, r = u / nqb; attn_unit<0>(P, r >> 3, r & 7, qb, lds, tid, wid, lane); }
        else { const int v = u - nMLA; const int qb = v % nqb, r = v / nqb; attn_unit<1>(P, r >> 2, r & 3, qb, lds, tid, wid, lane); }
    }
}
#define XB_TMO      128
#define XB_XCNT(j)  (256  + 64 * (j))
#define XB_XSUB(j)  (1280 + 64 * (j))
#define XB_XGEN(j)  (2304 + 64 * (j))
#define XB_TOP      3328
#define XB_TOPGEN   3392
#define XCD_BAR_WORDS 3456
#define XB_SPIN_CAP (1u << 18)

__device__ __forceinline__ unsigned xb_ld(unsigned* p)              { return __hip_atomic_load(p, __ATOMIC_RELAXED, __HIP_MEMORY_SCOPE_AGENT); }
__device__ __forceinline__ unsigned xb_add(unsigned* p, unsigned v) { return __hip_atomic_fetch_add(p, v, __ATOMIC_RELAXED, __HIP_MEMORY_SCOPE_AGENT); }
__device__ __forceinline__ unsigned xb_xcc_id() { return (unsigned)__builtin_amdgcn_s_getreg((3 << 11) | 20) & 0xFu; }
#define XB_SPIN(cond, bar) do { unsigned _sp = 0; while (cond) { __builtin_amdgcn_s_sleep(1); \
    if ((++_sp & 255u) == 0u) { if (xb_ld(&(bar)[XB_TMO])) break; if (_sp > XB_SPIN_CAP) { atomicAdd(&(bar)[XB_TMO], 1u); break; } } } } while (0)

struct XcdBarrier {
    unsigned* bar; unsigned x;
    volatile LAS unsigned* st;
};

__device__ __forceinline__ XcdBarrier xcd_barrier_post(unsigned* bar, volatile LAS unsigned* st) {
    XcdBarrier b; b.bar = bar; b.x = xb_xcc_id(); b.st = st;
    if (threadIdx.x == 0) (void)xb_add(&bar[XB_XCNT(b.x)], 1u);
    return b;
}
__device__ __forceinline__ void xcd_barrier_complete(unsigned* bar, unsigned x, unsigned& nloc, unsigned& nx) {
    const unsigned G = gridDim.x * gridDim.y * gridDim.z;
    unsigned sum, cnt, mine, sp = 0u;
    for (;;) {
        sum = 0u; cnt = 0u; mine = 0u;
#pragma unroll
        for (unsigned j = 0; j < 16; ++j) { const unsigned c = xb_ld(&bar[XB_XCNT(j)]); sum += c; cnt += (c > 0u) ? 1u : 0u; mine = (j == x) ? c : mine; }
        if (sum == G) break;
        __builtin_amdgcn_s_sleep(1);
        if ((++sp & 255u) == 0u) { if (xb_ld(&bar[XB_TMO])) break; if (sp > XB_SPIN_CAP) { atomicAdd(&bar[XB_TMO], 1u); break; } }
    }
    nloc = mine > 0u ? mine : 1u; nx = cnt > 0u ? cnt : 1u;
}

__device__ __forceinline__ void xcd_barrier(const XcdBarrier& b) {
    asm volatile("s_waitcnt vmcnt(0)" ::: "memory");
    __syncthreads();
    if (threadIdx.x == 0) {
        unsigned* bar = b.bar;
        __builtin_amdgcn_s_waitcnt(0);
        unsigned nloc = b.st[0], nx = b.st[1];
        if (nloc == 0u) { xcd_barrier_complete(bar, b.x, nloc, nx); b.st[0] = nloc; b.st[1] = nx; }
        const unsigned old = xb_add(&bar[XB_XSUB(b.x)], 1u);
        const unsigned gen = old / nloc;
        if (old + 1u == (gen + 1u) * nloc) {
            __builtin_amdgcn_fence(__ATOMIC_RELEASE, "agent");
            asm volatile("s_waitcnt vmcnt(0)" ::: "memory");
            const unsigned og = xb_add(&bar[XB_TOP], 1u);
            const unsigned tg = og / nx;
            if (og + 1u == (tg + 1u) * nx) xb_add(&bar[XB_TOPGEN], 1u);
            else XB_SPIN(xb_ld(&bar[XB_TOPGEN]) == tg, bar);
            __builtin_amdgcn_fence(__ATOMIC_ACQUIRE, "agent");
            xb_add(&bar[XB_XGEN(b.x)], 1u);
            asm volatile("s_waitcnt vmcnt(0)" ::: "memory");
        } else {
            XB_SPIN(xb_ld(&bar[XB_XGEN(b.x)]) == gen, bar);
            __builtin_amdgcn_fence(__ATOMIC_ACQUIRE, "agent");
            asm volatile("s_waitcnt vmcnt(0)" ::: "memory");
        }
    }
    __syncthreads();
}

constexpr int CW_BAR = 1024;
#define XBAR() do { KArgsP A_ = KA(); XcdBarrier b_; b_.bar = (unsigned*)(A_->ws + WS_CTL) + CW_BAR; b_.x = xb_xcc_id(); b_.st = (volatile LAS unsigned*)(L + 133120); xcd_barrier(b_); } while (0)

#ifndef REP_GEMM
#define REP_GEMM 1
#endif
#ifndef REP_ATT
#define REP_ATT 1
#endif
#ifndef REP_FFN
#define REP_FFN 1
#endif
#define GEMM_CALL1(EpiT, gobj, sobj, eobj) pg8::gemm_phase<EpiT, pg8::StaticOrder, true, true>(L, gobj, sobj, eobj)
#define GEMM_CALL2(EpiT, gobj, sobj, eobj) do { GEMM_CALL1(EpiT, gobj, sobj, eobj); asm volatile("" ::: "memory"); GEMM_CALL1(EpiT, gobj, sobj, eobj); } while (0)
#if REP_FFN == 1
#define GEMM_CALL_F GEMM_CALL1
#else
#define GEMM_CALL_F GEMM_CALL2
#endif
#if REP_GEMM == 1
#define GEMM_CALL(EpiT, gobj, sobj, eobj) pg8::gemm_phase<EpiT, pg8::StaticOrder, true, true>(L, gobj, sobj, eobj)
#else
#define GEMM_CALL(EpiT, gobj, sobj, eobj) do { pg8::gemm_phase<EpiT, pg8::StaticOrder, true, true>(L, gobj, sobj, eobj); asm volatile("" ::: "memory"); pg8::gemm_phase<EpiT, pg8::StaticOrder, true, true>(L, gobj, sobj, eobj); } while (0)
#endif
#define KA() ({ KArgsP p_ = (KArgsP)__builtin_amdgcn_kernarg_segment_ptr(); asm volatile("" : "+s"(p_)); p_; })
__global__ void __launch_bounds__(NTHR, 2) mk_fwd(Args a_unused) {
    extern __shared__ __attribute__((aligned(16))) unsigned char lds_raw[];
    cg::grid_group grid = cg::this_grid();
    LAS unsigned char* L = (LAS unsigned char*)lds_raw;
#define TID ({ int t_ = (int)threadIdx.x; asm volatile("" : "+v"(t_)); t_; })
#define LANE (TID & 63)
#define WID (__builtin_amdgcn_readfirstlane(TID >> 6))
#define NG ((int)gridDim.x)
#define BX ((int)blockIdx.x)
#define GW (BX * NWAVES + WID)
#define NGW (NG * NWAVES)
#define SCR ((LAS float*)(L + WID * 8448))
    if (threadIdx.x < 2) ((volatile LAS unsigned*)(L + 133120))[threadIdx.x] = 0u;
    __syncthreads();
    { KArgsP A = KA(); (void)xcd_barrier_post((unsigned*)(A->ws + WS_CTL) + CW_BAR, (volatile LAS unsigned*)(L + 133120)); }
    { KArgsP A = KA(); rope_table((GAS float*)(A->ws + WS_ROPE), BX * NTHR + TID, NG * NTHR); }
    { KArgsP A = KA(); convert_layer(A, 0, SCR, GW, NGW, LANE); }
    { KArgsP A = KA(); rowpass(A, nullptr, 0.f, true, true, GW, NGW, LANE); }
    grid.sync();
    for (int st = 0; st < 3 * DEPTH; ++st) {
        const int l = st / 3, k = st - 3 * l;
        if (k != 1) {
            const int f = k >> 1;
            { KArgsP A = KA(); unsigned char* ws = A->ws; pg8::Gemm g{(const bf16*)(ws + WS_XY), (const bf16*)(ws + WS_W + (f ? W_GU2 : W_GU1)), MP, 2 * FF, DM, DM, DM}; pg8::StaticOrder S; S.init(MP, 2 * FF, NG, BX);
              pg8::EpiSwiGLU E{(GAS bf16*)(ws + WS_BIG), FF}; GEMM_CALL_F(pg8::EpiSwiGLU, g, S, E); }
            XBAR();
            { KArgsP A = KA(); unsigned char* ws = A->ws; pg8::Gemm g{(const bf16*)(ws + WS_BIG), (const bf16*)(ws + WS_W + (f ? W_DN2 : W_DN1)), MP, DM, FF, FF, FF}; pg8::StaticOrder S; S.init(MP, DM, NG, BX);
              pg8::EpiPlain E{(GAS bf16*)(ws + WS_XY), DM}; GEMM_CALL_F(pg8::EpiPlain, g, S, E); }
            XBAR();
            const bool last = (l == DEPTH - 1 && f == 1);
            { KArgsP A = KA(); rowpass(A, (const GAS float*)A->in[f ? I_F2POST : I_F1POST] + l * DM, 0.5f, false, !last, GW, NGW, LANE); }
            if (f == 1 && !last) { KArgsP A = KA(); convert_layer(A, l + 1, SCR, GW, NGW, LANE); }
            if (!last) XBAR();
        } else {
            for (int gi = 0; gi < 2; ++gi) {
                { KArgsP A = KA(); unsigned char* ws = A->ws; const Grp G = grp_of(gi);
                  pg8::Gemm g{(const bf16*)(ws + WS_XY) + (size_t)G.row0 * DM, (const bf16*)(ws + WS_W + W_IN), G.rows, NINP, DM, DM, DM}; pg8::StaticOrder S; S.init(G.rows, NINP, NG, BX);
                  pg8::EpiInProj E{(GAS bf16*)(ws + WS_BIG + B_Z), (GAS float*)(ws + WS_SSP) + (size_t)G.row0 * 32}; GEMM_CALL(pg8::EpiInProj, g, S, E); }
                XBAR();
                { KArgsP A = KA(); unsigned char* ws = A->ws; const Grp G = grp_of(gi);
                  pg8::Gemm g{(const bf16*)(ws + WS_BIG + B_Z) + 1536, (const bf16*)(ws + WS_W + W_UQ), G.rows, 768, 768, ZP, 768}; pg8::StaticOrder S; S.init(G.rows, 768, NG, BX);
                  pg8::EpiRowScale E{(GAS bf16*)(ws + WS_XY) + (size_t)G.row0 * DM, 768, (const GAS float*)(ws + WS_SSP) + (size_t)G.row0 * 32, 0, 6, 1.0f / 768.0f, 0.10206207261596575f * LOG2E, 0, (LAS float*)(L + 132096)}; GEMM_CALL(pg8::EpiRowScale, g, S, E); }
                { KArgsP A = KA(); unsigned char* ws = A->ws; const Grp G = grp_of(gi);
                  pg8::Gemm g{(const bf16*)(ws + WS_BIG + B_Z) + 2304, (const bf16*)(ws + WS_W + W_UK), G.rows, 512, 256, ZP, 256}; pg8::StaticOrder S; S.init(G.rows, 512, NG, BX, NG - 140 % NG);
                  pg8::EpiRowScale E{(GAS bf16*)(ws + WS_BIG + B_K), 768, (const GAS float*)(ws + WS_SSP) + (size_t)G.row0 * 32, 24, 2, 1.0f / 256.0f, 1.0f, 1, (LAS float*)(L + 132096)}; GEMM_CALL(pg8::EpiRowScale, g, S, E); }
                { KArgsP A = KA(); unsigned char* ws = A->ws; const Grp G = grp_of(gi);
                  pg8::Gemm g{(const bf16*)(ws + WS_W + W_UV), (const bf16*)(ws + WS_BIG + B_Z) + 2304, 512, G.rows, 256, 256, ZP}; pg8::StaticOrder S; S.init(512, G.rows, NG, BX, NG - 148 % NG);
                  pg8::EpiColScale E{(GAS bf16*)(ws + WS_BIG + B_VT), G.rows, (const GAS float*)(ws + WS_SSP) + (size_t)G.row0 * 32, (LAS float*)(L + 132096)}; GEMM_CALL(pg8::EpiColScale, g, S, E); }
                { KArgsP A = KA(); const Grp G = grp_of(gi); conv_kpe_pass(A, l, G, GW, NGW, LANE); }
                XBAR();
                { KArgsP A = KA(); const Grp G = grp_of(gi); for (int rep_ = 0; rep_ < REP_ATT; ++rep_) attn_phase(A, l, G, (unsigned*)(A->ws + WS_CTL) + 64 * (l * 2 + gi) + 32 * rep_, L, TID, WID, LANE); }
                XBAR();
                { KArgsP A = KA(); const Grp G = grp_of(gi); ynorm_pass(A, G, GW, NGW, LANE); }
                XBAR();
                { KArgsP A = KA(); unsigned char* ws = A->ws; const Grp G = grp_of(gi);
                  pg8::Gemm g{(const bf16*)(ws + WS_BIG + B_YC), (const bf16*)(ws + WS_W + W_O), G.rows, DM, DM, DM, DM}; pg8::StaticOrder S; S.init(G.rows, DM, NG, BX);
                  pg8::EpiPlain E{(GAS bf16*)(ws + WS_XY) + (size_t)G.row0 * DM, DM}; GEMM_CALL(pg8::EpiPlain, g, S, E); }
                XBAR();
            }
            { KArgsP A = KA(); rowpass(A, (const GAS float*)A->in[I_MPOST] + l * DM, 1.0f, false, true, GW, NGW, LANE); }
            XBAR();
        }
    }
}

extern "C" void kernel_launch(void* const* d_in, const int* in_sizes, int n_in, void* d_out, int out_size, void* d_ws, size_t ws_size, hipStream_t stream) {
    static int grid = 0;
    if (grid == 0) {
        if (n_in != 25 || ws_size < WS_END) { fprintf(stderr, "kernel_launch: need 25 inputs and %zu B of workspace (got %d, %zu)\n", (size_t)WS_END, n_in, ws_size); grid = -1; return; }
        int dev = 0, cus = 0, per_cu = 0;
        if (hipGetDevice(&dev) != hipSuccess || hipDeviceGetAttribute(&cus, hipDeviceAttributeMultiprocessorCount, dev) != hipSuccess) { grid = -1; return; }
        if (hipFuncSetAttribute((const void*)mk_fwd, hipFuncAttributeMaxDynamicSharedMemorySize, LDS_BYTES) != hipSuccess) { fprintf(stderr, "kernel_launch: hipFuncSetAttribute failed\n"); grid = -1; return; }
        if (hipOccupancyMaxActiveBlocksPerMultiprocessor(&per_cu, (const void*)mk_fwd, NTHR, LDS_BYTES) != hipSuccess || per_cu < 1) { fprintf(stderr, "kernel_launch: occupancy query says %d\n", per_cu); }
        (void)hipGetLastError();
        grid = cus;
    }
    if (grid < 0) return;
    if (hipMemsetAsync((char*)d_ws + WS_CTL, 0, 32768, stream) != hipSuccess) return;
    Args a{};
    for (int i = 0; i < 25; ++i) a.in[i] = (const float*)d_in[i];
    a.out = (float*)d_out; a.ws = (unsigned char*)d_ws;
    void* args[] = {&a};
    hipError_t e = hipLaunchCooperativeKernel((const void*)mk_fwd, dim3(grid), dim3(NTHR), args, LDS_BYTES, stream);
    if (e != hipSuccess) fprintf(stderr, "kernel_launch: cooperative launch failed: %s\n", hipGetErrorString(e));
}
```

```cpp
#include <hip/hip_runtime.h>
#include <hip/hip_cooperative_groups.h>
#include <cstdio>
#include <cstdint>
namespace cg = cooperative_groups;
#define GAS __attribute__((address_space(1)))
namespace pg8 {
#define PG8_LAS __attribute__((address_space(3)))
typedef unsigned short bf16_t;
typedef short bf16x8 __attribute__((ext_vector_type(8)));
typedef float f32x4 __attribute__((ext_vector_type(4)));
typedef unsigned u32x4 __attribute__((ext_vector_type(4)));
constexpr int BM = 256, BK = 64, HALF = 128, HTB = HALF * BK * 2  , STAGE_BYTES = 8 * HTB, NXCD = 8, WGM = 8;

__host__ __device__ __forceinline__ int lds_byte(int r, int c) { const int st = (r >> 4) * 2 + (c >> 5), rr = r & 15, cc = c & 31, ob = rr * 64 + cc * 2; return st * 1024 + (ob ^ (((ob >> 9) & 1) << 5)); }
__host__ __device__ __forceinline__ void stage_rc(int b, int& R, int& C) { const int st = b / 1024, sb = b % 1024, swz = sb ^ (((sb >> 9) & 1) << 5); R = (st >> 1) * 16 + swz / 64; C = (st & 1) * 32 + (swz % 64) / 2; }
__host__ __device__ __forceinline__ int perm32(int rho) { const int n = rho >> 4, i = rho & 15; return 8 * (i >> 2) + 4 * n + (i & 3); }

struct Unit { int pm, pn; };
struct Gemm { const bf16_t* A; const bf16_t* Bt; int M, N, K, lda, ldb; };

struct StaticOrder {
    int nM, nN, nwg, G, c;
    __host__ __device__ void init(int M, int N, int G_, int c_, int shift = 0) { nM = M / BM; nN = N / BM; nwg = nM * nN; G = G_; c = (c_ + shift) % G_; }
    __host__ __device__ bool next(int i, Unit& u) const {
        const long L = (long)i * G + c; if (L >= nwg) return false;
        int wgid = (int)L; { const int q = nwg / NXCD, r = nwg % NXCD, xcd = wgid % NXCD, off = wgid / NXCD; wgid = (xcd < r ? xcd * (q + 1) : r * (q + 1) + (xcd - r) * q) + off; }
        const int nig = WGM * nN, gid = wgid / nig, fm = gid * WGM, gsz = (nM - fm) < WGM ? (nM - fm) : WGM;
        u.pm = fm + ((wgid % nig) % gsz); u.pn = (wgid % nig) / gsz; return true;
    }
    __device__ __forceinline__ void a_ready(const Unit&) const {}
    __device__ __forceinline__ void done(const Unit&) const {}
};

__device__ __forceinline__ unsigned cvt_pk_bf16(float lo, float hi) { typedef float f2 __attribute__((ext_vector_type(2))); typedef __bf16 b2 __attribute__((ext_vector_type(2))); f2 v = {lo, hi}; b2 b = __builtin_convertvector(v, b2); return __builtin_bit_cast(unsigned, b); }
constexpr float LOG2E = 1.4426950408889634f;
constexpr float RMS_EPS = 1e-6f;
#define EPI_STORE8(ptr, v0, v1) do { u32x4 w_; w_.x = cvt_pk_bf16((v0)[0], (v0)[1]); w_.y = cvt_pk_bf16((v0)[2], (v0)[3]); w_.z = cvt_pk_bf16((v1)[0], (v1)[1]); w_.w = cvt_pk_bf16((v1)[2], (v1)[3]); *(GAS u32x4*)(ptr) = w_; } while (0)
struct EpiPlain {
    static constexpr bool PERM = true, AFTER_DRAIN = false;
    GAS bf16_t* O; int ldc;
    __device__ __forceinline__ void operator()(const f32x4 (&acc)[2][2][4][2], const Unit& u, int wr, int wc, int fr, int fq) const {
        const int row0 = u.pm * BM + wr * 64 + fr, col0 = u.pn * BM + wc * 32 + 8 * fq;
#pragma unroll
        for (int ai = 0; ai < 2; ++ai)
#pragma unroll
            for (int m = 0; m < 4; ++m) { GAS bf16_t* rowp = O + (size_t)(row0 + ai * HALF + m * 16) * ldc + col0;
#pragma unroll
                for (int bj = 0; bj < 2; ++bj) EPI_STORE8(rowp + bj * HALF, acc[ai][bj][m][0], acc[ai][bj][m][1]); }
    }
};
__device__ __forceinline__ float silu_mul(float g, float u) { return g * u * __builtin_amdgcn_rcpf(1.0f + __builtin_amdgcn_exp2f(-g * LOG2E)); }
struct EpiSwiGLU {
    static constexpr bool PERM = true, AFTER_DRAIN = false;
    GAS bf16_t* O; int ldc;
    __device__ __forceinline__ void operator()(const f32x4 (&acc)[2][2][4][2], const Unit& u, int wr, int wc, int fr, int fq) const {
        const int row0 = u.pm * BM + wr * 64 + fr, col0 = u.pn * HALF + wc * 32 + 8 * fq;
#pragma unroll
        for (int ai = 0; ai < 2; ++ai)
#pragma unroll
            for (int m = 0; m < 4; ++m) { GAS bf16_t* rowp = O + (size_t)(row0 + ai * HALF + m * 16) * ldc + col0;
                f32x4 v0, v1;
#pragma unroll
                for (int e = 0; e < 4; ++e) { v0[e] = silu_mul(acc[ai][0][m][0][e], acc[ai][1][m][0][e]); v1[e] = silu_mul(acc[ai][0][m][1][e], acc[ai][1][m][1][e]); }
                EPI_STORE8(rowp, v0, v1); }
    }
};
struct EpiInProj {
    static constexpr bool PERM = true, AFTER_DRAIN = false;
    GAS bf16_t* Z; GAS float* SSP;
    __device__ __forceinline__ void operator()(const f32x4 (&acc)[2][2][4][2], const Unit& u, int wr, int wc, int fr, int fq) const {
        const int row0 = u.pm * BM + wr * 64 + fr;
#pragma unroll
        for (int bj = 0; bj < 2; ++bj) {
            const int G = 8 * u.pn + 4 * bj + wc, col0 = 32 * G;
            if (col0 >= 2592) continue;
            const float sc = (col0 >= 768 && col0 < 1024) ? 0.125f * LOG2E : 1.0f;
            const bool doss = (G >= 48 && G < 80); const int slot = G - 48;
#pragma unroll
            for (int ai = 0; ai < 2; ++ai)
#pragma unroll
                for (int m = 0; m < 4; ++m) { const int row = row0 + ai * HALF + m * 16;
                    const f32x4 v0 = acc[ai][bj][m][0] * sc, v1 = acc[ai][bj][m][1] * sc;
                    if (doss) { float s = (v0[0] * v0[0] + v0[1] * v0[1]) + (v0[2] * v0[2] + v0[3] * v0[3]) + (v1[0] * v1[0] + v1[1] * v1[1]) + (v1[2] * v1[2] + v1[3] * v1[3]);
                        s += __shfl_xor(s, 16); s += __shfl_xor(s, 32); if (fq == 0) SSP[(size_t)row * 32 + slot] = s; }
                    EPI_STORE8(Z + (size_t)row * 2592 + col0 + 8 * fq, v0, v1); }
        }
    }
};
struct EpiRowScale {
    static constexpr bool PERM = true, AFTER_DRAIN = false;
    GAS bf16_t* O; int ldo; const GAS float* SSP; int slot0, nslot4; float invn, extra; int kmap; PG8_LAS float* tab;
    __device__ __forceinline__ void operator()(const f32x4 (&acc)[2][2][4][2], const Unit& u, int wr, int wc, int fr, int fq) const {
        const int row0 = u.pm * BM + wr * 64 + fr;
        __builtin_amdgcn_s_barrier();
        { const int t = threadIdx.x; if (t < 256) { const GAS f32x4* sp = (const GAS f32x4*)(SSP + (size_t)(u.pm * BM + t) * 32 + slot0); float s = 0.f;
            for (int k = 0; k < nslot4; ++k) { const f32x4 v = sp[k]; s += (v[0] + v[1]) + (v[2] + v[3]); }
            tab[t] = __builtin_amdgcn_rsqf(s * invn + RMS_EPS) * extra; } }
        asm volatile("s_waitcnt lgkmcnt(0)" ::: "memory"); __builtin_amdgcn_s_barrier(); asm volatile("" ::: "memory");
#pragma unroll
        for (int ai = 0; ai < 2; ++ai)
#pragma unroll
            for (int m = 0; m < 4; ++m) { const float rs = tab[ai * HALF + wr * 64 + m * 16 + fr];
#pragma unroll
                for (int bj = 0; bj < 2; ++bj) { const int c0 = u.pn * BM + bj * HALF + wc * 32; const int dc = (kmap ? 96 * (c0 >> 6) + (c0 & 63) : c0) + 8 * fq;
                    const f32x4 v0 = acc[ai][bj][m][0] * rs, v1 = acc[ai][bj][m][1] * rs;
                    EPI_STORE8(O + (size_t)(row0 + ai * HALF + m * 16) * ldo + dc, v0, v1); } }
    }
};
struct EpiColScale {
    static constexpr bool PERM = true, AFTER_DRAIN = false;
    GAS bf16_t* O; int ldo; const GAS float* SSP; PG8_LAS float* tab;
    __device__ __forceinline__ void operator()(const f32x4 (&acc)[2][2][4][2], const Unit& u, int wr, int wc, int fr, int fq) const {
        const int row0 = u.pm * BM + wr * 64 + fr;
        __builtin_amdgcn_s_barrier();
        { const int t = threadIdx.x; if (t < 256) { const GAS f32x4* sp = (const GAS f32x4*)(SSP + (size_t)(u.pn * BM + t) * 32 + 24); const f32x4 a = sp[0], b = sp[1];
            tab[t] = __builtin_amdgcn_rsqf(((a[0] + a[1]) + (a[2] + a[3]) + (b[0] + b[1]) + (b[2] + b[3])) * (1.0f / 256.0f) + RMS_EPS); } }
        asm volatile("s_waitcnt lgkmcnt(0)" ::: "memory"); __builtin_amdgcn_s_barrier(); asm volatile("" ::: "memory");
#pragma unroll
        for (int bj = 0; bj < 2; ++bj) { const int cl = bj * HALF + wc * 32 + 8 * fq, c0 = u.pn * BM + cl;
            const f32x4 s0 = *(const PG8_LAS f32x4*)(tab + cl), s1 = *(const PG8_LAS f32x4*)(tab + cl + 4);
#pragma unroll
            for (int ai = 0; ai < 2; ++ai)
#pragma unroll
                for (int m = 0; m < 4; ++m) { const f32x4 v0 = acc[ai][bj][m][0] * s0, v1 = acc[ai][bj][m][1] * s1;
                    EPI_STORE8(O + (size_t)(row0 + ai * HALF + m * 16) * ldo + c0, v0, v1); } }
    }
};
template <class Epi, class Sched, bool ALIGN_EPI = false, bool SP2 = false>
__device__ __forceinline__ void gemm_phase(PG8_LAS unsigned char* lds, const Gemm g, const Sched& S, const Epi& E) {
    int tid_l = threadIdx.x; asm volatile("" : "+v"(tid_l)); const int tid = tid_l, wid = __builtin_amdgcn_readfirstlane(tid >> 6), lane = tid & 63, wr = wid >> 2, wc = wid & 3, fr = lane & 15, fq = lane >> 4;
    int K_l = g.K; asm volatile("" : "+s"(K_l)); const int K = K_l, nt = K / BK;
    unsigned voffA[2], voffB[2];
#pragma unroll
    for (int i = 0; i < 2; ++i) { int R, C; stage_rc(tid * 16 + i * 8192, R, C); const int Rb = Epi::PERM ? ((R & ~31) + perm32(R & 31)) : R;
        voffA[i] = (unsigned)(R * g.lda + C) * 2u; voffB[i] = (unsigned)(Rb * g.ldb + C) * 2u; }
    const size_t kstep = (size_t)(BK * 2);
    const size_t hstepA = (size_t)HALF * g.lda * 2, hstepB = (size_t)HALF * g.ldb * 2;
    const size_t tstepA = 2 * hstepA, tstepB = 2 * hstepB;
    const unsigned ldsw = (unsigned)wid * 1024u;
    const int aoff = lds_byte(wr * 64 + fr, fq * 8), boff = lds_byte(wc * 32 + fr, fq * 8);
#define PG8_SA(b, h) (((b) * 2 + (h)) * HTB)
#define PG8_SB(b, h) ((4 + (b) * 2 + (h)) * HTB)
#define PG8_STAGE(bufoff, gbase, voff) do { _Pragma("unroll") for (int _i = 0; _i < 2; ++_i) \
        __builtin_amdgcn_global_load_lds((const unsigned*)((const char*)(gbase) + (voff)[_i]), (PG8_LAS unsigned*)(lds + (bufoff) + ldsw + _i * 8192), 16, 0, 0); } while (0)
#define PG8_LDA(dst, b, h) do { _Pragma("unroll") for (int m = 0; m < 4; ++m) _Pragma("unroll") for (int k = 0; k < 2; ++k) dst[m][k] = *(const PG8_LAS bf16x8*)(lds + PG8_SA(b, h) + aoff + m * 2048 + k * 1024); } while (0)
#define PG8_LDB(dst, b, h) do { _Pragma("unroll") for (int n = 0; n < 2; ++n) _Pragma("unroll") for (int k = 0; k < 2; ++k) dst[n][k] = *(const PG8_LAS bf16x8*)(lds + PG8_SB(b, h) + boff + n * 2048 + k * 1024); } while (0)
#define PG8_MMA(ai, bj, At, Bt) do { __builtin_amdgcn_s_setprio(1); _Pragma("unroll") for (int m = 0; m < 4; ++m) _Pragma("unroll") for (int n = 0; n < 2; ++n) _Pragma("unroll") for (int k = 0; k < 2; ++k) \
        acc[ai][bj][m][n] = __builtin_amdgcn_mfma_f32_16x16x32_bf16(Bt[n][k], At[m][k], acc[ai][bj][m][n], 0, 0, 0); __builtin_amdgcn_s_setprio(0); } while (0)
#define PG8_WAIT_V(n) asm volatile("s_waitcnt vmcnt(" #n ")" ::: "memory")
#define PG8_WAIT_L(n) asm volatile("s_waitcnt lgkmcnt(" #n ")" ::: "memory")
#define PG8_BAR __builtin_amdgcn_s_barrier()
#define PG8_SCHED __builtin_amdgcn_sched_barrier(0)
    Unit cur, nxt; int ui = 0;
    if (!S.next(0, cur)) return;
    f32x4 acc[2][2][4][2];
#pragma unroll
    for (int a = 0; a < 2; ++a)
#pragma unroll
        for (int b = 0; b < 2; ++b)
#pragma unroll
            for (int m = 0; m < 4; ++m)
#pragma unroll
                for (int n = 0; n < 2; ++n) acc[a][b][m][n] = (f32x4){0.f, 0.f, 0.f, 0.f};
    bf16x8 At[4][2], B0[2][2], B1[2][2];
    const char* cA = (const char*)g.A + (size_t)cur.pm * tstepA; const char* cB = (const char*)g.Bt + (size_t)cur.pn * tstepB;
    S.a_ready(cur);
    if constexpr (SP2) {
        PG8_STAGE(PG8_SB(0, 0), cB, voffB); PG8_STAGE(PG8_SB(0, 1), cB + hstepB, voffB); PG8_STAGE(PG8_SA(0, 0), cA, voffA); PG8_STAGE(PG8_SA(0, 1), cA + hstepA, voffA);
        if (wr == 1) PG8_BAR;
        PG8_WAIT_V(2); PG8_BAR;
        PG8_STAGE(PG8_SB(1, 0), cB + kstep, voffB); PG8_STAGE(PG8_SA(1, 0), cA + kstep, voffA); PG8_STAGE(PG8_SB(1, 1), cB + hstepB + kstep, voffB);
        PG8_WAIT_V(6); PG8_BAR;
    } else {
        PG8_STAGE(PG8_SB(0, 0), cB, voffB); PG8_STAGE(PG8_SA(0, 0), cA, voffA); PG8_STAGE(PG8_SB(0, 1), cB + hstepB, voffB); PG8_STAGE(PG8_SA(0, 1), cA + hstepA, voffA);
        if (wr == 1) PG8_BAR;
        PG8_WAIT_V(4); PG8_BAR;
        PG8_STAGE(PG8_SB(1, 0), cB + kstep, voffB); PG8_STAGE(PG8_SA(1, 0), cA + kstep, voffA); PG8_STAGE(PG8_SB(1, 1), cB + hstepB + kstep, voffB);
        PG8_WAIT_V(6); PG8_BAR;
    }
    for (;;) {
        const bool has_next = S.next(ui + 1, nxt);
        const char* nA = has_next ? (const char*)g.A + (size_t)nxt.pm * tstepA : cA; const char* nB = has_next ? (const char*)g.Bt + (size_t)nxt.pn * tstepB : cB;
        for (int t = 0; t < nt; t += 2) {
            const bool last = (t == nt - 2);
            const char* a1 = cA + (size_t)(t + 1) * kstep;
            const char* a2 = last ? nA : cA + (size_t)(t + 2) * kstep; const char* b2 = last ? nB : cB + (size_t)(t + 2) * kstep;
            const char* a3 = a2 + kstep; const char* b3 = b2 + kstep;
            if (last && has_next) S.a_ready(nxt);
            if constexpr (SP2) {
            PG8_LDB(B0, 0, 0); PG8_LDB(B1, 0, 1); PG8_SCHED; PG8_LDA(At, 0, 0); PG8_STAGE(PG8_SA(1, 1), a1 + hstepA, voffA);
            PG8_WAIT_V(8); PG8_WAIT_L(0); PG8_BAR; PG8_MMA(0, 0, At, B0); PG8_MMA(0, 1, At, B1); PG8_BAR; PG8_SCHED;
            PG8_LDA(At, 0, 1); PG8_STAGE(PG8_SB(0, 0), b2, voffB); PG8_STAGE(PG8_SB(0, 1), b2 + hstepB, voffB); PG8_STAGE(PG8_SA(0, 0), a2, voffA);
            PG8_WAIT_V(8); PG8_WAIT_L(0); PG8_BAR; PG8_MMA(1, 0, At, B0); PG8_MMA(1, 1, At, B1); PG8_BAR; PG8_SCHED;
            PG8_LDB(B0, 1, 0); PG8_LDB(B1, 1, 1); PG8_SCHED; PG8_LDA(At, 1, 0); PG8_STAGE(PG8_SA(0, 1), a2 + hstepA, voffA);
            PG8_WAIT_V(8); PG8_WAIT_L(0); PG8_BAR; PG8_MMA(0, 0, At, B0); PG8_MMA(0, 1, At, B1); PG8_BAR; PG8_SCHED;
            PG8_LDA(At, 1, 1); PG8_STAGE(PG8_SB(1, 0), b3, voffB); PG8_STAGE(PG8_SB(1, 1), b3 + hstepB, voffB); PG8_STAGE(PG8_SA(1, 0), a3, voffA);
            PG8_WAIT_V(8); PG8_WAIT_L(0); PG8_BAR; PG8_MMA(1, 0, At, B0); PG8_MMA(1, 1, At, B1); PG8_BAR; PG8_SCHED;
            } else {
            PG8_LDB(B0, 0, 0); PG8_SCHED; PG8_LDA(At, 0, 0); PG8_STAGE(PG8_SA(1, 1), a1 + hstepA, voffA);
            PG8_WAIT_L(8); PG8_BAR; PG8_WAIT_L(0); PG8_MMA(0, 0, At, B0); PG8_BAR; PG8_SCHED;
            PG8_LDB(B1, 0, 1); PG8_STAGE(PG8_SB(0, 0), b2, voffB);
            PG8_BAR; PG8_WAIT_L(0); PG8_MMA(0, 1, At, B1); PG8_BAR;
            PG8_LDA(At, 0, 1); PG8_STAGE(PG8_SA(0, 0), a2, voffA);
            PG8_BAR; PG8_WAIT_L(0); PG8_MMA(1, 0, At, B0); PG8_BAR; PG8_SCHED;
            PG8_STAGE(PG8_SB(0, 1), b2 + hstepB, voffB);
            PG8_WAIT_V(6); PG8_BAR; PG8_MMA(1, 1, At, B1); PG8_BAR;
            PG8_LDB(B0, 1, 0); PG8_SCHED; PG8_LDA(At, 1, 0); PG8_STAGE(PG8_SA(0, 1), a2 + hstepA, voffA);
            PG8_WAIT_L(8); PG8_BAR; PG8_WAIT_L(0); PG8_MMA(0, 0, At, B0); PG8_BAR; PG8_SCHED;
            PG8_LDB(B1, 1, 1); PG8_STAGE(PG8_SB(1, 0), b3, voffB);
            PG8_BAR; PG8_WAIT_L(0); PG8_MMA(0, 1, At, B1); PG8_BAR;
            PG8_LDA(At, 1, 1); PG8_STAGE(PG8_SA(1, 0), a3, voffA);
            PG8_BAR; PG8_WAIT_L(0); PG8_MMA(1, 0, At, B0); PG8_BAR; PG8_SCHED;
            PG8_STAGE(PG8_SB(1, 1), b3 + hstepB, voffB);
            PG8_WAIT_V(6); PG8_BAR; PG8_MMA(1, 1, At, B1); PG8_BAR;
            }
        }
        if constexpr (ALIGN_EPI) { if (wr == 0) PG8_BAR; }
        if constexpr (!Epi::AFTER_DRAIN) { E(acc, cur, wr, wc, fr, fq); S.done(cur); }
        if (!has_next) break;
#pragma unroll
        for (int a = 0; a < 2; ++a)
#pragma unroll
            for (int b = 0; b < 2; ++b)
#pragma unroll
                for (int m = 0; m < 4; ++m)
#pragma unroll
                    for (int n = 0; n < 2; ++n) acc[a][b][m][n] = (f32x4){0.f, 0.f, 0.f, 0.f};
        cur = nxt; cA = nA; cB = nB; ++ui;
        if constexpr (ALIGN_EPI) { if (wr == 1) PG8_BAR; }
    }
    PG8_WAIT_V(0);
    if constexpr (!ALIGN_EPI) { if (wr == 0) PG8_BAR; }
    PG8_BAR;
    if constexpr (Epi::AFTER_DRAIN) { E.fused(acc, cur, wr, wc, fr, fq, lds, wid, lane); S.done(cur); }
#undef PG8_SA
#undef PG8_SB
#undef PG8_STAGE
#undef PG8_LDA
#undef PG8_LDB
#undef PG8_MMA
#undef PG8_WAIT_V
#undef PG8_WAIT_L
#undef PG8_BAR
#undef PG8_SCHED
}
}
#define LAS __attribute__((address_space(3)))
typedef unsigned short bf16;
typedef unsigned u32x4 __attribute__((ext_vector_type(4)));
typedef unsigned u32x2 __attribute__((ext_vector_type(2)));
typedef float f32x4 __attribute__((ext_vector_type(4)));
typedef float f32x16 __attribute__((ext_vector_type(16)));
typedef short bf16x8 __attribute__((ext_vector_type(8)));
typedef short s16x4 __attribute__((ext_vector_type(4)));
using pg8::cvt_pk_bf16; using pg8::LOG2E; using pg8::RMS_EPS;

constexpr int NWAVES = 8, NTHR = 512;
constexpr int DM = 1024, FF = 2816, ZP = 2592, NINP = 2816, DEPTH = 4;
constexpr int MP = 67072;
constexpr int G0_ROWS = 33792, G1_ROWS = 33280;
constexpr size_t MiB = 1u << 20;
constexpr size_t WS_CTL = 0, WS_ROPE = 1 * MiB, WS_SSP = 2 * MiB, WS_METAH = 11 * MiB, WS_W = 13 * MiB, WS_XY = 61 * MiB, WS_BIG = 192 * MiB, WS_END = 553 * MiB;
constexpr size_t W_GU1 = 0, W_DN1 = 11 * MiB, W_GU2 = 33 * MiB / 2, W_DN2 = 55 * MiB / 2, W_IN = 33 * MiB, W_UQ = 77 * MiB / 2, W_UK = 40 * MiB, W_UV = 40 * MiB + MiB / 4, W_O = 40 * MiB + MiB / 2;
constexpr size_t B_Z = 0, B_K = 168 * MiB, B_VT = 218 * MiB, B_YC = 251 * MiB;
constexpr int LDS_BYTES = 147456;
constexpr int A_K = 0, A_KBUF = 64 * 208, A_V = 2 * A_KBUF, A_VBUF = 64 * 144, A_WSF = A_V + 2 * A_VBUF, A_STG = A_WSF + 8 * 256, A_TAB = A_STG + 8 * 4096, A_UW = A_TAB + 4 * 640 * 4 + 256;
static_assert(A_UW + 64 <= 131072, "attention LDS");

struct Args { const float* in[25]; float* out; unsigned char* ws; };
typedef const __attribute__((address_space(4))) Args KArgs;
typedef KArgs* KArgsP;
enum { I_XP = 0, I_XS, I_META, I_F1PRE, I_F1GU, I_F1DN, I_F1POST, I_MPRE, I_WIN, I_CONVW, I_RPB, I_MB, I_QN, I_WUQ, I_KVN, I_WUKV, I_CON, I_NON, I_MON, I_WO, I_MPOST, I_F2PRE, I_F2GU, I_F2DN, I_F2POST };

__device__ __forceinline__ float bf2f(unsigned short b) { return __uint_as_float((unsigned)b << 16); }
__device__ __forceinline__ float bflo(unsigned w) { return __uint_as_float(w << 16); }
__device__ __forceinline__ float bfhi(unsigned w) { return __uint_as_float(w & 0xffff0000u); }
__device__ __forceinline__ float wave_sum(float v) {
#pragma unroll
    for (int o = 1; o < 64; o <<= 1) v += __shfl_xor(v, o);
    return v;
}
__device__ __forceinline__ void row_decode(int row, int& s, int& i, int& T) {
    if (row < G0_ROWS) { s = row / 2112; i = row - s * 2112; T = 2048; } else { const int r = row - G0_ROWS, q = r / 4160; s = 16 + q; i = r - q * 4160; T = 4096; }
}
__device__ __forceinline__ GAS float* hptr(GAS float* out, GAS float* metah, int s, int i, int T) {
    if (i < T) { const size_t ob = s < 16 ? (size_t)s * 2048 : (size_t)32768 + (size_t)(s - 16) * 4096; return out + (ob + i) * DM; }
    return metah + (size_t)(s * 16 + (i - T)) * DM;
}
__device__ __forceinline__ void wt_item(const GAS float* W, int ldw, int K, GAS bf16* WT, const GAS float* gain, int k0, int srcn0, int dstn0, LAS float* scr, int lane) {
    const int c = lane & 7;
    if (srcn0 < 0) {
#pragma unroll
        for (int j = 0; j < 4; ++j) { const int n = (lane >> 3) + 8 * j; *(GAS u32x4*)(WT + (size_t)(dstn0 + n) * K + k0 + 8 * c) = (u32x4){0u, 0u, 0u, 0u}; }
        return;
    }
#pragma unroll 8
    for (int i = 0; i < 32; ++i) { const int kk = 2 * i + (lane >> 5); float v = W[(size_t)(k0 + kk) * ldw + srcn0 + (lane & 31)]; if (gain) v *= gain[k0 + kk]; scr[kk * 33 + (lane & 31)] = v; }
    asm volatile("s_waitcnt lgkmcnt(0)" ::: "memory");
#pragma unroll
    for (int j = 0; j < 4; ++j) { const int n = (lane >> 3) + 8 * j; const LAS float* s = scr + (8 * c) * 33 + n;
        u32x4 o; o.x = cvt_pk_bf16(s[0 * 33], s[1 * 33]); o.y = cvt_pk_bf16(s[2 * 33], s[3 * 33]); o.z = cvt_pk_bf16(s[4 * 33], s[5 * 33]); o.w = cvt_pk_bf16(s[6 * 33], s[7 * 33]);
        *(GAS u32x4*)(WT + (size_t)(dstn0 + n) * K + k0 + 8 * c) = o; }
    asm volatile("s_waitcnt lgkmcnt(0)" ::: "memory");
}
__device__ __forceinline__ void convert_layer(KArgsP ap, int l, LAS float* scr, int gw, int NGW, int lane) {
    const KArgs& a = *ap;
    GAS unsigned char* wb = (GAS unsigned char*)(a.ws + WS_W);
    constexpr int N_GU = 16 * 176, N_DN = 44 * 32, N_IN = 16 * 88, N_UQ = 12 * 24, N_UK = 4 * 16, N_WO = 16 * 32;
    constexpr int TOT = 2 * N_GU + 2 * N_DN + N_IN + N_UQ + 2 * N_UK + N_WO;
    for (int it = gw; it < TOT; it += NGW) {
        int r = it;
        if (r < 2 * N_GU) { const int f = r / N_GU; r -= f * N_GU; const int kb = r / 176, nb = r % 176; const int sb = ((nb >> 2) & 1) * 88 + 4 * (nb >> 3) + (nb & 3);
            wt_item((const GAS float*)a.in[f ? I_F2GU : I_F1GU] + (size_t)l * 1024 * 5632, 5632, 1024, (GAS bf16*)(wb + (f ? W_GU2 : W_GU1)), (const GAS float*)a.in[f ? I_F2PRE : I_F1PRE] + l * 1024, 64 * kb, 32 * sb, 32 * nb, scr, lane); continue; }
        r -= 2 * N_GU;
        if (r < 2 * N_DN) { const int f = r / N_DN; r -= f * N_DN; const int kb = r / 32, nb = r % 32;
            wt_item((const GAS float*)a.in[f ? I_F2DN : I_F1DN] + (size_t)l * 2816 * 1024, 1024, 2816, (GAS bf16*)(wb + (f ? W_DN2 : W_DN1)), nullptr, 64 * kb, 32 * nb, 32 * nb, scr, lane); continue; }
        r -= 2 * N_DN;
        if (r < N_IN) { const int kb = r / 88, nb = r % 88;
            wt_item((const GAS float*)a.in[I_WIN] + (size_t)l * 1024 * 2592, 2592, 1024, (GAS bf16*)(wb + W_IN), (const GAS float*)a.in[I_MPRE] + l * 1024, 64 * kb, nb < 81 ? 32 * nb : -1, 32 * nb, scr, lane); continue; }
        r -= N_IN;
        if (r < N_UQ) { const int kb = r / 24, nb = r % 24;
            wt_item((const GAS float*)a.in[I_WUQ] + (size_t)l * 768 * 768, 768, 768, (GAS bf16*)(wb + W_UQ), (const GAS float*)a.in[I_QN] + l * 768, 64 * kb, 32 * nb, 32 * nb, scr, lane); continue; }
        r -= N_UQ;
        if (r < 2 * N_UK) { const int v = r / N_UK; r -= v * N_UK; const int kb = r / 16, nb = r % 16; const int sb = (nb >> 1) * 4 + 2 * v + (nb & 1);
            wt_item((const GAS float*)a.in[I_WUKV] + (size_t)l * 256 * 1024, 1024, 256, (GAS bf16*)(wb + (v ? W_UV : W_UK)), (const GAS float*)a.in[I_KVN] + l * 256, 64 * kb, 32 * sb, 32 * nb, scr, lane); continue; }
        r -= 2 * N_UK;
        { const int kb = r / 32, nb = r % 32; const int k0 = 64 * kb;
            const GAS float* gain = k0 < 256 ? (const GAS float*)a.in[I_CON] + l * 256 : (k0 < 512 ? (const GAS float*)a.in[I_NON] + l * 256 - 256 : (const GAS float*)a.in[I_MON] + l * 512 - 512);
            wt_item((const GAS float*)a.in[I_WO] + (size_t)l * 1024 * 1024, 1024, 1024, (GAS bf16*)(wb + W_O), gain, k0, 32 * nb, 32 * nb, scr, lane); }
    }
}
__device__ __forceinline__ void wave_sum2(float& a, float& b) {
#pragma unroll
    for (int o = 1; o < 64; o <<= 1) { const float ta = __shfl_xor(a, o), tb = __shfl_xor(b, o); a += ta; b += tb; }
}
__device__ __forceinline__ void rowpass(KArgsP ap, const GAS float* gpost, float coef, bool init, bool wxn, int gw, int NGW, int lane) {
    const KArgs& a = *ap;
    GAS float* metah = (GAS float*)(a.ws + WS_METAH); GAS bf16* XY = (GAS bf16*)(a.ws + WS_XY);
    f32x4 g[4];
#pragma unroll
    for (int j = 0; j < 4; ++j) g[j] = init ? (f32x4){0.f, 0.f, 0.f, 0.f} : ((const GAS f32x4*)gpost)[lane + 64 * j] * coef;
    for (int row0 = gw; row0 < MP; row0 += 2 * NGW) {
        GAS unsigned long long* xy8[2]; GAS float* hp[2]; bool val[2], ex[2]; f32x4 h[2][4]; unsigned long long yw[2][4];
#pragma unroll
        for (int k = 0; k < 2; ++k) {
            const int row = row0 + k * NGW; ex[k] = row < MP; int s = 0, i = 0, T = 1; if (ex[k]) row_decode(row, s, i, T);
            val[k] = ex[k] && (i < T + 16);
            xy8[k] = (GAS unsigned long long*)(XY + (size_t)(ex[k] ? row : 0) * DM) + lane;
            hp[k] = hptr((GAS float*)a.out, metah, s, val[k] ? i : 0, T);
            if (val[k]) {
                if (init) { const GAS float* src = (i < T) ? (s < 16 ? (const GAS float*)a.in[I_XP] + ((size_t)s * 2048 + i) * DM : (const GAS float*)a.in[I_XS] + ((size_t)(s - 16) * 4096 + i) * DM) : (const GAS float*)a.in[I_META] + (size_t)(i - T) * DM;
#pragma unroll
                    for (int j = 0; j < 4; ++j) { h[k][j] = ((const GAS f32x4*)src)[lane + 64 * j]; yw[k][j] = 0ull; } }
                else {
#pragma unroll
                    for (int j = 0; j < 4; ++j) { yw[k][j] = xy8[k][64 * j]; h[k][j] = ((const GAS f32x4*)hp[k])[lane + 64 * j]; } }
            } else {
#pragma unroll
                for (int j = 0; j < 4; ++j) { h[k][j] = (f32x4){0.f, 0.f, 0.f, 0.f}; yw[k][j] = 0ull; } }
        }
        f32x4 y[2][4]; float ss[2] = {0.f, 0.f};
#pragma unroll
        for (int k = 0; k < 2; ++k)
#pragma unroll
            for (int j = 0; j < 4; ++j) { const unsigned lo = (unsigned)yw[k][j], hi = (unsigned)(yw[k][j] >> 32);
                y[k][j] = (f32x4){bflo(lo), bfhi(lo), bflo(hi), bfhi(hi)}; ss[k] += (y[k][j][0] * y[k][j][0] + y[k][j][1] * y[k][j][1]) + (y[k][j][2] * y[k][j][2] + y[k][j][3] * y[k][j][3]); }
        if (!init) wave_sum2(ss[0], ss[1]);
        float s2[2] = {0.f, 0.f};
#pragma unroll
        for (int k = 0; k < 2; ++k) { const float ry = __builtin_amdgcn_rsqf(ss[k] * (1.0f / DM) + RMS_EPS);
#pragma unroll
            for (int j = 0; j < 4; ++j) { if (!init) h[k][j] = h[k][j] + y[k][j] * g[j] * ry;
                s2[k] += (h[k][j][0] * h[k][j][0] + h[k][j][1] * h[k][j][1]) + (h[k][j][2] * h[k][j][2] + h[k][j][3] * h[k][j][3]); }
            if (val[k]) {
#pragma unroll
                for (int j = 0; j < 4; ++j) ((GAS f32x4*)hp[k])[lane + 64 * j] = h[k][j]; } }
        if (wxn) {
            wave_sum2(s2[0], s2[1]);
#pragma unroll
            for (int k = 0; k < 2; ++k) if (ex[k]) { const float rh = val[k] ? __builtin_amdgcn_rsqf(s2[k] * (1.0f / DM) + RMS_EPS) : 0.f;
#pragma unroll
                for (int j = 0; j < 4; ++j) { const f32x4 v = h[k][j] * rh; xy8[k][64 * j] = (unsigned long long)cvt_pk_bf16(v[0], v[1]) | ((unsigned long long)cvt_pk_bf16(v[2], v[3]) << 32); } }
        }
    }
}
__device__ __forceinline__ void rope_table(GAS float* tab, int gt, int NGT) {
    for (int e = gt; e < 4112 * 16; e += NGT) { const int pos = e >> 4, j = e & 15; double f = 1.0; for (int k = 0; k < j; ++k) f *= 0.56234132519034907;
        double rev = (double)pos * f * 0.15915494309189535; rev -= __builtin_floor(rev); const float rv = (float)rev;
        tab[2 * e] = __builtin_amdgcn_cosf(rv); tab[2 * e + 1] = __builtin_amdgcn_sinf(rv); }
}
struct Grp { int row0, rows, T, Lp, nseq; };
__device__ __forceinline__ Grp grp_of(int g) { Grp r; if (g == 0) { r.row0 = 0; r.rows = G0_ROWS; r.T = 2048; r.Lp = 2112; r.nseq = 16; } else { r.row0 = G0_ROWS; r.rows = G1_ROWS; r.T = 4096; r.Lp = 4160; r.nseq = 8; } return r; }
__device__ __forceinline__ f32x4 cprod(unsigned long long c, unsigned long long u) {
    return (f32x4){bflo((unsigned)c) * bflo((unsigned)u), bfhi((unsigned)c) * bfhi((unsigned)u), bflo((unsigned)(c >> 32)) * bflo((unsigned)(u >> 32)), bfhi((unsigned)(c >> 32)) * bfhi((unsigned)(u >> 32))};
}
__device__ __forceinline__ void conv_kpe_pass(KArgsP ap, int l, const Grp& G, int gw, int NGW, int lane) {
    const KArgs& a = *ap;
    const GAS bf16* Z = (const GAS bf16*)(a.ws + WS_BIG + B_Z); GAS bf16* KB = (GAS bf16*)(a.ws + WS_BIG + B_K); GAS bf16* YC = (GAS bf16*)(a.ws + WS_BIG + B_YC);
    const GAS float* cw = (const GAS float*)a.in[I_CONVW] + (size_t)l * 3 * 256; const GAS float* rope = (const GAS float*)(a.ws + WS_ROPE);
    const f32x4 w0 = ((const GAS f32x4*)cw)[lane], w1 = ((const GAS f32x4*)(cw + 256))[lane], w2 = ((const GAS f32x4*)(cw + 512))[lane];
    const int T = G.T;
    for (int gr0 = gw; gr0 < G.rows; gr0 += 2 * NGW) {
        bool ex[2], val[2]; int grr[2], pp[2]; unsigned long long cb[2], cc[2], cu[2], lc[2], lu[2], rc[2], ru[2]; unsigned short x1[2], x2[2]; float rcs[2], rsn[2];
#pragma unroll
        for (int k = 0; k < 2; ++k) {
            const int gr = gr0 + k * NGW; ex[k] = gr < G.rows; grr[k] = ex[k] ? gr : 0;
            const int sq = grr[k] / G.Lp, i = grr[k] - sq * G.Lp; val[k] = ex[k] && (i < T + 16);
            const int p = (i < T) ? 16 + i : i - T; pp[k] = val[k] ? p : 0;
            const int il = (p == 0) ? -1 : ((p - 1 >= 16) ? p - 17 : T + p - 1), ir = (p == T + 15) ? -1 : ((p + 1 >= 16) ? p - 15 : T + p + 1);
            cb[k] = cc[k] = cu[k] = lc[k] = lu[k] = rc[k] = ru[k] = 0ull; x1[k] = x2[k] = 0; rcs[k] = 1.f; rsn[k] = 0.f;
            if (val[k]) {
                const GAS bf16* zr = Z + (size_t)grr[k] * ZP;
                cb[k] = *((const GAS unsigned long long*)zr + lane); cc[k] = *((const GAS unsigned long long*)(zr + 256) + lane); cu[k] = *((const GAS unsigned long long*)(zr + 512) + lane);
                if (il >= 0) { const GAS bf16* z2 = Z + (size_t)(sq * G.Lp + il) * ZP; lc[k] = *((const GAS unsigned long long*)(z2 + 256) + lane); lu[k] = *((const GAS unsigned long long*)(z2 + 512) + lane); }
                if (ir >= 0) { const GAS bf16* z2 = Z + (size_t)(sq * G.Lp + ir) * ZP; rc[k] = *((const GAS unsigned long long*)(z2 + 256) + lane); ru[k] = *((const GAS unsigned long long*)(z2 + 512) + lane); }
                if (lane < 16) { x1[k] = zr[2560 + lane]; x2[k] = zr[2576 + lane]; rcs[k] = rope[(size_t)p * 32 + 2 * lane]; rsn[k] = rope[(size_t)p * 32 + 2 * lane + 1]; }
            }
        }
        f32x4 y[2]; float ss[2];
#pragma unroll
        for (int k = 0; k < 2; ++k) { const f32x4 cbv = (f32x4){bflo((unsigned)cb[k]), bfhi((unsigned)cb[k]), bflo((unsigned)(cb[k] >> 32)), bfhi((unsigned)(cb[k] >> 32))};
            y[k] = cbv * (w0 * cprod(lc[k], lu[k]) + w1 * cprod(cc[k], cu[k]) + w2 * cprod(rc[k], ru[k]));
            ss[k] = (y[k][0] * y[k][0] + y[k][1] * y[k][1]) + (y[k][2] * y[k][2] + y[k][3] * y[k][3]); }
        wave_sum2(ss[0], ss[1]);
#pragma unroll
        for (int k = 0; k < 2; ++k) if (ex[k]) {
            const float rn = __builtin_amdgcn_rsqf(ss[k] * (1.0f / 256.0f) + RMS_EPS); const f32x4 o = y[k] * rn;
            *((GAS unsigned long long*)(YC + (size_t)grr[k] * DM) + lane) = (unsigned long long)cvt_pk_bf16(o[0], o[1]) | ((unsigned long long)cvt_pk_bf16(o[2], o[3]) << 32);
            if (lane < 16) { const float a1 = bf2f(x1[k]), a2 = bf2f(x2[k]); const unsigned pk = cvt_pk_bf16(a1 * rcs[k] - a2 * rsn[k], a1 * rsn[k] + a2 * rcs[k]); const bf16 o1 = (bf16)(pk & 0xffffu), o2 = (bf16)(pk >> 16);
#pragma unroll
                for (int h = 0; h < 8; ++h) { KB[(size_t)grr[k] * 768 + 96 * h + 64 + lane] = o1; KB[(size_t)grr[k] * 768 + 96 * h + 80 + lane] = o2; } }
        }
    }
}
__device__ __forceinline__ void ynorm_pass(KArgsP ap, const Grp& G, int gw, int NGW, int lane) {
    const KArgs& a = *ap;
    GAS bf16* YC = (GAS bf16*)(a.ws + WS_BIG + B_YC);
    for (int gr0 = gw; gr0 < G.rows; gr0 += 2 * NGW) {
        bool ex[2], val[2]; GAS unsigned long long* p1[2]; GAS u32x4* p2[2]; unsigned long long w[2]; u32x4 v[2];
#pragma unroll
        for (int k = 0; k < 2; ++k) { const int gr = gr0 + k * NGW; ex[k] = gr < G.rows; const int g2 = ex[k] ? gr : 0; const int sq = g2 / G.Lp, i = g2 - sq * G.Lp; val[k] = ex[k] && (i < G.T + 16);
            p1[k] = (GAS unsigned long long*)(YC + (size_t)g2 * DM + 256) + lane; p2[k] = (GAS u32x4*)(YC + (size_t)g2 * DM + 512) + lane;
            w[k] = 0ull; v[k] = (u32x4){0u, 0u, 0u, 0u}; if (val[k]) { w[k] = *p1[k]; v[k] = *p2[k]; } }
        float y[2][4], z[2][8], s1[2], s2[2];
#pragma unroll
        for (int k = 0; k < 2; ++k) { y[k][0] = bflo((unsigned)w[k]); y[k][1] = bfhi((unsigned)w[k]); y[k][2] = bflo((unsigned)(w[k] >> 32)); y[k][3] = bfhi((unsigned)(w[k] >> 32));
            z[k][0] = bflo(v[k].x); z[k][1] = bfhi(v[k].x); z[k][2] = bflo(v[k].y); z[k][3] = bfhi(v[k].y); z[k][4] = bflo(v[k].z); z[k][5] = bfhi(v[k].z); z[k][6] = bflo(v[k].w); z[k][7] = bfhi(v[k].w);
            s1[k] = (y[k][0] * y[k][0] + y[k][1] * y[k][1]) + (y[k][2] * y[k][2] + y[k][3] * y[k][3]); s2[k] = 0.f;
#pragma unroll
            for (int e = 0; e < 8; ++e) s2[k] += z[k][e] * z[k][e]; }
        wave_sum2(s1[0], s1[1]); wave_sum2(s2[0], s2[1]);
#pragma unroll
        for (int k = 0; k < 2; ++k) if (ex[k]) {
            const float r1 = val[k] ? __builtin_amdgcn_rsqf(s1[k] * (1.0f / 256.0f) + RMS_EPS) : 0.f, r2 = val[k] ? __builtin_amdgcn_rsqf(s2[k] * (1.0f / 512.0f) + RMS_EPS) : 0.f;
            *p1[k] = (unsigned long long)cvt_pk_bf16(y[k][0] * r1, y[k][1] * r1) | ((unsigned long long)cvt_pk_bf16(y[k][2] * r1, y[k][3] * r1) << 32);
            u32x4 o; o.x = cvt_pk_bf16(z[k][0] * r2, z[k][1] * r2); o.y = cvt_pk_bf16(z[k][2] * r2, z[k][3] * r2); o.z = cvt_pk_bf16(z[k][4] * r2, z[k][5] * r2); o.w = cvt_pk_bf16(z[k][6] * r2, z[k][7] * r2); *p2[k] = o; }
    }
}
struct AttG { const GAS bf16 *Q, *K, *VT, *Z; GAS bf16* YC; const GAS float* rope; int rows, T, Lp; };
__device__ __forceinline__ int crow(int r, int hi) { return (r & 3) + 8 * (r >> 2) + 4 * hi; }
#define MFMA32(a, b, c) __builtin_amdgcn_mfma_f32_32x32x16_bf16((a), (b), (c), 0, 0, 0)
template <int MODE>
__device__ __forceinline__ void attn_unit(const AttG& P, int seq, int head, int qb, LAS unsigned char* lds, int tid, int wid, int lane) {
    constexpr int DQK = MODE == 0 ? 96 : 64, NDK = DQK / 16, KP = DQK * 2 + 16, VP = 144;
    const int r32 = lane & 31, hi = lane >> 5;
    const int T = P.T, Lp = P.Lp, nqbr = T >> 8; const bool metablk = (qb == nqbr);
    const int sbase = seq * Lp;
    const int qi = qb * 256 + wid * 32 + r32; const int qic = qi < Lp - 1 ? qi : Lp - 1;
    bf16x8 qr[NDK];
    { const GAS bf16* qsrc = MODE == 0 ? P.Q + (size_t)(sbase + qic) * 768 + 96 * head : P.Z + (size_t)(sbase + qic) * ZP + 768 + 64 * head;
#pragma unroll
      for (int d0 = 0; d0 < NDK; ++d0) qr[d0] = *(const GAS bf16x8*)(qsrc + 16 * d0 + 8 * hi); }
    if constexpr (MODE == 0) {
        const int pos = qic < T ? 16 + qic : (qic - T < 15 ? qic - T : 15);
        const GAS f32x4* rp = (const GAS f32x4*)(P.rope + (size_t)pos * 32 + 16 * hi);
#pragma unroll
        for (int e2 = 0; e2 < 4; ++e2) { const f32x4 cs = rp[e2];
#pragma unroll
            for (int q = 0; q < 2; ++q) { const int e = 2 * e2 + q; const float c = cs[2 * q], s = cs[2 * q + 1];
                const float x1 = bf2f((unsigned short)qr[4][e]), x2 = bf2f((unsigned short)qr[5][e]);
                const unsigned pk = cvt_pk_bf16(x1 * c - x2 * s, x1 * s + x2 * c); qr[4][e] = (short)(pk & 0xffffu); qr[5][e] = (short)(pk >> 16); } }
    }
    int nt, kr_lo = 0; const int rows_total = T >> 6;
    int na_r = 0, na_c = 0, na_rs = 0, na_cs = 0;
    if constexpr (MODE == 0) nt = rows_total + 1;
    else {
        if (metablk) nt = 1;
        else { const int r0 = 4 * qb; int lo = r0 - 4; lo = lo < 0 ? 0 : (lo > rows_total - 8 ? rows_total - 8 : lo); int h2 = r0 - 1; h2 = h2 < 0 ? 0 : (h2 > rows_total - 8 ? rows_total - 8 : h2);
            kr_lo = lo; nt = (h2 + 7 - lo + 1) + 1; }
        na_r = 4 * qb + (wid >> 1); na_c = 32 * (wid & 1) + r32;
        na_rs = na_r - 4; na_rs = na_rs < 0 ? 0 : (na_rs > rows_total - 8 ? rows_total - 8 : na_rs);
        na_cs = na_c - 8; na_cs = na_cs < 0 ? 0 : (na_cs > 48 ? 48 : na_cs);
    }
    const LAS float* tabL = (const LAS float*)(lds + A_TAB) + head * 640 + 64;
    const LAS float* mbL = (const LAS float*)(lds + A_TAB + 4 * 640 * 4) + head * 16;
    LAS float* wsf = (LAS float*)(lds + A_WSF) + wid * 64;
    u32x4 kst0, kst1 = {0u, 0u, 0u, 0u}, vst;
    const int kc0 = tid, kc1 = 512 + tid;
#define TILE_KB(t) ((t) == nt - 1 ? T : 64 * (kr_lo + (t)))
#define GLOAD(t) do { const int kb_ = TILE_KB(t); \
      if constexpr (MODE == 0) { { const int krow = kc0 / 12, part = kc0 % 12; kst0 = *(const GAS u32x4*)(P.K + (size_t)(sbase + kb_ + krow) * 768 + 96 * head + 8 * part); } \
          if (tid < 256) { const int krow = kc1 / 12, part = kc1 % 12; kst1 = *(const GAS u32x4*)(P.K + (size_t)(sbase + kb_ + krow) * 768 + 96 * head + 8 * part); } \
          { const int d = tid >> 3, part = tid & 7; vst = *(const GAS u32x4*)(P.VT + (size_t)(64 * head + d) * P.rows + sbase + kb_ + 8 * part); } } \
      else { const int krow = tid >> 3, part = tid & 7; const GAS bf16* zr_ = P.Z + (size_t)(sbase + kb_ + krow) * ZP + 64 * head + 8 * part; kst0 = *(const GAS u32x4*)(zr_ + 1024); vst = *(const GAS u32x4*)(zr_ + 1280); } } while (0)
#define LSTORE(buf) do { LAS unsigned char* Kb_ = lds + A_K + (buf) * A_KBUF; LAS unsigned char* Vb_ = lds + A_V + (buf) * A_VBUF; \
      if constexpr (MODE == 0) { { const int krow = kc0 / 12, part = kc0 % 12; *(LAS u32x4*)(Kb_ + krow * KP + part * 16) = kst0; } \
          if (tid < 256) { const int krow = kc1 / 12, part = kc1 % 12; *(LAS u32x4*)(Kb_ + krow * KP + part * 16) = kst1; } \
          { const int d = tid >> 3, part = tid & 7; *(LAS u32x4*)(Vb_ + d * VP + part * 16) = vst; } } \
      else { const int krow = tid >> 3, part = tid & 7; *(LAS u32x4*)(Kb_ + krow * KP + part * 16) = kst0; \
          LAS unsigned short* vt_ = (LAS unsigned short*)(Vb_ + (8 * part) * VP + krow * 2); \
          vt_[0 * (VP / 2)] = (unsigned short)(vst.x & 0xffffu); vt_[1 * (VP / 2)] = (unsigned short)(vst.x >> 16); vt_[2 * (VP / 2)] = (unsigned short)(vst.y & 0xffffu); vt_[3 * (VP / 2)] = (unsigned short)(vst.y >> 16); \
          vt_[4 * (VP / 2)] = (unsigned short)(vst.z & 0xffffu); vt_[5 * (VP / 2)] = (unsigned short)(vst.z >> 16); vt_[6 * (VP / 2)] = (unsigned short)(vst.w & 0xffffu); vt_[7 * (VP / 2)] = (unsigned short)(vst.w >> 16); } } while (0)
    GLOAD(0); LSTORE(0);
    __syncthreads();
    float l_reg = 0.f; bool have_m0 = false;
    f32x16 o0, o1, negm;
#pragma unroll
    for (int r = 0; r < 16; ++r) { o0[r] = 0.f; o1[r] = 0.f; negm[r] = 0.f; }
    for (int t = 0; t < nt; ++t) {
        const int buf = t & 1; const bool more = (t + 1 < nt);
        if (more) GLOAD(t + 1);
        const bool is_meta = (t == nt - 1);
        bool active = true;
        if constexpr (MODE == 1) { if (!is_meta) { const int kr = kr_lo + t; active = (kr >= na_rs && kr <= na_rs + 7); } }
        if (active) {
            const LAS unsigned char* Kb = lds + A_K + buf * A_KBUF; const LAS unsigned char* Vb = lds + A_V + buf * A_VBUF;
            f32x16 p0 = negm, p1 = negm;
            bf16x8 kf[2 * NDK]; s16x4 vf[16];
#pragma unroll
            for (int d0 = 0; d0 < NDK; ++d0) {
                kf[2 * d0] = *(const LAS bf16x8*)(Kb + r32 * KP + d0 * 32 + hi * 16);
                kf[2 * d0 + 1] = *(const LAS bf16x8*)(Kb + (32 + r32) * KP + d0 * 32 + hi * 16);
            }
            __builtin_amdgcn_sched_barrier(0);
#pragma unroll
            for (int d0 = 0; d0 < NDK; ++d0) { p0 = MFMA32(kf[2 * d0], qr[d0], p0); p1 = MFMA32(kf[2 * d0 + 1], qr[d0], p1); }
            __builtin_amdgcn_sched_barrier(0);
#pragma unroll
            for (int ks = 0; ks < 4; ++ks) {
                const LAS unsigned char* vp0 = Vb + r32 * VP + (16 * ks + 4 * hi) * 2; const LAS unsigned char* vp1 = vp0 + 32 * VP;
                vf[4 * ks + 0] = *(const LAS s16x4*)vp0; vf[4 * ks + 1] = *(const LAS s16x4*)(vp0 + 16); vf[4 * ks + 2] = *(const LAS s16x4*)vp1; vf[4 * ks + 3] = *(const LAS s16x4*)(vp1 + 16);
            }
            __builtin_amdgcn_sched_barrier(0);
            if (is_meta) {
#pragma unroll
                for (int r = 0; r < 16; ++r) { const int kv = crow(r, hi); float b = 0.f; if constexpr (MODE == 1) b = mbL[kv & 15]; p0[r] = kv < 16 ? p0[r] + b : -INFINITY; p1[r] = -INFINITY; }
            } else if constexpr (MODE == 1) {
                const int kr = kr_lo + t; const LAS float* rp = tabL + (kr - na_r + 7) * 31 + (15 - na_c);
#pragma unroll
                for (int r = 0; r < 16; ++r) { const int kc = crow(r, hi);
                    p0[r] = (kc >= na_cs && kc < na_cs + 16) ? p0[r] + rp[kc] : -INFINITY;
                    p1[r] = (kc + 32 >= na_cs && kc + 32 < na_cs + 16) ? p1[r] + rp[kc + 32] : -INFINITY; }
            }
            if (!have_m0) {
                float mx = fmaxf(p0[0], p1[0]);
#pragma unroll
                for (int r = 1; r < 16; ++r) mx = fmaxf(mx, fmaxf(p0[r], p1[r]));
                mx = fmaxf(mx, __shfl_xor(mx, 32));
#pragma unroll
                for (int r = 0; r < 16; ++r) { p0[r] -= mx; p1[r] -= mx; negm[r] = -mx; }
                have_m0 = true;
            }
            float ls = 0.f;
#pragma unroll
            for (int r = 0; r < 16; ++r) { p0[r] = __builtin_amdgcn_exp2f(fminf(p0[r], 100.0f)); p1[r] = __builtin_amdgcn_exp2f(fminf(p1[r], 100.0f)); ls += p0[r] + p1[r]; }
            l_reg += ls;
            bf16x8 pa[4];
#pragma unroll
            for (int ks = 0; ks < 4; ++ks) { u32x4 w;
                if (ks < 2) { w.x = cvt_pk_bf16(p0[8 * ks + 0], p0[8 * ks + 1]); w.y = cvt_pk_bf16(p0[8 * ks + 2], p0[8 * ks + 3]); w.z = cvt_pk_bf16(p0[8 * ks + 4], p0[8 * ks + 5]); w.w = cvt_pk_bf16(p0[8 * ks + 6], p0[8 * ks + 7]); }
                else { const int b = 8 * (ks - 2); w.x = cvt_pk_bf16(p1[b + 0], p1[b + 1]); w.y = cvt_pk_bf16(p1[b + 2], p1[b + 3]); w.z = cvt_pk_bf16(p1[b + 4], p1[b + 5]); w.w = cvt_pk_bf16(p1[b + 6], p1[b + 7]); }
                pa[ks] = __builtin_bit_cast(bf16x8, w); }
#pragma unroll
            for (int ks = 0; ks < 4; ++ks) {
                const s16x4 a0 = vf[4 * ks + 0], a1 = vf[4 * ks + 1], b0 = vf[4 * ks + 2], b1 = vf[4 * ks + 3];
                const bf16x8 v0 = (bf16x8){a0[0], a0[1], a0[2], a0[3], a1[0], a1[1], a1[2], a1[3]}, v1 = (bf16x8){b0[0], b0[1], b0[2], b0[3], b1[0], b1[1], b1[2], b1[3]};
                o0 = MFMA32(pa[ks], v0, o0); o1 = MFMA32(pa[ks], v1, o1);
            }
        }
        if (more) LSTORE(buf ^ 1);
        __syncthreads();
    }
#undef GLOAD
#undef LSTORE
#undef TILE_KB
    l_reg += __shfl_xor(l_reg, 32);
    if (hi == 0) wsf[32 + r32] = l_reg;
    asm volatile("s_waitcnt lgkmcnt(0)" ::: "memory");
    LAS unsigned short* stg = (LAS unsigned short*)(lds + A_STG) + wid * 2048;
#pragma unroll
    for (int j = 0; j < 4; ++j) { const f32x4 lv = *(const LAS f32x4*)(wsf + 32 + 8 * j + 4 * hi);
#pragma unroll
        for (int e = 0; e < 4; ++e) { const int r = 4 * j + e; const float rl = __builtin_amdgcn_rcpf(lv[e]); const int orow = crow(r, hi);
            const unsigned pk = cvt_pk_bf16(o0[r] * rl, o1[r] * rl); stg[orow * 64 + r32] = (unsigned short)(pk & 0xffffu); stg[orow * 64 + 32 + r32] = (unsigned short)(pk >> 16); } }
    asm volatile("s_waitcnt lgkmcnt(0)" ::: "memory");
    { const int coloff = (MODE == 0 ? 512 : 256) + 64 * head;
#pragma unroll
      for (int i = 0; i < 4; ++i) { const int row = i * 8 + (lane >> 3), ch = lane & 7; const u32x4 v = *(const LAS u32x4*)(stg + row * 64 + ch * 8);
          const int qrow = qb * 256 + wid * 32 + row; const bool valid = metablk ? (wid == 0 && row < 16) : true;
          if (valid) *(GAS u32x4*)(P.YC + (size_t)(sbase + qrow) * DM + coloff + ch * 8) = v; } }
    asm volatile("s_waitcnt lgkmcnt(0)" ::: "memory");
}
__device__ __forceinline__ void attn_phase(KArgsP ap, int l, const Grp& G, unsigned* ctr, LAS unsigned char* lds, int tid, int wid, int lane) {
    const KArgs& a = *ap;
    AttG P; P.Q = (const GAS bf16*)(a.ws + WS_XY) + (size_t)G.row0 * DM; P.K = (const GAS bf16*)(a.ws + WS_BIG + B_K); P.VT = (const GAS bf16*)(a.ws + WS_BIG + B_VT); P.Z = (const GAS bf16*)(a.ws + WS_BIG + B_Z);
    P.YC = (GAS bf16*)(a.ws + WS_BIG + B_YC); P.rope = (const GAS float*)(a.ws + WS_ROPE); P.rows = G.rows; P.T = G.T; P.Lp = G.Lp;
    { LAS float* tab = (LAS float*)(lds + A_TAB); const GAS float* rpb = (const GAS float*)a.in[I_RPB] + (size_t)l * 4 * 465; const GAS float* mb = (const GAS float*)a.in[I_MB] + (size_t)l * 64;
      for (int e = tid; e < 4 * 640; e += NTHR) { const int h = e / 640, j = e - h * 640 - 64; tab[e] = (j >= 0 && j < 465) ? rpb[h * 465 + j] * LOG2E : 0.f; }
      if (tid < 64) tab[4 * 640 + tid] = mb[tid] * LOG2E; }
    const int nqb = (G.T >> 8) + 1; const int P8 = G.nseq, P4 = G.nseq >> 1; const int nq_mla = P8 * nqb, nq_tot = nq_mla + P4 * nqb;
    LAS volatile unsigned* uw = (LAS volatile unsigned*)(lds + A_UW);
    int q = (int)(__builtin_amdgcn_s_getreg((3 << 11) | 20) & 7u), tried = 0;
    for (;;) {
        __syncthreads();
        if (tid == 0) { unsigned j; for (;;) { j = atomicAdd(ctr + q, 1u); if (j < (unsigned)nq_tot || tried >= 7) break; q = (q + 1) & 7; ++tried; }
            *uw = (j < (unsigned)nq_tot) ? (((unsigned)q << 16) | j) : 0xffffffffu; }
        __syncthreads();
        const unsigned w = *uw;
        if (w == 0xffffffffu) break;
        const int qq = (int)(w >> 16), j = (int)(w & 0xffffu);
        if (j < nq_mla) { const int pair = qq * P8 + j / nqb, qb = j % nqb; attn_unit<0>(P, pair >> 3, pair & 7, qb, lds, tid, wid, lane); }
        else { const int v = j - nq_mla; const int pair = qq * P4 + v / nqb, qb = v % nqb; attn_unit<1>(P, pair >> 2, pair & 3, qb, lds, tid, wid, lane); }
    }
}
#define XB_TMO      128
#define XB_XCNT(j)  (256  + 64 * (j))
#define XB_XSUB(j)  (1280 + 64 * (j))
#define XB_XGEN(j)  (2304 + 64 * (j))
#define XB_TOP      3328
#define XB_TOPGEN   3392
#define XCD_BAR_WORDS 3456
#define XB_SPIN_CAP (1u << 18)

__device__ __forceinline__ unsigned xb_ld(unsigned* p)              { return __hip_atomic_load(p, __ATOMIC_RELAXED, __HIP_MEMORY_SCOPE_AGENT); }
__device__ __forceinline__ unsigned xb_add(unsigned* p, unsigned v) { return __hip_atomic_fetch_add(p, v, __ATOMIC_RELAXED, __HIP_MEMORY_SCOPE_AGENT); }
__device__ __forceinline__ unsigned xb_xcc_id() { return (unsigned)__builtin_amdgcn_s_getreg((3 << 11) | 20) & 0xFu; }
#define XB_SPIN(cond, bar) do { unsigned _sp = 0; while (cond) { __builtin_amdgcn_s_sleep(1); \
    if ((++_sp & 255u) == 0u) { if (xb_ld(&(bar)[XB_TMO])) break; if (_sp > XB_SPIN_CAP) { atomicAdd(&(bar)[XB_TMO], 1u); break; } } } } while (0)

struct XcdBarrier {
    unsigned* bar; unsigned x;
    volatile LAS unsigned* st;
};

__device__ __forceinline__ XcdBarrier xcd_barrier_post(unsigned* bar, volatile LAS unsigned* st) {
    XcdBarrier b; b.bar = bar; b.x = xb_xcc_id(); b.st = st;
    if (threadIdx.x == 0) (void)xb_add(&bar[XB_XCNT(b.x)], 1u);
    return b;
}
__device__ __forceinline__ void xcd_barrier_complete(unsigned* bar, unsigned x, unsigned& nloc, unsigned& nx) {
    const unsigned G = gridDim.x * gridDim.y * gridDim.z;
    unsigned sum, cnt, mine, sp = 0u;
    for (;;) {
        sum = 0u; cnt = 0u; mine = 0u;
#pragma unroll
        for (unsigned j = 0; j < 16; ++j) { const unsigned c = xb_ld(&bar[XB_XCNT(j)]); sum += c; cnt += (c > 0u) ? 1u : 0u; mine = (j == x) ? c : mine; }
        if (sum == G) break;
        __builtin_amdgcn_s_sleep(1);
        if ((++sp & 255u) == 0u) { if (xb_ld(&bar[XB_TMO])) break; if (sp > XB_SPIN_CAP) { atomicAdd(&bar[XB_TMO], 1u); break; } }
    }
    nloc = mine > 0u ? mine : 1u; nx = cnt > 0u ? cnt : 1u;
}

__device__ __forceinline__ void xcd_barrier(const XcdBarrier& b) {
    asm volatile("s_waitcnt vmcnt(0)" ::: "memory");
    __syncthreads();
    if (threadIdx.x == 0) {
        unsigned* bar = b.bar;
        __builtin_amdgcn_s_waitcnt(0);
        unsigned nloc = b.st[0], nx = b.st[1];
        if (nloc == 0u) { xcd_barrier_complete(bar, b.x, nloc, nx); b.st[0] = nloc; b.st[1] = nx; }
        const unsigned old = xb_add(&bar[XB_XSUB(b.x)], 1u);
        const unsigned gen = old / nloc;
        if (old + 1u == (gen + 1u) * nloc) {
            __builtin_amdgcn_fence(__ATOMIC_RELEASE, "agent");
            asm volatile("s_waitcnt vmcnt(0)" ::: "memory");
            const unsigned og = xb_add(&bar[XB_TOP], 1u);
            const unsigned tg = og / nx;
            if (og + 1u == (tg + 1u) * nx) xb_add(&bar[XB_TOPGEN], 1u);
            else XB_SPIN(xb_ld(&bar[XB_TOPGEN]) == tg, bar);
            __builtin_amdgcn_fence(__ATOMIC_ACQUIRE, "agent");
            xb_add(&bar[XB_XGEN(b.x)], 1u);
            asm volatile("s_waitcnt vmcnt(0)" ::: "memory");
        } else {
            XB_SPIN(xb_ld(&bar[XB_XGEN(b.x)]) == gen, bar);
            __builtin_amdgcn_fence(__ATOMIC_ACQUIRE, "agent");
            asm volatile("s_waitcnt vmcnt(0)" ::: "memory");
        }
    }
    __syncthreads();
}

constexpr int CW_BAR = 1024;
#define XBAR() do { KArgsP A_ = KA(); XcdBarrier b_; b_.bar = (unsigned*)(A_->ws + WS_CTL) + CW_BAR; b_.x = xb_xcc_id(); b_.st = (volatile LAS unsigned*)(L + 133120); xcd_barrier(b_); } while (0)

#ifndef REP_GEMM
#define REP_GEMM 1
#endif
#ifndef REP_ATT
#define REP_ATT 1
#endif
#ifndef REP_FFN
#define REP_FFN 1
#endif
#define GEMM_CALL1(EpiT, gobj, sobj, eobj) pg8::gemm_phase<EpiT, pg8::StaticOrder, true, true>(L, gobj, sobj, eobj)
#define GEMM_CALL2(EpiT, gobj, sobj, eobj) do { GEMM_CALL1(EpiT, gobj, sobj, eobj); asm volatile("" ::: "memory"); GEMM_CALL1(EpiT, gobj, sobj, eobj); } while (0)
#if REP_FFN == 1
#define GEMM_CALL_F GEMM_CALL1
#else
#define GEMM_CALL_F GEMM_CALL2
#endif
#if REP_GEMM == 1
#define GEMM_CALL(EpiT, gobj, sobj, eobj) pg8::gemm_phase<EpiT, pg8::StaticOrder, true, true>(L, gobj, sobj, eobj)
#else
#define GEMM_CALL(EpiT, gobj, sobj, eobj) do { pg8::gemm_phase<EpiT, pg8::StaticOrder, true, true>(L, gobj, sobj, eobj); asm volatile("" ::: "memory"); pg8::gemm_phase<EpiT, pg8::StaticOrder, true, true>(L, gobj, sobj, eobj); } while (0)
#endif
#define KA() ({ KArgsP p_ = (KArgsP)__builtin_amdgcn_kernarg_segment_ptr(); asm volatile("" : "+s"(p_)); p_; })
__global__ void __launch_bounds__(NTHR, 2) mk_fwd(Args a_unused) {
    extern __shared__ __attribute__((aligned(16))) unsigned char lds_raw[];
    cg::grid_group grid = cg::this_grid();
    LAS unsigned char* L = (LAS unsigned char*)lds_raw;
#define TID ({ int t_ = (int)threadIdx.x; asm volatile("" : "+v"(t_)); t_; })
#define LANE (TID & 63)
#define WID (__builtin_amdgcn_readfirstlane(TID >> 6))
#define NG ((int)gridDim.x)
#define BX ((int)blockIdx.x)
#define GW (BX * NWAVES + WID)
#define NGW (NG * NWAVES)
#define SCR ((LAS float*)(L + WID * 8448))
    if (threadIdx.x < 2) ((volatile LAS unsigned*)(L + 133120))[threadIdx.x] = 0u;
    __syncthreads();
    { KArgsP A = KA(); (void)xcd_barrier_post((unsigned*)(A->ws + WS_CTL) + CW_BAR, (volatile LAS unsigned*)(L + 133120)); }
    { KArgsP A = KA(); rope_table((GAS float*)(A->ws + WS_ROPE), BX * NTHR + TID, NG * NTHR); }
    { KArgsP A = KA(); convert_layer(A, 0, SCR, GW, NGW, LANE); }
    { KArgsP A = KA(); rowpass(A, nullptr, 0.f, true, true, GW, NGW, LANE); }
    grid.sync();
    for (int st = 0; st < 3 * DEPTH; ++st) {
        const int l = st / 3, k = st - 3 * l;
        if (k != 1) {
            const int f = k >> 1;
            { KArgsP A = KA(); unsigned char* ws = A->ws; pg8::Gemm g{(const bf16*)(ws + WS_XY), (const bf16*)(ws + WS_W + (f ? W_GU2 : W_GU1)), MP, 2 * FF, DM, DM, DM}; pg8::StaticOrder S; S.init(MP, 2 * FF, NG, BX);
              pg8::EpiSwiGLU E{(GAS bf16*)(ws + WS_BIG), FF}; GEMM_CALL_F(pg8::EpiSwiGLU, g, S, E); }
            XBAR();
            { KArgsP A = KA(); unsigned char* ws = A->ws; pg8::Gemm g{(const bf16*)(ws + WS_BIG), (const bf16*)(ws + WS_W + (f ? W_DN2 : W_DN1)), MP, DM, FF, FF, FF}; pg8::StaticOrder S; S.init(MP, DM, NG, BX);
              pg8::EpiPlain E{(GAS bf16*)(ws + WS_XY), DM}; GEMM_CALL_F(pg8::EpiPlain, g, S, E); }
            XBAR();
            const bool last = (l == DEPTH - 1 && f == 1);
            { KArgsP A = KA(); rowpass(A, (const GAS float*)A->in[f ? I_F2POST : I_F1POST] + l * DM, 0.5f, false, !last, GW, NGW, LANE); }
            if (f == 1 && !last) { KArgsP A = KA(); convert_layer(A, l + 1, SCR, GW, NGW, LANE); }
            if (!last) XBAR();
        } else {
            for (int gi = 0; gi < 2; ++gi) {
                { KArgsP A = KA(); unsigned char* ws = A->ws; const Grp G = grp_of(gi);
                  pg8::Gemm g{(const bf16*)(ws + WS_XY) + (size_t)G.row0 * DM, (const bf16*)(ws + WS_W + W_IN), G.rows, NINP, DM, DM, DM}; pg8::StaticOrder S; S.init(G.rows, NINP, NG, BX);
                  pg8::EpiInProj E{(GAS bf16*)(ws + WS_BIG + B_Z), (GAS float*)(ws + WS_SSP) + (size_t)G.row0 * 32}; GEMM_CALL(pg8::EpiInProj, g, S, E); }
                XBAR();
                { KArgsP A = KA(); unsigned char* ws = A->ws; const Grp G = grp_of(gi);
                  pg8::Gemm g{(const bf16*)(ws + WS_BIG + B_Z) + 1536, (const bf16*)(ws + WS_W + W_UQ), G.rows, 768, 768, ZP, 768}; pg8::StaticOrder S; S.init(G.rows, 768, NG, BX);
                  pg8::EpiRowScale E{(GAS bf16*)(ws + WS_XY) + (size_t)G.row0 * DM, 768, (const GAS float*)(ws + WS_SSP) + (size_t)G.row0 * 32, 0, 6, 1.0f / 768.0f, 0.10206207261596575f * LOG2E, 0, (LAS float*)(L + 132096)}; GEMM_CALL(pg8::EpiRowScale, g, S, E); }
                { KArgsP A = KA(); unsigned char* ws = A->ws; const Grp G = grp_of(gi);
                  pg8::Gemm g{(const bf16*)(ws + WS_BIG + B_Z) + 2304, (const bf16*)(ws + WS_W + W_UK), G.rows, 512, 256, ZP, 256}; pg8::StaticOrder S; S.init(G.rows, 512, NG, BX, NG - 140 % NG);
                  pg8::EpiRowScale E{(GAS bf16*)(ws + WS_BIG + B_K), 768, (const GAS float*)(ws + WS_SSP) + (size_t)G.row0 * 32, 24, 2, 1.0f / 256.0f, 1.0f, 1, (LAS float*)(L + 132096)}; GEMM_CALL(pg8::EpiRowScale, g, S, E); }
                { KArgsP A = KA(); unsigned char* ws = A->ws; const Grp G = grp_of(gi);
                  pg8::Gemm g{(const bf16*)(ws + WS_W + W_UV), (const bf16*)(ws + WS_BIG + B_Z) + 2304, 512, G.rows, 256, 256, ZP}; pg8::StaticOrder S; S.init(512, G.rows, NG, BX, NG - 148 % NG);
                  pg8::EpiColScale E{(GAS bf16*)(ws + WS_BIG + B_VT), G.rows, (const GAS float*)(ws + WS_SSP) + (size_t)G.row0 * 32, (LAS float*)(L + 132096)}; GEMM_CALL(pg8::EpiColScale, g, S, E); }
                { KArgsP A = KA(); const Grp G = grp_of(gi); conv_kpe_pass(A, l, G, GW, NGW, LANE); }
                XBAR();
                { KArgsP A = KA(); const Grp G = grp_of(gi); for (int rep_ = 0; rep_ < REP_ATT; ++rep_) attn_phase(A, l, G, (unsigned*)(A->ws + WS_CTL) + 64 * (l * 2 + gi) + 32 * rep_, L, TID, WID, LANE); }
                XBAR();
                { KArgsP A = KA(); const Grp G = grp_of(gi); ynorm_pass(A, G, GW, NGW, LANE); }
                XBAR();
                { KArgsP A = KA(); unsigned char* ws = A->ws; const Grp G = grp_of(gi);
                  pg8::Gemm g{(const bf16*)(ws + WS_BIG + B_YC), (const bf16*)(ws + WS_W + W_O), G.rows, DM, DM, DM, DM}; pg8::StaticOrder S; S.init(G.rows, DM, NG, BX);
                  pg8::EpiPlain E{(GAS bf16*)(ws + WS_XY) + (size_t)G.row0 * DM, DM}; GEMM_CALL(pg8::EpiPlain, g, S, E); }
                XBAR();
            }
            { KArgsP A = KA(); rowpass(A, (const GAS float*)A->in[I_MPOST] + l * DM, 1.0f, false, true, GW, NGW, LANE); }
            XBAR();
        }
    }
}

extern "C" void kernel_launch(void* const* d_in, const int* in_sizes, int n_in, void* d_out, int out_size, void* d_ws, size_t ws_size, hipStream_t stream) {
    static int grid = 0;
    if (grid == 0) {
        if (n_in != 25 || ws_size < WS_END) { fprintf(stderr, "kernel_launch: need 25 inputs and %zu B of workspace (got %d, %zu)\n", (size_t)WS_END, n_in, ws_size); grid = -1; return; }
        int dev = 0, cus = 0, per_cu = 0;
        if (hipGetDevice(&dev) != hipSuccess || hipDeviceGetAttribute(&cus, hipDeviceAttributeMultiprocessorCount, dev) != hipSuccess) { grid = -1; return; }
        if (hipFuncSetAttribute((const void*)mk_fwd, hipFuncAttributeMaxDynamicSharedMemorySize, LDS_BYTES) != hipSuccess) { fprintf(stderr, "kernel_launch: hipFuncSetAttribute failed\n"); grid = -1; return; }
        if (hipOccupancyMaxActiveBlocksPerMultiprocessor(&per_cu, (const void*)mk_fwd, NTHR, LDS_BYTES) != hipSuccess || per_cu < 1) { fprintf(stderr, "kernel_launch: occupancy query says %d\n", per_cu); }
        (void)hipGetLastError();
        grid = cus;
    }
    if (grid < 0) return;
    if (hipMemsetAsync((char*)d_ws + WS_CTL, 0, 32768, stream) != hipSuccess) return;
    Args a{};
    for (int i = 0; i < 25; ++i) a.in[i] = (const float*)d_in[i];
    a.out = (float*)d_out; a.ws = (unsigned char*)d_ws;
    void* args[] = {&a};
    hipError_t e = hipLaunchCooperativeKernel((const void*)mk_fwd, dim3(grid), dim3(NTHR), args, LDS_BYTES, stream);
    if (e != hipSuccess) fprintf(stderr, "kernel_launch: cooperative launch failed: %s\n", hipGetErrorString(e));
}
```

```cpp
#include <hip/hip_runtime.h>
#include <hip/hip_cooperative_groups.h>
#include <cstdio>
#include <cstdint>
namespace cg = cooperative_groups;
#define GAS __attribute__((address_space(1)))
namespace pg8 {
#define PG8_LAS __attribute__((address_space(3)))
typedef unsigned short bf16_t;
typedef short bf16x8 __attribute__((ext_vector_type(8)));
typedef float f32x4 __attribute__((ext_vector_type(4)));
typedef unsigned u32x4 __attribute__((ext_vector_type(4)));
constexpr int BM = 256, BK = 64, HALF = 128, HTB = HALF * BK * 2  , STAGE_BYTES = 8 * HTB, NXCD = 8, WGM = 8;

__host__ __device__ __forceinline__ int lds_byte(int r, int c) { const int st = (r >> 4) * 2 + (c >> 5), rr = r & 15, cc = c & 31, ob = rr * 64 + cc * 2; return st * 1024 + (ob ^ (((ob >> 9) & 1) << 5)); }
__host__ __device__ __forceinline__ void stage_rc(int b, int& R, int& C) { const int st = b / 1024, sb = b % 1024, swz = sb ^ (((sb >> 9) & 1) << 5); R = (st >> 1) * 16 + swz / 64; C = (st & 1) * 32 + (swz % 64) / 2; }
__host__ __device__ __forceinline__ int perm32(int rho) { const int n = rho >> 4, i = rho & 15; return 8 * (i >> 2) + 4 * n + (i & 3); }

struct Unit { int pm, pn; };
struct Gemm { const bf16_t* A; const bf16_t* Bt; int M, N, K, lda, ldb; };

struct StaticOrder {
    int nM, nN, nwg, G, c;
    __host__ __device__ void init(int M, int N, int G_, int c_, int shift = 0) { nM = M / BM; nN = N / BM; nwg = nM * nN; G = G_; c = (c_ + shift) % G_; }
    __host__ __device__ bool next(int i, Unit& u) const {
        const long L = (long)i * G + c; if (L >= nwg) return false;
        int wgid = (int)L; { const int q = nwg / NXCD, r = nwg % NXCD, xcd = wgid % NXCD, off = wgid / NXCD; wgid = (xcd < r ? xcd * (q + 1) : r * (q + 1) + (xcd - r) * q) + off; }
        const int nig = WGM * nN, gid = wgid / nig, fm = gid * WGM, gsz = (nM - fm) < WGM ? (nM - fm) : WGM;
        u.pm = fm + ((wgid % nig) % gsz); u.pn = (wgid % nig) / gsz; return true;
    }
    __device__ __forceinline__ void a_ready(const Unit&) const {}
    __device__ __forceinline__ void done(const Unit&) const {}
};

__device__ __forceinline__ unsigned cvt_pk_bf16(float lo, float hi) { typedef float f2 __attribute__((ext_vector_type(2))); typedef __bf16 b2 __attribute__((ext_vector_type(2))); f2 v = {lo, hi}; b2 b = __builtin_convertvector(v, b2); return __builtin_bit_cast(unsigned, b); }
constexpr float LOG2E = 1.4426950408889634f;
constexpr float RMS_EPS = 1e-6f;
#define EPI_STORE8(ptr, v0, v1) do { u32x4 w_; w_.x = cvt_pk_bf16((v0)[0], (v0)[1]); w_.y = cvt_pk_bf16((v0)[2], (v0)[3]); w_.z = cvt_pk_bf16((v1)[0], (v1)[1]); w_.w = cvt_pk_bf16((v1)[2], (v1)[3]); *(GAS u32x4*)(ptr) = w_; } while (0)
struct EpiPlain {
    static constexpr bool PERM = true, AFTER_DRAIN = false;
    GAS bf16_t* O; int ldc;
    __device__ __forceinline__ void operator()(const f32x4 (&acc)[2][2][4][2], const Unit& u, int wr, int wc, int fr, int fq) const {
        const int row0 = u.pm * BM + wr * 64 + fr, col0 = u.pn * BM + wc * 32 + 8 * fq;
#pragma unroll
        for (int ai = 0; ai < 2; ++ai)
#pragma unroll
            for (int m = 0; m < 4; ++m) { GAS bf16_t* rowp = O + (size_t)(row0 + ai * HALF + m * 16) * ldc + col0;
#pragma unroll
                for (int bj = 0; bj < 2; ++bj) EPI_STORE8(rowp + bj * HALF, acc[ai][bj][m][0], acc[ai][bj][m][1]); }
    }
};
__device__ __forceinline__ float silu_mul(float g, float u) { return g * u * __builtin_amdgcn_rcpf(1.0f + __builtin_amdgcn_exp2f(-g * LOG2E)); }
struct EpiSwiGLU {
    static constexpr bool PERM = true, AFTER_DRAIN = false;
    GAS bf16_t* O; int ldc; const GAS float* rinv; PG8_LAS float* tab;
    __device__ __forceinline__ void operator()(const f32x4 (&acc)[2][2][4][2], const Unit& u, int wr, int wc, int fr, int fq) const {
        const int row0 = u.pm * BM + wr * 64 + fr, col0 = u.pn * HALF + wc * 32 + 8 * fq;
        __builtin_amdgcn_s_barrier();
        { const int t = threadIdx.x; if (t < 256) tab[t] = rinv[u.pm * BM + t]; }
        asm volatile("s_waitcnt lgkmcnt(0)" ::: "memory"); __builtin_amdgcn_s_barrier(); asm volatile("" ::: "memory");
#pragma unroll
        for (int ai = 0; ai < 2; ++ai)
#pragma unroll
            for (int m = 0; m < 4; ++m) { GAS bf16_t* rowp = O + (size_t)(row0 + ai * HALF + m * 16) * ldc + col0; const float rs = tab[ai * HALF + wr * 64 + m * 16 + fr];
                f32x4 v0, v1;
#pragma unroll
                for (int e = 0; e < 4; ++e) { v0[e] = silu_mul(acc[ai][0][m][0][e] * rs, acc[ai][1][m][0][e] * rs); v1[e] = silu_mul(acc[ai][0][m][1][e] * rs, acc[ai][1][m][1][e] * rs); }
                EPI_STORE8(rowp, v0, v1); }
    }
};
struct EpiInProj {
    static constexpr bool PERM = true, AFTER_DRAIN = false;
    GAS bf16_t* Z; GAS float* SSP; const GAS float* rinv; PG8_LAS float* tab;
    __device__ __forceinline__ void operator()(const f32x4 (&acc)[2][2][4][2], const Unit& u, int wr, int wc, int fr, int fq) const {
        const int row0 = u.pm * BM + wr * 64 + fr;
        __builtin_amdgcn_s_barrier();
        { const int t = threadIdx.x; if (t < 256) tab[t] = rinv[u.pm * BM + t]; }
        asm volatile("s_waitcnt lgkmcnt(0)" ::: "memory"); __builtin_amdgcn_s_barrier(); asm volatile("" ::: "memory");
#pragma unroll
        for (int bj = 0; bj < 2; ++bj) {
            const int G = 8 * u.pn + 4 * bj + wc, col0 = 32 * G;
            if (col0 >= 2592) continue;
            const float sc = (col0 >= 768 && col0 < 1024) ? 0.125f * LOG2E : 1.0f;
            const bool doss = (G >= 48 && G < 80); const int slot = G - 48;
#pragma unroll
            for (int ai = 0; ai < 2; ++ai)
#pragma unroll
                for (int m = 0; m < 4; ++m) { const int row = row0 + ai * HALF + m * 16; const float rs = tab[ai * HALF + wr * 64 + m * 16 + fr] * sc;
                    const f32x4 v0 = acc[ai][bj][m][0] * rs, v1 = acc[ai][bj][m][1] * rs;
                    if (doss) { float s = (v0[0] * v0[0] + v0[1] * v0[1]) + (v0[2] * v0[2] + v0[3] * v0[3]) + (v1[0] * v1[0] + v1[1] * v1[1]) + (v1[2] * v1[2] + v1[3] * v1[3]);
                        s += __shfl_xor(s, 16); s += __shfl_xor(s, 32); if (fq == 0) SSP[(size_t)row * 32 + slot] = s; }
                    EPI_STORE8(Z + (size_t)row * 2592 + col0 + 8 * fq, v0, v1); }
        }
    }
};
struct EpiRowScale {
    static constexpr bool PERM = true, AFTER_DRAIN = false;
    GAS bf16_t* O; int ldo; const GAS float* SSP; int slot0, nslot4; float invn, extra; int kmap; PG8_LAS float* tab;
    __device__ __forceinline__ void operator()(const f32x4 (&acc)[2][2][4][2], const Unit& u, int wr, int wc, int fr, int fq) const {
        const int row0 = u.pm * BM + wr * 64 + fr;
        __builtin_amdgcn_s_barrier();
        { const int t = threadIdx.x; if (t < 256) { const GAS f32x4* sp = (const GAS f32x4*)(SSP + (size_t)(u.pm * BM + t) * 32 + slot0); float s = 0.f;
            for (int k = 0; k < nslot4; ++k) { const f32x4 v = sp[k]; s += (v[0] + v[1]) + (v[2] + v[3]); }
            tab[t] = __builtin_amdgcn_rsqf(s * invn + RMS_EPS) * extra; } }
        asm volatile("s_waitcnt lgkmcnt(0)" ::: "memory"); __builtin_amdgcn_s_barrier(); asm volatile("" ::: "memory");
#pragma unroll
        for (int ai = 0; ai < 2; ++ai)
#pragma unroll
            for (int m = 0; m < 4; ++m) { const float rs = tab[ai * HALF + wr * 64 + m * 16 + fr];
#pragma unroll
                for (int bj = 0; bj < 2; ++bj) { const int c0 = u.pn * BM + bj * HALF + wc * 32; const int dc = (kmap ? 96 * (c0 >> 6) + (c0 & 63) : c0) + 8 * fq;
                    const f32x4 v0 = acc[ai][bj][m][0] * rs, v1 = acc[ai][bj][m][1] * rs;
                    EPI_STORE8(O + (size_t)(row0 + ai * HALF + m * 16) * ldo + dc, v0, v1); } }
    }
};
struct EpiColScale {
    static constexpr bool PERM = true, AFTER_DRAIN = false;
    GAS bf16_t* O; int ldo; const GAS float* SSP; PG8_LAS float* tab;
    __device__ __forceinline__ void operator()(const f32x4 (&acc)[2][2][4][2], const Unit& u, int wr, int wc, int fr, int fq) const {
        const int row0 = u.pm * BM + wr * 64 + fr;
        __builtin_amdgcn_s_barrier();
        { const int t = threadIdx.x; if (t < 256) { const GAS f32x4* sp = (const GAS f32x4*)(SSP + (size_t)(u.pn * BM + t) * 32 + 24); const f32x4 a = sp[0], b = sp[1];
            tab[t] = __builtin_amdgcn_rsqf(((a[0] + a[1]) + (a[2] + a[3]) + (b[0] + b[1]) + (b[2] + b[3])) * (1.0f / 256.0f) + RMS_EPS); } }
        asm volatile("s_waitcnt lgkmcnt(0)" ::: "memory"); __builtin_amdgcn_s_barrier(); asm volatile("" ::: "memory");
#pragma unroll
        for (int bj = 0; bj < 2; ++bj) { const int cl = bj * HALF + wc * 32 + 8 * fq, c0 = u.pn * BM + cl;
            const f32x4 s0 = *(const PG8_LAS f32x4*)(tab + cl), s1 = *(const PG8_LAS f32x4*)(tab + cl + 4);
#pragma unroll
            for (int ai = 0; ai < 2; ++ai)
#pragma unroll
                for (int m = 0; m < 4; ++m) { const f32x4 v0 = acc[ai][bj][m][0] * s0, v1 = acc[ai][bj][m][1] * s1;
                    EPI_STORE8(O + (size_t)(row0 + ai * HALF + m * 16) * ldo + c0, v0, v1); } }
    }
};
template <class Epi, class Sched, bool ALIGN_EPI = false, bool SP2 = false>
__device__ __forceinline__ void gemm_phase(PG8_LAS unsigned char* lds, const Gemm g, const Sched& S, const Epi& E) {
    int tid_l = threadIdx.x; asm volatile("" : "+v"(tid_l)); const int tid = tid_l, wid = __builtin_amdgcn_readfirstlane(tid >> 6), lane = tid & 63, wr = wid >> 2, wc = wid & 3, fr = lane & 15, fq = lane >> 4;
    int K_l = g.K; asm volatile("" : "+s"(K_l)); const int K = K_l, nt = K / BK;
    unsigned voffA[2], voffB[2];
#pragma unroll
    for (int i = 0; i < 2; ++i) { int R, C; stage_rc(tid * 16 + i * 8192, R, C); const int Rb = Epi::PERM ? ((R & ~31) + perm32(R & 31)) : R;
        voffA[i] = (unsigned)(R * g.lda + C) * 2u; voffB[i] = (unsigned)(Rb * g.ldb + C) * 2u; }
    const size_t kstep = (size_t)(BK * 2);
    const size_t hstepA = (size_t)HALF * g.lda * 2, hstepB = (size_t)HALF * g.ldb * 2;
    const size_t tstepA = 2 * hstepA, tstepB = 2 * hstepB;
    const unsigned ldsw = (unsigned)wid * 1024u;
    const int aoff = lds_byte(wr * 64 + fr, fq * 8), boff = lds_byte(wc * 32 + fr, fq * 8);
#define PG8_SA(b, h) (((b) * 2 + (h)) * HTB)
#define PG8_SB(b, h) ((4 + (b) * 2 + (h)) * HTB)
#define PG8_STAGE(bufoff, gbase, voff) do { _Pragma("unroll") for (int _i = 0; _i < 2; ++_i) \
        __builtin_amdgcn_global_load_lds((const unsigned*)((const char*)(gbase) + (voff)[_i]), (PG8_LAS unsigned*)(lds + (bufoff) + ldsw + _i * 8192), 16, 0, 0); } while (0)
#define PG8_LDA(dst, b, h) do { _Pragma("unroll") for (int m = 0; m < 4; ++m) _Pragma("unroll") for (int k = 0; k < 2; ++k) dst[m][k] = *(const PG8_LAS bf16x8*)(lds + PG8_SA(b, h) + aoff + m * 2048 + k * 1024); } while (0)
#define PG8_LDB(dst, b, h) do { _Pragma("unroll") for (int n = 0; n < 2; ++n) _Pragma("unroll") for (int k = 0; k < 2; ++k) dst[n][k] = *(const PG8_LAS bf16x8*)(lds + PG8_SB(b, h) + boff + n * 2048 + k * 1024); } while (0)
#define PG8_MMA(ai, bj, At, Bt) do { __builtin_amdgcn_s_setprio(1); _Pragma("unroll") for (int m = 0; m < 4; ++m) _Pragma("unroll") for (int n = 0; n < 2; ++n) _Pragma("unroll") for (int k = 0; k < 2; ++k) \
        acc[ai][bj][m][n] = __builtin_amdgcn_mfma_f32_16x16x32_bf16(Bt[n][k], At[m][k], acc[ai][bj][m][n], 0, 0, 0); __builtin_amdgcn_s_setprio(0); } while (0)
#define PG8_WAIT_V(n) asm volatile("s_waitcnt vmcnt(" #n ")" ::: "memory")
#define PG8_WAIT_L(n) asm volatile("s_waitcnt lgkmcnt(" #n ")" ::: "memory")
#define PG8_BAR __builtin_amdgcn_s_barrier()
#define PG8_SCHED __builtin_amdgcn_sched_barrier(0)
    Unit cur, nxt; int ui = 0;
    if (!S.next(0, cur)) return;
    f32x4 acc[2][2][4][2];
#pragma unroll
    for (int a = 0; a < 2; ++a)
#pragma unroll
        for (int b = 0; b < 2; ++b)
#pragma unroll
            for (int m = 0; m < 4; ++m)
#pragma unroll
                for (int n = 0; n < 2; ++n) acc[a][b][m][n] = (f32x4){0.f, 0.f, 0.f, 0.f};
    bf16x8 At[4][2], B0[2][2], B1[2][2];
    const char* cA = (const char*)g.A + (size_t)cur.pm * tstepA; const char* cB = (const char*)g.Bt + (size_t)cur.pn * tstepB;
    S.a_ready(cur);
    if constexpr (SP2) {
        PG8_STAGE(PG8_SB(0, 0), cB, voffB); PG8_STAGE(PG8_SB(0, 1), cB + hstepB, voffB); PG8_STAGE(PG8_SA(0, 0), cA, voffA); PG8_STAGE(PG8_SA(0, 1), cA + hstepA, voffA);
        if (wr == 1) PG8_BAR;
        PG8_WAIT_V(2); PG8_BAR;
        PG8_STAGE(PG8_SB(1, 0), cB + kstep, voffB); PG8_STAGE(PG8_SA(1, 0), cA + kstep, voffA); PG8_STAGE(PG8_SB(1, 1), cB + hstepB + kstep, voffB);
        PG8_WAIT_V(6); PG8_BAR;
    } else {
        PG8_STAGE(PG8_SB(0, 0), cB, voffB); PG8_STAGE(PG8_SA(0, 0), cA, voffA); PG8_STAGE(PG8_SB(0, 1), cB + hstepB, voffB); PG8_STAGE(PG8_SA(0, 1), cA + hstepA, voffA);
        if (wr == 1) PG8_BAR;
        PG8_WAIT_V(4); PG8_BAR;
        PG8_STAGE(PG8_SB(1, 0), cB + kstep, voffB); PG8_STAGE(PG8_SA(1, 0), cA + kstep, voffA); PG8_STAGE(PG8_SB(1, 1), cB + hstepB + kstep, voffB);
        PG8_WAIT_V(6); PG8_BAR;
    }
    for (;;) {
        const bool has_next = S.next(ui + 1, nxt);
        const char* nA = has_next ? (const char*)g.A + (size_t)nxt.pm * tstepA : cA; const char* nB = has_next ? (const char*)g.Bt + (size_t)nxt.pn * tstepB : cB;
        for (int t = 0; t < nt; t += 2) {
            const bool last = (t == nt - 2);
            const char* a1 = cA + (size_t)(t + 1) * kstep;
            const char* a2 = last ? nA : cA + (size_t)(t + 2) * kstep; const char* b2 = last ? nB : cB + (size_t)(t + 2) * kstep;
            const char* a3 = a2 + kstep; const char* b3 = b2 + kstep;
            if (last && has_next) S.a_ready(nxt);
            if constexpr (SP2) {
            PG8_LDB(B0, 0, 0); PG8_LDB(B1, 0, 1); PG8_SCHED; PG8_LDA(At, 0, 0); PG8_STAGE(PG8_SA(1, 1), a1 + hstepA, voffA);
            PG8_WAIT_V(8); PG8_WAIT_L(0); PG8_BAR; PG8_MMA(0, 0, At, B0); PG8_MMA(0, 1, At, B1); PG8_BAR; PG8_SCHED;
            PG8_LDA(At, 0, 1); PG8_STAGE(PG8_SB(0, 0), b2, voffB); PG8_STAGE(PG8_SB(0, 1), b2 + hstepB, voffB); PG8_STAGE(PG8_SA(0, 0), a2, voffA);
            PG8_WAIT_V(8); PG8_WAIT_L(0); PG8_BAR; PG8_MMA(1, 0, At, B0); PG8_MMA(1, 1, At, B1); PG8_BAR; PG8_SCHED;
            PG8_LDB(B0, 1, 0); PG8_LDB(B1, 1, 1); PG8_SCHED; PG8_LDA(At, 1, 0); PG8_STAGE(PG8_SA(0, 1), a2 + hstepA, voffA);
            PG8_WAIT_V(8); PG8_WAIT_L(0); PG8_BAR; PG8_MMA(0, 0, At, B0); PG8_MMA(0, 1, At, B1); PG8_BAR; PG8_SCHED;
            PG8_LDA(At, 1, 1); PG8_STAGE(PG8_SB(1, 0), b3, voffB); PG8_STAGE(PG8_SB(1, 1), b3 + hstepB, voffB); PG8_STAGE(PG8_SA(1, 0), a3, voffA);
            PG8_WAIT_V(8); PG8_WAIT_L(0); PG8_BAR; PG8_MMA(1, 0, At, B0); PG8_MMA(1, 1, At, B1); PG8_BAR; PG8_SCHED;
            } else {
            PG8_LDB(B0, 0, 0); PG8_SCHED; PG8_LDA(At, 0, 0); PG8_STAGE(PG8_SA(1, 1), a1 + hstepA, voffA);
            PG8_WAIT_L(8); PG8_BAR; PG8_WAIT_L(0); PG8_MMA(0, 0, At, B0); PG8_BAR; PG8_SCHED;
            PG8_LDB(B1, 0, 1); PG8_STAGE(PG8_SB(0, 0), b2, voffB);
            PG8_BAR; PG8_WAIT_L(0); PG8_MMA(0, 1, At, B1); PG8_BAR;
            PG8_LDA(At, 0, 1); PG8_STAGE(PG8_SA(0, 0), a2, voffA);
            PG8_BAR; PG8_WAIT_L(0); PG8_MMA(1, 0, At, B0); PG8_BAR; PG8_SCHED;
            PG8_STAGE(PG8_SB(0, 1), b2 + hstepB, voffB);
            PG8_WAIT_V(6); PG8_BAR; PG8_MMA(1, 1, At, B1); PG8_BAR;
            PG8_LDB(B0, 1, 0); PG8_SCHED; PG8_LDA(At, 1, 0); PG8_STAGE(PG8_SA(0, 1), a2 + hstepA, voffA);
            PG8_WAIT_L(8); PG8_BAR; PG8_WAIT_L(0); PG8_MMA(0, 0, At, B0); PG8_BAR; PG8_SCHED;
            PG8_LDB(B1, 1, 1); PG8_STAGE(PG8_SB(1, 0), b3, voffB);
            PG8_BAR; PG8_WAIT_L(0); PG8_MMA(0, 1, At, B1); PG8_BAR;
            PG8_LDA(At, 1, 1); PG8_STAGE(PG8_SA(1, 0), a3, voffA);
            PG8_BAR; PG8_WAIT_L(0); PG8_MMA(1, 0, At, B0); PG8_BAR; PG8_SCHED;
            PG8_STAGE(PG8_SB(1, 1), b3 + hstepB, voffB);
            PG8_WAIT_V(6); PG8_BAR; PG8_MMA(1, 1, At, B1); PG8_BAR;
            }
        }
        if constexpr (ALIGN_EPI) { if (wr == 0) PG8_BAR; }
        if constexpr (!Epi::AFTER_DRAIN) { E(acc, cur, wr, wc, fr, fq); S.done(cur); }
        if (!has_next) break;
#pragma unroll
        for (int a = 0; a < 2; ++a)
#pragma unroll
            for (int b = 0; b < 2; ++b)
#pragma unroll
                for (int m = 0; m < 4; ++m)
#pragma unroll
                    for (int n = 0; n < 2; ++n) acc[a][b][m][n] = (f32x4){0.f, 0.f, 0.f, 0.f};
        cur = nxt; cA = nA; cB = nB; ++ui;
        if constexpr (ALIGN_EPI) { if (wr == 1) PG8_BAR; }
    }
    PG8_WAIT_V(0);
    if constexpr (!ALIGN_EPI) { if (wr == 0) PG8_BAR; }
    PG8_BAR;
    if constexpr (Epi::AFTER_DRAIN) { E.fused(acc, cur, wr, wc, fr, fq, lds, wid, lane); S.done(cur); }
#undef PG8_SA
#undef PG8_SB
#undef PG8_STAGE
#undef PG8_LDA
#undef PG8_LDB
#undef PG8_MMA
#undef PG8_WAIT_V
#undef PG8_WAIT_L
#undef PG8_BAR
#undef PG8_SCHED
}
}
#define LAS __attribute__((address_space(3)))
typedef unsigned short bf16;
typedef unsigned u32x4 __attribute__((ext_vector_type(4)));
typedef unsigned u32x2 __attribute__((ext_vector_type(2)));
typedef float f32x4 __attribute__((ext_vector_type(4)));
typedef float f32x16 __attribute__((ext_vector_type(16)));
typedef short bf16x8 __attribute__((ext_vector_type(8)));
typedef short s16x4 __attribute__((ext_vector_type(4)));
using pg8::cvt_pk_bf16; using pg8::LOG2E; using pg8::RMS_EPS;

constexpr int NWAVES = 8, NTHR = 512;
constexpr int DM = 1024, FF = 2816, ZP = 2592, NINP = 2816, DEPTH = 4;
constexpr int MP = 67072;
constexpr int G0_ROWS = 33792, G1_ROWS = 33280;
constexpr size_t MiB = 1u << 20;
constexpr size_t WS_RINV = 1 * MiB + 640 * 1024;
constexpr size_t WS_CTL = 0, WS_ROPE = 1 * MiB, WS_SSP = 2 * MiB, WS_METAH = 11 * MiB, WS_W = 13 * MiB, WS_XY = 61 * MiB, WS_BIG = 192 * MiB, WS_END = 574 * MiB;
constexpr size_t W_GU1 = 0, W_DN1 = 11 * MiB, W_GU2 = 33 * MiB / 2, W_DN2 = 55 * MiB / 2, W_IN = 33 * MiB, W_UQ = 77 * MiB / 2, W_UK = 40 * MiB, W_UV = 40 * MiB + MiB / 4, W_O = 40 * MiB + MiB / 2;
constexpr size_t B_Z = 0, B_K = 168 * MiB, B_VT = 218 * MiB, B_YC = 251 * MiB;
constexpr int LDS_BYTES = 147456;
constexpr int A_K = 0, A_KBUF = 64 * 208, A_V = 2 * A_KBUF, A_VBUF = 64 * 144, A_WSF = A_V + 2 * A_VBUF, A_STG = A_WSF + 8 * 256, A_TAB = A_STG + 8 * 4096, A_UW = A_TAB + 4 * 640 * 4 + 256;
static_assert(A_UW + 64 <= 131072, "attention LDS");

struct Args { const float* in[25]; float* out; unsigned char* ws; };
typedef const __attribute__((address_space(4))) Args KArgs;
typedef KArgs* KArgsP;
enum { I_XP = 0, I_XS, I_META, I_F1PRE, I_F1GU, I_F1DN, I_F1POST, I_MPRE, I_WIN, I_CONVW, I_RPB, I_MB, I_QN, I_WUQ, I_KVN, I_WUKV, I_CON, I_NON, I_MON, I_WO, I_MPOST, I_F2PRE, I_F2GU, I_F2DN, I_F2POST };

__device__ __forceinline__ float bf2f(unsigned short b) { return __uint_as_float((unsigned)b << 16); }
__device__ __forceinline__ float bflo(unsigned w) { return __uint_as_float(w << 16); }
__device__ __forceinline__ float bfhi(unsigned w) { return __uint_as_float(w & 0xffff0000u); }
__device__ __forceinline__ float wave_sum(float v) {
#pragma unroll
    for (int o = 1; o < 64; o <<= 1) v += __shfl_xor(v, o);
    return v;
}
__device__ __forceinline__ void row_decode(int row, int& s, int& i, int& T) {
    if (row < G0_ROWS) { s = row / 2112; i = row - s * 2112; T = 2048; } else { const int r = row - G0_ROWS, q = r / 4160; s = 16 + q; i = r - q * 4160; T = 4096; }
}
__device__ __forceinline__ GAS float* hptr(GAS float* out, GAS float* metah, int s, int i, int T) {
    if (i < T) { const size_t ob = s < 16 ? (size_t)s * 2048 : (size_t)32768 + (size_t)(s - 16) * 4096; return out + (ob + i) * DM; }
    return metah + (size_t)(s * 16 + (i - T)) * DM;
}
__device__ __forceinline__ void wt_item(const GAS float* W, int ldw, int K, GAS bf16* WT, const GAS float* gain, int k0, int srcn0, int dstn0, LAS float* scr, int lane) {
    const int c = lane & 7;
    if (srcn0 < 0) {
#pragma unroll
        for (int j = 0; j < 4; ++j) { const int n = (lane >> 3) + 8 * j; *(GAS u32x4*)(WT + (size_t)(dstn0 + n) * K + k0 + 8 * c) = (u32x4){0u, 0u, 0u, 0u}; }
        return;
    }
#pragma unroll 8
    for (int i = 0; i < 32; ++i) { const int kk = 2 * i + (lane >> 5); float v = W[(size_t)(k0 + kk) * ldw + srcn0 + (lane & 31)]; if (gain) v *= gain[k0 + kk]; scr[kk * 33 + (lane & 31)] = v; }
    asm volatile("s_waitcnt lgkmcnt(0)" ::: "memory");
#pragma unroll
    for (int j = 0; j < 4; ++j) { const int n = (lane >> 3) + 8 * j; const LAS float* s = scr + (8 * c) * 33 + n;
        u32x4 o; o.x = cvt_pk_bf16(s[0 * 33], s[1 * 33]); o.y = cvt_pk_bf16(s[2 * 33], s[3 * 33]); o.z = cvt_pk_bf16(s[4 * 33], s[5 * 33]); o.w = cvt_pk_bf16(s[6 * 33], s[7 * 33]);
        *(GAS u32x4*)(WT + (size_t)(dstn0 + n) * K + k0 + 8 * c) = o; }
    asm volatile("s_waitcnt lgkmcnt(0)" ::: "memory");
}
__device__ __forceinline__ void convert_layer(KArgsP ap, int l, LAS float* scr, int gw, int NGW, int lane) {
    const KArgs& a = *ap;
    GAS unsigned char* wb = (GAS unsigned char*)(a.ws + WS_W);
    constexpr int N_GU = 16 * 176, N_DN = 44 * 32, N_IN = 16 * 88, N_UQ = 12 * 24, N_UK = 4 * 16, N_WO = 16 * 32;
    constexpr int TOT = 2 * N_GU + 2 * N_DN + N_IN + N_UQ + 2 * N_UK + N_WO;
    for (int it = gw; it < TOT; it += NGW) {
        int r = it;
        if (r < 2 * N_GU) { const int f = r / N_GU; r -= f * N_GU; const int kb = r / 176, nb = r % 176; const int sb = ((nb >> 2) & 1) * 88 + 4 * (nb >> 3) + (nb & 3);
            wt_item((const GAS float*)a.in[f ? I_F2GU : I_F1GU] + (size_t)l * 1024 * 5632, 5632, 1024, (GAS bf16*)(wb + (f ? W_GU2 : W_GU1)), (const GAS float*)a.in[f ? I_F2PRE : I_F1PRE] + l * 1024, 64 * kb, 32 * sb, 32 * nb, scr, lane); continue; }
        r -= 2 * N_GU;
        if (r < 2 * N_DN) { const int f = r / N_DN; r -= f * N_DN; const int kb = r / 32, nb = r % 32;
            wt_item((const GAS float*)a.in[f ? I_F2DN : I_F1DN] + (size_t)l * 2816 * 1024, 1024, 2816, (GAS bf16*)(wb + (f ? W_DN2 : W_DN1)), nullptr, 64 * kb, 32 * nb, 32 * nb, scr, lane); continue; }
        r -= 2 * N_DN;
        if (r < N_IN) { const int kb = r / 88, nb = r % 88;
            wt_item((const GAS float*)a.in[I_WIN] + (size_t)l * 1024 * 2592, 2592, 1024, (GAS bf16*)(wb + W_IN), (const GAS float*)a.in[I_MPRE] + l * 1024, 64 * kb, nb < 81 ? 32 * nb : -1, 32 * nb, scr, lane); continue; }
        r -= N_IN;
        if (r < N_UQ) { const int kb = r / 24, nb = r % 24;
            wt_item((const GAS float*)a.in[I_WUQ] + (size_t)l * 768 * 768, 768, 768, (GAS bf16*)(wb + W_UQ), (const GAS float*)a.in[I_QN] + l * 768, 64 * kb, 32 * nb, 32 * nb, scr, lane); continue; }
        r -= N_UQ;
        if (r < 2 * N_UK) { const int v = r / N_UK; r -= v * N_UK; const int kb = r / 16, nb = r % 16; const int sb = (nb >> 1) * 4 + 2 * v + (nb & 1);
            wt_item((const GAS float*)a.in[I_WUKV] + (size_t)l * 256 * 1024, 1024, 256, (GAS bf16*)(wb + (v ? W_UV : W_UK)), (const GAS float*)a.in[I_KVN] + l * 256, 64 * kb, 32 * sb, 32 * nb, scr, lane); continue; }
        r -= 2 * N_UK;
        { const int kb = r / 32, nb = r % 32; const int k0 = 64 * kb;
            const GAS float* gain = k0 < 256 ? (const GAS float*)a.in[I_CON] + l * 256 : (k0 < 512 ? (const GAS float*)a.in[I_NON] + l * 256 - 256 : (const GAS float*)a.in[I_MON] + l * 512 - 512);
            wt_item((const GAS float*)a.in[I_WO] + (size_t)l * 1024 * 1024, 1024, 1024, (GAS bf16*)(wb + W_O), gain, k0, 32 * nb, 32 * nb, scr, lane); }
    }
}
__device__ __forceinline__ void wave_sum2(float& a, float& b) {
#pragma unroll
    for (int o = 1; o < 64; o <<= 1) { const float ta = __shfl_xor(a, o), tb = __shfl_xor(b, o); a += ta; b += tb; }
}
__device__ __forceinline__ void rowpass(KArgsP ap, const GAS float* gpost, float coef, bool init, int gw, int NGW, int lane) {
    const KArgs& a = *ap;
    GAS bf16* XY = (GAS bf16*)(a.ws + WS_XY); const GAS bf16* YB = (const GAS bf16*)a.out; GAS float* RINV = (GAS float*)(a.ws + WS_RINV);
    f32x4 g[4];
#pragma unroll
    for (int j = 0; j < 4; ++j) g[j] = init ? (f32x4){0.f, 0.f, 0.f, 0.f} : ((const GAS f32x4*)gpost)[lane + 64 * j] * coef;
    for (int row0 = gw; row0 < MP; row0 += 2 * NGW) {
        GAS unsigned long long* xy8[2]; bool val[2], ex[2]; int rw[2]; f32x4 h[2][4]; unsigned long long yw[2][4];
#pragma unroll
        for (int k = 0; k < 2; ++k) {
            const int row = row0 + k * NGW; ex[k] = row < MP; rw[k] = ex[k] ? row : 0; int s = 0, i = 0, T = 1; row_decode(rw[k], s, i, T);
            val[k] = ex[k] && (i < T + 16);
            xy8[k] = (GAS unsigned long long*)(XY + (size_t)rw[k] * DM) + lane;
#pragma unroll
            for (int j = 0; j < 4; ++j) { h[k][j] = (f32x4){0.f, 0.f, 0.f, 0.f}; yw[k][j] = 0ull; }
            if (val[k]) {
                if (init) { const GAS float* src = (i < T) ? (s < 16 ? (const GAS float*)a.in[I_XP] + ((size_t)s * 2048 + i) * DM : (const GAS float*)a.in[I_XS] + ((size_t)(s - 16) * 4096 + i) * DM) : (const GAS float*)a.in[I_META] + (size_t)(i - T) * DM;
#pragma unroll
                    for (int j = 0; j < 4; ++j) h[k][j] = ((const GAS f32x4*)src)[lane + 64 * j]; }
                else { const GAS unsigned long long* y8 = (const GAS unsigned long long*)(YB + (size_t)rw[k] * DM) + lane;
#pragma unroll
                    for (int j = 0; j < 4; ++j) { yw[k][j] = y8[64 * j]; const unsigned long long hw = xy8[k][64 * j]; const unsigned lo = (unsigned)hw, hi = (unsigned)(hw >> 32); h[k][j] = (f32x4){bflo(lo), bfhi(lo), bflo(hi), bfhi(hi)}; } }
            }
        }
        f32x4 y[2][4]; float ss[2] = {0.f, 0.f};
#pragma unroll
        for (int k = 0; k < 2; ++k)
#pragma unroll
            for (int j = 0; j < 4; ++j) { const unsigned lo = (unsigned)yw[k][j], hi = (unsigned)(yw[k][j] >> 32);
                y[k][j] = (f32x4){bflo(lo), bfhi(lo), bflo(hi), bfhi(hi)}; ss[k] += (y[k][j][0] * y[k][j][0] + y[k][j][1] * y[k][j][1]) + (y[k][j][2] * y[k][j][2] + y[k][j][3] * y[k][j][3]); }
        if (!init) wave_sum2(ss[0], ss[1]);
        float s2[2] = {0.f, 0.f}; unsigned long long ow[2][4];
#pragma unroll
        for (int k = 0; k < 2; ++k) { const float ry = __builtin_amdgcn_rsqf(ss[k] * (1.0f / DM) + RMS_EPS);
#pragma unroll
            for (int j = 0; j < 4; ++j) { if (!init) h[k][j] = h[k][j] + y[k][j] * g[j] * ry;
                const unsigned lo = cvt_pk_bf16(h[k][j][0], h[k][j][1]), hi = cvt_pk_bf16(h[k][j][2], h[k][j][3]); ow[k][j] = (unsigned long long)lo | ((unsigned long long)hi << 32);
                const f32x4 hr = (f32x4){bflo(lo), bfhi(lo), bflo(hi), bfhi(hi)};
                s2[k] += (hr[0] * hr[0] + hr[1] * hr[1]) + (hr[2] * hr[2] + hr[3] * hr[3]); } }
        wave_sum2(s2[0], s2[1]);
#pragma unroll
        for (int k = 0; k < 2; ++k) if (ex[k]) {
#pragma unroll
            for (int j = 0; j < 4; ++j) xy8[k][64 * j] = val[k] ? ow[k][j] : 0ull;
            if (lane == 0) RINV[rw[k]] = val[k] ? __builtin_amdgcn_rsqf(s2[k] * (1.0f / DM) + RMS_EPS) : 0.f; }
    }
}
__device__ __forceinline__ void output_pass(KArgsP ap, int gw, int NGW, int lane) {
    const KArgs& a = *ap; const GAS bf16* XY = (const GAS bf16*)(a.ws + WS_XY); GAS float* out = (GAS float*)a.out;
    for (int row = gw; row < MP; row += NGW) {
        int s, i, T; row_decode(row, s, i, T); if (i >= T) continue;
        const size_t ob = s < 16 ? (size_t)s * 2048 : (size_t)32768 + (size_t)(s - 16) * 4096;
        const GAS unsigned long long* x8 = (const GAS unsigned long long*)(XY + (size_t)row * DM) + lane; GAS f32x4* o = (GAS f32x4*)(out + (ob + i) * DM) + lane;
#pragma unroll
        for (int j = 0; j < 4; ++j) { const unsigned long long w = x8[64 * j]; const unsigned lo = (unsigned)w, hi = (unsigned)(w >> 32); o[64 * j] = (f32x4){bflo(lo), bfhi(lo), bflo(hi), bfhi(hi)}; }
    }
}
__device__ __forceinline__ void rope_table(GAS float* tab, int gt, int NGT) {
    for (int e = gt; e < 4112 * 16; e += NGT) { const int pos = e >> 4, j = e & 15; double f = 1.0; for (int k = 0; k < j; ++k) f *= 0.56234132519034907;
        double rev = (double)pos * f * 0.15915494309189535; rev -= __builtin_floor(rev); const float rv = (float)rev;
        tab[2 * e] = __builtin_amdgcn_cosf(rv); tab[2 * e + 1] = __builtin_amdgcn_sinf(rv); }
}
struct Grp { int row0, rows, T, Lp, nseq; };
__device__ __forceinline__ Grp grp_of(int g) { Grp r; if (g == 0) { r.row0 = 0; r.rows = G0_ROWS; r.T = 2048; r.Lp = 2112; r.nseq = 16; } else { r.row0 = G0_ROWS; r.rows = G1_ROWS; r.T = 4096; r.Lp = 4160; r.nseq = 8; } return r; }
__device__ __forceinline__ f32x4 cprod(unsigned long long c, unsigned long long u) {
    return (f32x4){bflo((unsigned)c) * bflo((unsigned)u), bfhi((unsigned)c) * bfhi((unsigned)u), bflo((unsigned)(c >> 32)) * bflo((unsigned)(u >> 32)), bfhi((unsigned)(c >> 32)) * bfhi((unsigned)(u >> 32))};
}
__device__ __forceinline__ void conv_kpe_pass(KArgsP ap, int l, const Grp& G, int gw, int NGW, int lane) {
    const KArgs& a = *ap;
    const GAS bf16* Z = (const GAS bf16*)(a.ws + WS_BIG + B_Z); GAS bf16* KB = (GAS bf16*)(a.ws + WS_BIG + B_K); GAS bf16* YC = (GAS bf16*)(a.ws + WS_BIG + B_YC) + (size_t)G.row0 * DM;
    const GAS float* cw = (const GAS float*)a.in[I_CONVW] + (size_t)l * 3 * 256; const GAS float* rope = (const GAS float*)(a.ws + WS_ROPE);
    const f32x4 w0 = ((const GAS f32x4*)cw)[lane], w1 = ((const GAS f32x4*)(cw + 256))[lane], w2 = ((const GAS f32x4*)(cw + 512))[lane];
    const int T = G.T;
    for (int gr0 = gw; gr0 < G.rows; gr0 += 2 * NGW) {
        bool ex[2], val[2]; int grr[2], pp[2]; unsigned long long cb[2], cc[2], cu[2], lc[2], lu[2], rc[2], ru[2]; unsigned short x1[2], x2[2]; float rcs[2], rsn[2];
#pragma unroll
        for (int k = 0; k < 2; ++k) {
            const int gr = gr0 + k * NGW; ex[k] = gr < G.rows; grr[k] = ex[k] ? gr : 0;
            const int sq = grr[k] / G.Lp, i = grr[k] - sq * G.Lp; val[k] = ex[k] && (i < T + 16);
            const int p = (i < T) ? 16 + i : i - T; pp[k] = val[k] ? p : 0;
            const int il = (p == 0) ? -1 : ((p - 1 >= 16) ? p - 17 : T + p - 1), ir = (p == T + 15) ? -1 : ((p + 1 >= 16) ? p - 15 : T + p + 1);
            cb[k] = cc[k] = cu[k] = lc[k] = lu[k] = rc[k] = ru[k] = 0ull; x1[k] = x2[k] = 0; rcs[k] = 1.f; rsn[k] = 0.f;
            if (val[k]) {
                const GAS bf16* zr = Z + (size_t)grr[k] * ZP;
                cb[k] = *((const GAS unsigned long long*)zr + lane); cc[k] = *((const GAS unsigned long long*)(zr + 256) + lane); cu[k] = *((const GAS unsigned long long*)(zr + 512) + lane);
                if (il >= 0) { const GAS bf16* z2 = Z + (size_t)(sq * G.Lp + il) * ZP; lc[k] = *((const GAS unsigned long long*)(z2 + 256) + lane); lu[k] = *((const GAS unsigned long long*)(z2 + 512) + lane); }
                if (ir >= 0) { const GAS bf16* z2 = Z + (size_t)(sq * G.Lp + ir) * ZP; rc[k] = *((const GAS unsigned long long*)(z2 + 256) + lane); ru[k] = *((const GAS unsigned long long*)(z2 + 512) + lane); }
                if (lane < 16) { x1[k] = zr[2560 + lane]; x2[k] = zr[2576 + lane]; rcs[k] = rope[(size_t)p * 32 + 2 * lane]; rsn[k] = rope[(size_t)p * 32 + 2 * lane + 1]; }
            }
        }
        f32x4 y[2]; float ss[2];
#pragma unroll
        for (int k = 0; k < 2; ++k) { const f32x4 cbv = (f32x4){bflo((unsigned)cb[k]), bfhi((unsigned)cb[k]), bflo((unsigned)(cb[k] >> 32)), bfhi((unsigned)(cb[k] >> 32))};
            y[k] = cbv * (w0 * cprod(lc[k], lu[k]) + w1 * cprod(cc[k], cu[k]) + w2 * cprod(rc[k], ru[k]));
            ss[k] = (y[k][0] * y[k][0] + y[k][1] * y[k][1]) + (y[k][2] * y[k][2] + y[k][3] * y[k][3]); }
        wave_sum2(ss[0], ss[1]);
#pragma unroll
        for (int k = 0; k < 2; ++k) if (ex[k]) {
            const float rn = __builtin_amdgcn_rsqf(ss[k] * (1.0f / 256.0f) + RMS_EPS); const f32x4 o = y[k] * rn;
            *((GAS unsigned long long*)(YC + (size_t)grr[k] * DM) + lane) = (unsigned long long)cvt_pk_bf16(o[0], o[1]) | ((unsigned long long)cvt_pk_bf16(o[2], o[3]) << 32);
            if (lane < 16) { const float a1 = bf2f(x1[k]), a2 = bf2f(x2[k]); const unsigned pk = cvt_pk_bf16(a1 * rcs[k] - a2 * rsn[k], a1 * rsn[k] + a2 * rcs[k]); const bf16 o1 = (bf16)(pk & 0xffffu), o2 = (bf16)(pk >> 16);
#pragma unroll
                for (int h = 0; h < 8; ++h) { KB[(size_t)grr[k] * 768 + 96 * h + 64 + lane] = o1; KB[(size_t)grr[k] * 768 + 96 * h + 80 + lane] = o2; } }
        }
    }
}
__device__ __forceinline__ void ynorm_pass(KArgsP ap, int gw, int NGW, int lane) {
    const KArgs& a = *ap;
    GAS bf16* YC = (GAS bf16*)(a.ws + WS_BIG + B_YC);
    for (int gr0 = gw; gr0 < MP; gr0 += 2 * NGW) {
        bool ex[2], val[2]; GAS unsigned long long* p1[2]; GAS u32x4* p2[2]; unsigned long long w[2]; u32x4 v[2];
#pragma unroll
        for (int k = 0; k < 2; ++k) { const int gr = gr0 + k * NGW; ex[k] = gr < MP; const int g2 = ex[k] ? gr : 0; int sq, i, T; row_decode(g2, sq, i, T); val[k] = ex[k] && (i < T + 16);
            p1[k] = (GAS unsigned long long*)(YC + (size_t)g2 * DM + 256) + lane; p2[k] = (GAS u32x4*)(YC + (size_t)g2 * DM + 512) + lane;
            w[k] = 0ull; v[k] = (u32x4){0u, 0u, 0u, 0u}; if (val[k]) { w[k] = *p1[k]; v[k] = *p2[k]; } }
        float y[2][4], z[2][8], s1[2], s2[2];
#pragma unroll
        for (int k = 0; k < 2; ++k) { y[k][0] = bflo((unsigned)w[k]); y[k][1] = bfhi((unsigned)w[k]); y[k][2] = bflo((unsigned)(w[k] >> 32)); y[k][3] = bfhi((unsigned)(w[k] >> 32));
            z[k][0] = bflo(v[k].x); z[k][1] = bfhi(v[k].x); z[k][2] = bflo(v[k].y); z[k][3] = bfhi(v[k].y); z[k][4] = bflo(v[k].z); z[k][5] = bfhi(v[k].z); z[k][6] = bflo(v[k].w); z[k][7] = bfhi(v[k].w);
            s1[k] = (y[k][0] * y[k][0] + y[k][1] * y[k][1]) + (y[k][2] * y[k][2] + y[k][3] * y[k][3]); s2[k] = 0.f;
#pragma unroll
            for (int e = 0; e < 8; ++e) s2[k] += z[k][e] * z[k][e]; }
        wave_sum2(s1[0], s1[1]); wave_sum2(s2[0], s2[1]);
#pragma unroll
        for (int k = 0; k < 2; ++k) if (ex[k]) {
            const float r1 = val[k] ? __builtin_amdgcn_rsqf(s1[k] * (1.0f / 256.0f) + RMS_EPS) : 0.f, r2 = val[k] ? __builtin_amdgcn_rsqf(s2[k] * (1.0f / 512.0f) + RMS_EPS) : 0.f;
            *p1[k] = (unsigned long long)cvt_pk_bf16(y[k][0] * r1, y[k][1] * r1) | ((unsigned long long)cvt_pk_bf16(y[k][2] * r1, y[k][3] * r1) << 32);
            u32x4 o; o.x = cvt_pk_bf16(z[k][0] * r2, z[k][1] * r2); o.y = cvt_pk_bf16(z[k][2] * r2, z[k][3] * r2); o.z = cvt_pk_bf16(z[k][4] * r2, z[k][5] * r2); o.w = cvt_pk_bf16(z[k][6] * r2, z[k][7] * r2); *p2[k] = o; }
    }
}
struct AttG { const GAS bf16 *Q, *K, *VT, *Z; GAS bf16* YC; const GAS float* rope; int rows, T, Lp; };
__device__ __forceinline__ int crow(int r, int hi) { return (r & 3) + 8 * (r >> 2) + 4 * hi; }
#define MFMA32(a, b, c) __builtin_amdgcn_mfma_f32_32x32x16_bf16((a), (b), (c), 0, 0, 0)
template <int MODE>
__device__ __forceinline__ void attn_unit(const AttG& P, int seq, int head, int qb, LAS unsigned char* lds, int tid, int wid, int lane) {
    constexpr int DQK = MODE == 0 ? 96 : 64, NDK = DQK / 16, KP = DQK * 2 + 16, VP = 144;
    const int r32 = lane & 31, hi = lane >> 5;
    const int T = P.T, Lp = P.Lp, nqbr = T >> 8; const bool metablk = (qb == nqbr);
    const int sbase = seq * Lp;
    const int qi = qb * 256 + wid * 32 + r32; const int qic = qi < Lp - 1 ? qi : Lp - 1;
    bf16x8 qr[NDK];
    { const GAS bf16* qsrc = MODE == 0 ? P.Q + (size_t)(sbase + qic) * 768 + 96 * head : P.Z + (size_t)(sbase + qic) * ZP + 768 + 64 * head;
#pragma unroll
      for (int d0 = 0; d0 < NDK; ++d0) qr[d0] = *(const GAS bf16x8*)(qsrc + 16 * d0 + 8 * hi); }
    if constexpr (MODE == 0) {
        const int pos = qic < T ? 16 + qic : (qic - T < 15 ? qic - T : 15);
        const GAS f32x4* rp = (const GAS f32x4*)(P.rope + (size_t)pos * 32 + 16 * hi);
#pragma unroll
        for (int e2 = 0; e2 < 4; ++e2) { const f32x4 cs = rp[e2];
#pragma unroll
            for (int q = 0; q < 2; ++q) { const int e = 2 * e2 + q; const float c = cs[2 * q], s = cs[2 * q + 1];
                const float x1 = bf2f((unsigned short)qr[4][e]), x2 = bf2f((unsigned short)qr[5][e]);
                const unsigned pk = cvt_pk_bf16(x1 * c - x2 * s, x1 * s + x2 * c); qr[4][e] = (short)(pk & 0xffffu); qr[5][e] = (short)(pk >> 16); } }
    }
    int nt, kr_lo = 0; const int rows_total = T >> 6;
    int na_r = 0, na_c = 0, na_rs = 0, na_cs = 0;
    if constexpr (MODE == 0) nt = rows_total + 1;
    else {
        if (metablk) nt = 1;
        else { const int r0 = 4 * qb; int lo = r0 - 4; lo = lo < 0 ? 0 : (lo > rows_total - 8 ? rows_total - 8 : lo); int h2 = r0 - 1; h2 = h2 < 0 ? 0 : (h2 > rows_total - 8 ? rows_total - 8 : h2);
            kr_lo = lo; nt = (h2 + 7 - lo + 1) + 1; }
        na_r = 4 * qb + (wid >> 1); na_c = 32 * (wid & 1) + r32;
        na_rs = na_r - 4; na_rs = na_rs < 0 ? 0 : (na_rs > rows_total - 8 ? rows_total - 8 : na_rs);
        na_cs = na_c - 8; na_cs = na_cs < 0 ? 0 : (na_cs > 48 ? 48 : na_cs);
    }
    const LAS float* tabL = (const LAS float*)(lds + A_TAB) + head * 640 + 64;
    const LAS float* mbL = (const LAS float*)(lds + A_TAB + 4 * 640 * 4) + head * 16;
    LAS float* wsf = (LAS float*)(lds + A_WSF) + wid * 64;
    u32x4 kst0, kst1 = {0u, 0u, 0u, 0u}, vst;
    const int kc0 = tid, kc1 = 512 + tid;
#define TILE_KB(t) ((t) == nt - 1 ? T : 64 * (kr_lo + (t)))
#define GLOAD(t) do { const int kb_ = TILE_KB(t); \
      if constexpr (MODE == 0) { { const int krow = kc0 / 12, part = kc0 % 12; kst0 = *(const GAS u32x4*)(P.K + (size_t)(sbase + kb_ + krow) * 768 + 96 * head + 8 * part); } \
          if (tid < 256) { const int krow = kc1 / 12, part = kc1 % 12; kst1 = *(const GAS u32x4*)(P.K + (size_t)(sbase + kb_ + krow) * 768 + 96 * head + 8 * part); } \
          { const int d = tid >> 3, part = tid & 7; vst = *(const GAS u32x4*)(P.VT + (size_t)(64 * head + d) * P.rows + sbase + kb_ + 8 * part); } } \
      else { const int krow = tid >> 3, part = tid & 7; const GAS bf16* zr_ = P.Z + (size_t)(sbase + kb_ + krow) * ZP + 64 * head + 8 * part; kst0 = *(const GAS u32x4*)(zr_ + 1024); vst = *(const GAS u32x4*)(zr_ + 1280); } } while (0)
#define LSTORE(buf) do { LAS unsigned char* Kb_ = lds + A_K + (buf) * A_KBUF; LAS unsigned char* Vb_ = lds + A_V + (buf) * A_VBUF; \
      if constexpr (MODE == 0) { { const int krow = kc0 / 12, part = kc0 % 12; *(LAS u32x4*)(Kb_ + krow * KP + part * 16) = kst0; } \
          if (tid < 256) { const int krow = kc1 / 12, part = kc1 % 12; *(LAS u32x4*)(Kb_ + krow * KP + part * 16) = kst1; } \
          { const int d = tid >> 3, part = tid & 7; *(LAS u32x4*)(Vb_ + d * VP + part * 16) = vst; } } \
      else { const int krow = tid >> 3, part = tid & 7; *(LAS u32x4*)(Kb_ + krow * KP + part * 16) = kst0; \
          LAS unsigned short* vt_ = (LAS unsigned short*)(Vb_ + (8 * part) * VP + krow * 2); \
          vt_[0 * (VP / 2)] = (unsigned short)(vst.x & 0xffffu); vt_[1 * (VP / 2)] = (unsigned short)(vst.x >> 16); vt_[2 * (VP / 2)] = (unsigned short)(vst.y & 0xffffu); vt_[3 * (VP / 2)] = (unsigned short)(vst.y >> 16); \
          vt_[4 * (VP / 2)] = (unsigned short)(vst.z & 0xffffu); vt_[5 * (VP / 2)] = (unsigned short)(vst.z >> 16); vt_[6 * (VP / 2)] = (unsigned short)(vst.w & 0xffffu); vt_[7 * (VP / 2)] = (unsigned short)(vst.w >> 16); } } while (0)
    GLOAD(0); LSTORE(0);
    __syncthreads();
    float l_reg = 0.f; bool have_m0 = false;
    f32x16 o0, o1, negm;
#pragma unroll
    for (int r = 0; r < 16; ++r) { o0[r] = 0.f; o1[r] = 0.f; negm[r] = 0.f; }
    for (int t = 0; t < nt; ++t) {
        const int buf = t & 1; const bool more = (t + 1 < nt);
        if (more) GLOAD(t + 1);
        const bool is_meta = (t == nt - 1);
        bool active = true;
        if constexpr (MODE == 1) { if (!is_meta) { const int kr = kr_lo + t; active = (kr >= na_rs && kr <= na_rs + 7); } }
        if (active) {
            const LAS unsigned char* Kb = lds + A_K + buf * A_KBUF; const LAS unsigned char* Vb = lds + A_V + buf * A_VBUF;
            f32x16 p0 = negm, p1 = negm;
            bf16x8 kf[2 * NDK]; s16x4 vf[16];
#pragma unroll
            for (int d0 = 0; d0 < NDK; ++d0) {
                kf[2 * d0] = *(const LAS bf16x8*)(Kb + r32 * KP + d0 * 32 + hi * 16);
                kf[2 * d0 + 1] = *(const LAS bf16x8*)(Kb + (32 + r32) * KP + d0 * 32 + hi * 16);
            }
            __builtin_amdgcn_sched_barrier(0);
#pragma unroll
            for (int d0 = 0; d0 < NDK; ++d0) { p0 = MFMA32(kf[2 * d0], qr[d0], p0); p1 = MFMA32(kf[2 * d0 + 1], qr[d0], p1); }
            __builtin_amdgcn_sched_barrier(0);
#pragma unroll
            for (int ks = 0; ks < 4; ++ks) {
                const LAS unsigned char* vp0 = Vb + r32 * VP + (16 * ks + 4 * hi) * 2; const LAS unsigned char* vp1 = vp0 + 32 * VP;
                vf[4 * ks + 0] = *(const LAS s16x4*)vp0; vf[4 * ks + 1] = *(const LAS s16x4*)(vp0 + 16); vf[4 * ks + 2] = *(const LAS s16x4*)vp1; vf[4 * ks + 3] = *(const LAS s16x4*)(vp1 + 16);
            }
            __builtin_amdgcn_sched_barrier(0);
            if (is_meta) {
#pragma unroll
                for (int r = 0; r < 16; ++r) { const int kv = crow(r, hi); float b = 0.f; if constexpr (MODE == 1) b = mbL[kv & 15]; p0[r] = kv < 16 ? p0[r] + b : -INFINITY; p1[r] = -INFINITY; }
            } else if constexpr (MODE == 1) {
                const int kr = kr_lo + t; const LAS float* rp = tabL + (kr - na_r + 7) * 31 + (15 - na_c);
#pragma unroll
                for (int r = 0; r < 16; ++r) { const int kc = crow(r, hi);
                    p0[r] = (kc >= na_cs && kc < na_cs + 16) ? p0[r] + rp[kc] : -INFINITY;
                    p1[r] = (kc + 32 >= na_cs && kc + 32 < na_cs + 16) ? p1[r] + rp[kc + 32] : -INFINITY; }
            }
            if (!have_m0) {
                float mx = fmaxf(p0[0], p1[0]);
#pragma unroll
                for (int r = 1; r < 16; ++r) mx = fmaxf(mx, fmaxf(p0[r], p1[r]));
                mx = fmaxf(mx, __shfl_xor(mx, 32));
#pragma unroll
                for (int r = 0; r < 16; ++r) { p0[r] -= mx; p1[r] -= mx; negm[r] = -mx; }
                have_m0 = true;
            }
            { typedef float f32x2 __attribute__((ext_vector_type(2)));
              f32x2 accA = {0.f, 0.f}, accB = {0.f, 0.f};
#pragma unroll
              for (int r = 0; r < 16; r += 2) {
                  f32x2 a, b;
                  a.x = __builtin_amdgcn_exp2f(fminf(p0[r], 100.0f)); a.y = __builtin_amdgcn_exp2f(fminf(p0[r + 1], 100.0f));
                  b.x = __builtin_amdgcn_exp2f(fminf(p1[r], 100.0f)); b.y = __builtin_amdgcn_exp2f(fminf(p1[r + 1], 100.0f));
                  accA += a; accB += b; p0[r] = a.x; p0[r + 1] = a.y; p1[r] = b.x; p1[r + 1] = b.y; }
              const f32x2 acc = accA + accB; l_reg += acc.x + acc.y; }
            bf16x8 pa[4];
#pragma unroll
            for (int ks = 0; ks < 4; ++ks) { u32x4 w;
                if (ks < 2) { w.x = cvt_pk_bf16(p0[8 * ks + 0], p0[8 * ks + 1]); w.y = cvt_pk_bf16(p0[8 * ks + 2], p0[8 * ks + 3]); w.z = cvt_pk_bf16(p0[8 * ks + 4], p0[8 * ks + 5]); w.w = cvt_pk_bf16(p0[8 * ks + 6], p0[8 * ks + 7]); }
                else { const int b = 8 * (ks - 2); w.x = cvt_pk_bf16(p1[b + 0], p1[b + 1]); w.y = cvt_pk_bf16(p1[b + 2], p1[b + 3]); w.z = cvt_pk_bf16(p1[b + 4], p1[b + 5]); w.w = cvt_pk_bf16(p1[b + 6], p1[b + 7]); }
                pa[ks] = __builtin_bit_cast(bf16x8, w); }
#pragma unroll
            for (int ks = 0; ks < 4; ++ks) {
                const s16x4 a0 = vf[4 * ks + 0], a1 = vf[4 * ks + 1], b0 = vf[4 * ks + 2], b1 = vf[4 * ks + 3];
                const bf16x8 v0 = (bf16x8){a0[0], a0[1], a0[2], a0[3], a1[0], a1[1], a1[2], a1[3]}, v1 = (bf16x8){b0[0], b0[1], b0[2], b0[3], b1[0], b1[1], b1[2], b1[3]};
                o0 = MFMA32(pa[ks], v0, o0); o1 = MFMA32(pa[ks], v1, o1);
            }
        }
        if (more) LSTORE(buf ^ 1);
        __syncthreads();
    }
#undef GLOAD
#undef LSTORE
#undef TILE_KB
    l_reg += __shfl_xor(l_reg, 32);
    if (hi == 0) wsf[32 + r32] = l_reg;
    asm volatile("s_waitcnt lgkmcnt(0)" ::: "memory");
    LAS unsigned short* stg = (LAS unsigned short*)(lds + A_STG) + wid * 2048;
#pragma unroll
    for (int j = 0; j < 4; ++j) { const f32x4 lv = *(const LAS f32x4*)(wsf + 32 + 8 * j + 4 * hi);
#pragma unroll
        for (int e = 0; e < 4; ++e) { const int r = 4 * j + e; const float rl = __builtin_amdgcn_rcpf(lv[e]); const int orow = crow(r, hi);
            const unsigned pk = cvt_pk_bf16(o0[r] * rl, o1[r] * rl); stg[orow * 64 + r32] = (unsigned short)(pk & 0xffffu); stg[orow * 64 + 32 + r32] = (unsigned short)(pk >> 16); } }
    asm volatile("s_waitcnt lgkmcnt(0)" ::: "memory");
    { const int coloff = (MODE == 0 ? 512 : 256) + 64 * head;
#pragma unroll
      for (int i = 0; i < 4; ++i) { const int row = i * 8 + (lane >> 3), ch = lane & 7; const u32x4 v = *(const LAS u32x4*)(stg + row * 64 + ch * 8);
          const int qrow = qb * 256 + wid * 32 + row; const bool valid = metablk ? (wid == 0 && row < 16) : true;
          if (valid) *(GAS u32x4*)(P.YC + (size_t)(sbase + qrow) * DM + coloff + ch * 8) = v; } }
    asm volatile("s_waitcnt lgkmcnt(0)" ::: "memory");
}
__device__ __forceinline__ void mla_scores(const GAS bf16* Kh, int kb, int r32, const bf16x8 (&qr)[6], f32x16& p0, f32x16& p1) {
#pragma unroll
    for (int r = 0; r < 16; ++r) { p0[r] = 0.f; p1[r] = 0.f; }
    bf16x8 kf[12];
#pragma unroll
    for (int d0 = 0; d0 < 6; ++d0) { kf[2 * d0] = *(const GAS bf16x8*)(Kh + (size_t)(kb + r32) * 768 + 16 * d0); kf[2 * d0 + 1] = *(const GAS bf16x8*)(Kh + (size_t)(kb + 32 + r32) * 768 + 16 * d0); }
#pragma unroll
    for (int d0 = 0; d0 < 6; ++d0) { p0 = MFMA32(kf[2 * d0], qr[d0], p0); p1 = MFMA32(kf[2 * d0 + 1], qr[d0], p1); }
}
__device__ __forceinline__ void attn_meta_mla(const AttG& P, int seq, int head, LAS unsigned char* lds, int tid_in, int wid, int lane_in) {
    int lane = lane_in, tid = tid_in; asm volatile("" : "+v"(lane), "+v"(tid));
    const int r32 = lane & 31, hi = lane >> 5;
    const int T = P.T, Lp = P.Lp, sbase = seq * Lp, nt = (T >> 6) + 1;
    bf16x8 qr[6];
    { const GAS bf16* qsrc = P.Q + (size_t)(sbase + T + r32) * 768 + 96 * head;
#pragma unroll
      for (int d0 = 0; d0 < 6; ++d0) qr[d0] = *(const GAS bf16x8*)(qsrc + 16 * d0 + 8 * hi);
      const int pos = r32 < 15 ? r32 : 15; const GAS f32x4* rp = (const GAS f32x4*)(P.rope + (size_t)pos * 32 + 16 * hi);
#pragma unroll
      for (int e2 = 0; e2 < 4; ++e2) { const f32x4 cs = rp[e2];
#pragma unroll
          for (int q = 0; q < 2; ++q) { const int e = 2 * e2 + q; const float c = cs[2 * q], sn = cs[2 * q + 1];
              const float x1 = bf2f((unsigned short)qr[4][e]), x2 = bf2f((unsigned short)qr[5][e]);
              const unsigned pk = cvt_pk_bf16(x1 * c - x2 * sn, x1 * sn + x2 * c); qr[4][e] = (short)(pk & 0xffffu); qr[5][e] = (short)(pk >> 16); } } }
    float m0, l_reg = 0.f; f32x16 o0, o1;
#pragma unroll
    for (int r = 0; r < 16; ++r) { o0[r] = 0.f; o1[r] = 0.f; }
    const GAS bf16* Kh = P.K + (size_t)sbase * 768 + 96 * head + 8 * hi;
    const GAS bf16* Vh = P.VT + (size_t)(64 * head + r32) * P.rows + sbase + 4 * hi;
    { f32x16 p0, p1; mla_scores(Kh, 0, r32, qr, p0, p1);
      float mx = fmaxf(p0[0], p1[0]);
#pragma unroll
      for (int r = 1; r < 16; ++r) mx = fmaxf(mx, fmaxf(p0[r], p1[r]));
      m0 = fmaxf(mx, __shfl_xor(mx, 32)); }
#pragma unroll 1
    for (int t = wid; t < nt; t += 8) {
        const int kb = (t == nt - 1) ? T : 64 * t;
        f32x16 p0, p1; mla_scores(Kh, kb, r32, qr, p0, p1);
        s16x4 vf[16];
#pragma unroll
        for (int ks = 0; ks < 4; ++ks) { const GAS bf16* v0 = Vh + kb + 16 * ks; const GAS bf16* v1 = v0 + (size_t)32 * P.rows;
            vf[4 * ks + 0] = *(const GAS s16x4*)v0; vf[4 * ks + 1] = *(const GAS s16x4*)(v0 + 8); vf[4 * ks + 2] = *(const GAS s16x4*)v1; vf[4 * ks + 3] = *(const GAS s16x4*)(v1 + 8); }
        if (t == nt - 1) {
#pragma unroll
            for (int r = 0; r < 16; ++r) { if (crow(r, hi) >= 16) p0[r] = -INFINITY; p1[r] = -INFINITY; }
        }
        float ls = 0.f;
#pragma unroll
        for (int r = 0; r < 16; ++r) { p0[r] = __builtin_amdgcn_exp2f(fminf(p0[r] - m0, 100.0f)); p1[r] = __builtin_amdgcn_exp2f(fminf(p1[r] - m0, 100.0f)); ls += p0[r] + p1[r]; }
        l_reg += ls;
#pragma unroll
        for (int ks = 0; ks < 4; ++ks) { u32x4 w;
            if (ks < 2) { w.x = cvt_pk_bf16(p0[8 * ks + 0], p0[8 * ks + 1]); w.y = cvt_pk_bf16(p0[8 * ks + 2], p0[8 * ks + 3]); w.z = cvt_pk_bf16(p0[8 * ks + 4], p0[8 * ks + 5]); w.w = cvt_pk_bf16(p0[8 * ks + 6], p0[8 * ks + 7]); }
            else { const int b = 8 * (ks - 2); w.x = cvt_pk_bf16(p1[b + 0], p1[b + 1]); w.y = cvt_pk_bf16(p1[b + 2], p1[b + 3]); w.z = cvt_pk_bf16(p1[b + 4], p1[b + 5]); w.w = cvt_pk_bf16(p1[b + 6], p1[b + 7]); }
            const bf16x8 pa = __builtin_bit_cast(bf16x8, w);
            const s16x4 a0 = vf[4 * ks + 0], a1 = vf[4 * ks + 1], b0 = vf[4 * ks + 2], b1 = vf[4 * ks + 3];
            const bf16x8 v0 = (bf16x8){a0[0], a0[1], a0[2], a0[3], a1[0], a1[1], a1[2], a1[3]}, v1 = (bf16x8){b0[0], b0[1], b0[2], b0[3], b1[0], b1[1], b1[2], b1[3]};
            o0 = MFMA32(pa, v0, o0); o1 = MFMA32(pa, v1, o1); }
    }
    l_reg += __shfl_xor(l_reg, 32);
    LAS float* red = (LAS float*)lds; LAS float* lred = (LAS float*)(lds + 65536);
#pragma unroll
    for (int r = 0; r < 16; ++r) { red[wid * 2048 + (r * 2 + 0) * 64 + lane] = o0[r]; red[wid * 2048 + (r * 2 + 1) * 64 + lane] = o1[r]; }
    if (hi == 0) lred[wid * 32 + r32] = l_reg;
    asm volatile("s_waitcnt lgkmcnt(0)" ::: "memory"); __syncthreads();
#pragma unroll 1
    for (int e = tid; e < 2048; e += NTHR) { float a = 0.f;
#pragma unroll
        for (int w = 0; w < 8; ++w) a += red[w * 2048 + e];
        red[e] = a; }
    if (tid < 32) { float a = 0.f;
#pragma unroll
        for (int w = 0; w < 8; ++w) a += lred[w * 32 + tid];
        lred[tid] = a; }
    asm volatile("s_waitcnt lgkmcnt(0)" ::: "memory"); __syncthreads();
    if (wid == 0) {
#pragma unroll
        for (int r = 0; r < 16; ++r) { o0[r] = red[(r * 2 + 0) * 64 + lane]; o1[r] = red[(r * 2 + 1) * 64 + lane]; }
        LAS float* lsum = lred;
        float rl[16];
#pragma unroll
        for (int j = 0; j < 4; ++j) { const f32x4 lv = *(const LAS f32x4*)(lsum + 8 * j + 4 * hi);
#pragma unroll
            for (int e = 0; e < 4; ++e) rl[4 * j + e] = __builtin_amdgcn_rcpf(lv[e]); }
        asm volatile("s_waitcnt lgkmcnt(0)" ::: "memory");
        LAS unsigned short* stg = (LAS unsigned short*)(lds + A_STG);
#pragma unroll
        for (int r = 0; r < 16; ++r) { const int orow = crow(r, hi); const unsigned pk = cvt_pk_bf16(o0[r] * rl[r], o1[r] * rl[r]); stg[orow * 64 + r32] = (unsigned short)(pk & 0xffffu); stg[orow * 64 + 32 + r32] = (unsigned short)(pk >> 16); }
        asm volatile("s_waitcnt lgkmcnt(0)" ::: "memory");
#pragma unroll
        for (int i = 0; i < 2; ++i) { const int row = i * 8 + (lane >> 3), ch = lane & 7; const u32x4 v = *(const LAS u32x4*)(stg + row * 64 + ch * 8);
            *(GAS u32x4*)(P.YC + (size_t)(sbase + T + row) * DM + 512 + 64 * head + ch * 8) = v; }
        asm volatile("s_waitcnt lgkmcnt(0)" ::: "memory");
    }
}
__device__ __forceinline__ void attn_phase(KArgsP ap, int l, const Grp& G, unsigned* ctr, LAS unsigned char* lds, int tid, int wid, int lane) {
    const KArgs& a = *ap;
    AttG P; P.Q = (const GAS bf16*)a.out + (size_t)G.row0 * DM; P.K = (const GAS bf16*)(a.ws + WS_BIG + B_K); P.VT = (const GAS bf16*)(a.ws + WS_BIG + B_VT); P.Z = (const GAS bf16*)(a.ws + WS_BIG + B_Z);
    P.YC = (GAS bf16*)(a.ws + WS_BIG + B_YC) + (size_t)G.row0 * DM; P.rope = (const GAS float*)(a.ws + WS_ROPE); P.rows = G.rows; P.T = G.T; P.Lp = G.Lp;
    { LAS float* tab = (LAS float*)(lds + A_TAB); const GAS float* rpb = (const GAS float*)a.in[I_RPB] + (size_t)l * 4 * 465; const GAS float* mb = (const GAS float*)a.in[I_MB] + (size_t)l * 64;
      for (int e = tid; e < 4 * 640; e += NTHR) { const int h = e / 640, j = e - h * 640 - 64; tab[e] = (j >= 0 && j < 465) ? rpb[h * 465 + j] * LOG2E : 0.f; }
      if (tid < 64) tab[4 * 640 + tid] = mb[tid] * LOG2E; }
    const int nqb = (G.T >> 8) + 1; const int P8 = G.nseq, P4 = G.nseq >> 1; const int nq_mla = P8 * nqb, nq_tot = nq_mla + P4 * nqb;
    LAS volatile unsigned* uw = (LAS volatile unsigned*)(lds + A_UW);
    int q = (int)(__builtin_amdgcn_s_getreg((3 << 11) | 20) & 7u), tried = 0;
    for (;;) {
        __syncthreads();
        if (tid == 0) { unsigned j; for (;;) { j = atomicAdd(ctr + q, 1u); if (j < (unsigned)nq_tot || tried >= 7) break; q = (q + 1) & 7; ++tried; }
            *uw = (j < (unsigned)nq_tot) ? (((unsigned)q << 16) | j) : 0xffffffffu; }
        __syncthreads();
        const unsigned w = *uw;
        if (w == 0xffffffffu) break;
        const int qq = (int)(w >> 16), j = (int)(w & 0xffffu);
        if (j < nq_mla) { const int pair = qq * P8 + j / nqb, qb = j % nqb; if (qb == nqb - 1) attn_meta_mla(P, pair >> 3, pair & 7, lds, tid, wid, lane); else attn_unit<0>(P, pair >> 3, pair & 7, qb, lds, tid, wid, lane); }
        else { const int v = j - nq_mla; const int pair = qq * P4 + v / nqb, qb = v % nqb; attn_unit<1>(P, pair >> 2, pair & 3, qb, lds, tid, wid, lane); }
    }
}
#define XB_TMO      128
#define XB_XCNT(j)  (256  + 64 * (j))
#define XB_XSUB(j)  (1280 + 64 * (j))
#define XB_XGEN(j)  (2304 + 64 * (j))
#define XB_TOP      3328
#define XB_TOPGEN   3392
#define XCD_BAR_WORDS 3456
#define XB_SPIN_CAP (1u << 18)

__device__ __forceinline__ unsigned xb_ld(unsigned* p)              { return __hip_atomic_load(p, __ATOMIC_RELAXED, __HIP_MEMORY_SCOPE_AGENT); }
__device__ __forceinline__ unsigned xb_add(unsigned* p, unsigned v) { return __hip_atomic_fetch_add(p, v, __ATOMIC_RELAXED, __HIP_MEMORY_SCOPE_AGENT); }
__device__ __forceinline__ unsigned xb_xcc_id() { return (unsigned)__builtin_amdgcn_s_getreg((3 << 11) | 20) & 0xFu; }
#define XB_SPIN(cond, bar) do { unsigned _sp = 0; while (cond) { __builtin_amdgcn_s_sleep(1); \
    if ((++_sp & 255u) == 0u) { if (xb_ld(&(bar)[XB_TMO])) break; if (_sp > XB_SPIN_CAP) { atomicAdd(&(bar)[XB_TMO], 1u); break; } } } } while (0)

struct XcdBarrier {
    unsigned* bar; unsigned x;
    volatile LAS unsigned* st;
};

__device__ __forceinline__ XcdBarrier xcd_barrier_post(unsigned* bar, volatile LAS unsigned* st) {
    XcdBarrier b; b.bar = bar; b.x = xb_xcc_id(); b.st = st;
    if (threadIdx.x == 0) (void)xb_add(&bar[XB_XCNT(b.x)], 1u);
    return b;
}
__device__ __forceinline__ void xcd_barrier_complete(unsigned* bar, unsigned x, unsigned& nloc, unsigned& nx) {
    const unsigned G = gridDim.x * gridDim.y * gridDim.z;
    unsigned sum, cnt, mine, sp = 0u;
    for (;;) {
        sum = 0u; cnt = 0u; mine = 0u;
#pragma unroll
        for (unsigned j = 0; j < 16; ++j) { const unsigned c = xb_ld(&bar[XB_XCNT(j)]); sum += c; cnt += (c > 0u) ? 1u : 0u; mine = (j == x) ? c : mine; }
        if (sum == G) break;
        __builtin_amdgcn_s_sleep(1);
        if ((++sp & 255u) == 0u) { if (xb_ld(&bar[XB_TMO])) break; if (sp > XB_SPIN_CAP) { atomicAdd(&bar[XB_TMO], 1u); break; } }
    }
    nloc = mine > 0u ? mine : 1u; nx = cnt > 0u ? cnt : 1u;
}

__device__ __forceinline__ void xcd_barrier(const XcdBarrier& b) {
    asm volatile("s_waitcnt vmcnt(0)" ::: "memory");
    __syncthreads();
    if (threadIdx.x == 0) {
        unsigned* bar = b.bar;
        __builtin_amdgcn_s_waitcnt(0);
        unsigned nloc = b.st[0], nx = b.st[1];
        if (nloc == 0u) { xcd_barrier_complete(bar, b.x, nloc, nx); b.st[0] = nloc; b.st[1] = nx; }
        const unsigned old = xb_add(&bar[XB_XSUB(b.x)], 1u);
        const unsigned gen = old / nloc;
        if (old + 1u == (gen + 1u) * nloc) {
            __builtin_amdgcn_fence(__ATOMIC_RELEASE, "agent");
            asm volatile("s_waitcnt vmcnt(0)" ::: "memory");
            const unsigned og = xb_add(&bar[XB_TOP], 1u);
            const unsigned tg = og / nx;
            if (og + 1u == (tg + 1u) * nx) xb_add(&bar[XB_TOPGEN], 1u);
            else XB_SPIN(xb_ld(&bar[XB_TOPGEN]) == tg, bar);
            __builtin_amdgcn_fence(__ATOMIC_ACQUIRE, "agent");
            xb_add(&bar[XB_XGEN(b.x)], 1u);
            asm volatile("s_waitcnt vmcnt(0)" ::: "memory");
        } else {
            XB_SPIN(xb_ld(&bar[XB_XGEN(b.x)]) == gen, bar);
            __builtin_amdgcn_fence(__ATOMIC_ACQUIRE, "agent");
            asm volatile("s_waitcnt vmcnt(0)" ::: "memory");
        }
    }
    __syncthreads();
}

constexpr int CW_BAR = 1024;
#define XBAR() do { KArgsP A_ = KA(); XcdBarrier b_; b_.bar = (unsigned*)(A_->ws + WS_CTL) + CW_BAR; b_.x = xb_xcc_id(); b_.st = (volatile LAS unsigned*)(L + 133120); xcd_barrier(b_); } while (0)

#ifndef REP_GEMM
#define REP_GEMM 1
#endif
#ifndef REP_ATT
#define REP_ATT 1
#endif
#ifndef REP_FFN
#define REP_FFN 1
#endif
#define GEMM_CALL1(EpiT, gobj, sobj, eobj) pg8::gemm_phase<EpiT, pg8::StaticOrder, true, true>(L, gobj, sobj, eobj)
#define GEMM_CALL2(EpiT, gobj, sobj, eobj) do { GEMM_CALL1(EpiT, gobj, sobj, eobj); asm volatile("" ::: "memory"); GEMM_CALL1(EpiT, gobj, sobj, eobj); } while (0)
#if REP_FFN == 1
#define GEMM_CALL_F GEMM_CALL1
#else
#define GEMM_CALL_F GEMM_CALL2
#endif
#if REP_GEMM == 1
#define GEMM_CALL(EpiT, gobj, sobj, eobj) pg8::gemm_phase<EpiT, pg8::StaticOrder, true, true>(L, gobj, sobj, eobj)
#else
#define GEMM_CALL(EpiT, gobj, sobj, eobj) do { pg8::gemm_phase<EpiT, pg8::StaticOrder, true, true>(L, gobj, sobj, eobj); asm volatile("" ::: "memory"); pg8::gemm_phase<EpiT, pg8::StaticOrder, true, true>(L, gobj, sobj, eobj); } while (0)
#endif
#define KA() ({ KArgsP p_ = (KArgsP)__builtin_amdgcn_kernarg_segment_ptr(); asm volatile("" : "+s"(p_)); p_; })
__global__ void __launch_bounds__(NTHR, 2) mk_fwd(Args a_unused) {
    extern __shared__ __attribute__((aligned(16))) unsigned char lds_raw[];
    cg::grid_group grid = cg::this_grid();
    LAS unsigned char* L = (LAS unsigned char*)lds_raw;
#define TID ({ int t_ = (int)threadIdx.x; asm volatile("" : "+v"(t_)); t_; })
#define LANE (TID & 63)
#define WID (__builtin_amdgcn_readfirstlane(TID >> 6))
#define NG ((int)gridDim.x)
#define BX ((int)blockIdx.x)
#define GW (BX * NWAVES + WID)
#define NGW (NG * NWAVES)
#define SCR ((LAS float*)(L + WID * 8448))
    if (threadIdx.x < 2) ((volatile LAS unsigned*)(L + 133120))[threadIdx.x] = 0u;
    __syncthreads();
    { KArgsP A = KA(); (void)xcd_barrier_post((unsigned*)(A->ws + WS_CTL) + CW_BAR, (volatile LAS unsigned*)(L + 133120)); }
    { KArgsP A = KA(); rope_table((GAS float*)(A->ws + WS_ROPE), BX * NTHR + TID, NG * NTHR); }
    { KArgsP A = KA(); convert_layer(A, 0, SCR, GW, NGW, LANE); }
    { KArgsP A = KA(); rowpass(A, nullptr, 0.f, true, GW, NGW, LANE); }
    grid.sync();
    for (int st = 0; st < 3 * DEPTH; ++st) {
        const int l = st / 3, k = st - 3 * l;
        if (k != 1) {
            const int f = k >> 1;
            { KArgsP A = KA(); unsigned char* ws = A->ws; pg8::Gemm g{(const bf16*)(ws + WS_XY), (const bf16*)(ws + WS_W + (f ? W_GU2 : W_GU1)), MP, 2 * FF, DM, DM, DM}; pg8::StaticOrder S; S.init(MP, 2 * FF, NG, BX);
              pg8::EpiSwiGLU E{(GAS bf16*)(ws + WS_BIG), FF, (const GAS float*)(ws + WS_RINV), (LAS float*)(L + 132096)}; GEMM_CALL_F(pg8::EpiSwiGLU, g, S, E); }
            XBAR();
            { KArgsP A = KA(); unsigned char* ws = A->ws; pg8::Gemm g{(const bf16*)(ws + WS_BIG), (const bf16*)(ws + WS_W + (f ? W_DN2 : W_DN1)), MP, DM, FF, FF, FF}; pg8::StaticOrder S; S.init(MP, DM, NG, BX);
              pg8::EpiPlain E{(GAS bf16*)A->out, DM}; GEMM_CALL_F(pg8::EpiPlain, g, S, E); }
            XBAR();
            const bool last = (l == DEPTH - 1 && f == 1);
            { KArgsP A = KA(); rowpass(A, (const GAS float*)A->in[f ? I_F2POST : I_F1POST] + l * DM, 0.5f, false, GW, NGW, LANE); }
            if (f == 1 && !last) { KArgsP A = KA(); convert_layer(A, l + 1, SCR, GW, NGW, LANE); }
            XBAR();
            if (last) { KArgsP A = KA(); output_pass(A, GW, NGW, LANE); }
        } else {
            for (int gi = 0; gi < 2; ++gi) {
                { KArgsP A = KA(); unsigned char* ws = A->ws; const Grp G = grp_of(gi);
                  pg8::Gemm g{(const bf16*)(ws + WS_XY) + (size_t)G.row0 * DM, (const bf16*)(ws + WS_W + W_IN), G.rows, NINP, DM, DM, DM}; pg8::StaticOrder S; S.init(G.rows, NINP, NG, BX);
                  pg8::EpiInProj E{(GAS bf16*)(ws + WS_BIG + B_Z), (GAS float*)(ws + WS_SSP) + (size_t)G.row0 * 32, (const GAS float*)(ws + WS_RINV) + G.row0, (LAS float*)(L + 132096)}; GEMM_CALL(pg8::EpiInProj, g, S, E); }
                XBAR();
                { KArgsP A = KA(); unsigned char* ws = A->ws; const Grp G = grp_of(gi);
                  pg8::Gemm g{(const bf16*)(ws + WS_BIG + B_Z) + 1536, (const bf16*)(ws + WS_W + W_UQ), G.rows, 768, 768, ZP, 768}; pg8::StaticOrder S; S.init(G.rows, 768, NG, BX);
                  pg8::EpiRowScale E{(GAS bf16*)A->out + (size_t)G.row0 * DM, 768, (const GAS float*)(ws + WS_SSP) + (size_t)G.row0 * 32, 0, 6, 1.0f / 768.0f, 0.10206207261596575f * LOG2E, 0, (LAS float*)(L + 132096)}; GEMM_CALL(pg8::EpiRowScale, g, S, E); }
                { KArgsP A = KA(); unsigned char* ws = A->ws; const Grp G = grp_of(gi);
                  pg8::Gemm g{(const bf16*)(ws + WS_BIG + B_Z) + 2304, (const bf16*)(ws + WS_W + W_UK), G.rows, 512, 256, ZP, 256}; pg8::StaticOrder S; S.init(G.rows, 512, NG, BX, NG - 140 % NG);
                  pg8::EpiRowScale E{(GAS bf16*)(ws + WS_BIG + B_K), 768, (const GAS float*)(ws + WS_SSP) + (size_t)G.row0 * 32, 24, 2, 1.0f / 256.0f, 1.0f, 1, (LAS float*)(L + 132096)}; GEMM_CALL(pg8::EpiRowScale, g, S, E); }
                { KArgsP A = KA(); unsigned char* ws = A->ws; const Grp G = grp_of(gi);
                  pg8::Gemm g{(const bf16*)(ws + WS_W + W_UV), (const bf16*)(ws + WS_BIG + B_Z) + 2304, 512, G.rows, 256, 256, ZP}; pg8::StaticOrder S; S.init(512, G.rows, NG, BX, NG - 148 % NG);
                  pg8::EpiColScale E{(GAS bf16*)(ws + WS_BIG + B_VT), G.rows, (const GAS float*)(ws + WS_SSP) + (size_t)G.row0 * 32, (LAS float*)(L + 132096)}; GEMM_CALL(pg8::EpiColScale, g, S, E); }
                { KArgsP A = KA(); const Grp G = grp_of(gi); conv_kpe_pass(A, l, G, GW, NGW, LANE); }
                XBAR();
                { KArgsP A = KA(); const Grp G = grp_of(gi); for (int rep_ = 0; rep_ < REP_ATT; ++rep_) attn_phase(A, l, G, (unsigned*)(A->ws + WS_CTL) + 64 * (l * 2 + gi) + 32 * rep_, L, TID, WID, LANE); }
                XBAR();
            }
            { KArgsP A = KA(); ynorm_pass(A, GW, NGW, LANE); }
            XBAR();
            { KArgsP A = KA(); unsigned char* ws = A->ws;
              pg8::Gemm g{(const bf16*)(ws + WS_BIG + B_YC), (const bf16*)(ws + WS_W + W_O), MP, DM, DM, DM, DM}; pg8::StaticOrder S; S.init(MP, DM, NG, BX);
              pg8::EpiPlain E{(GAS bf16*)A->out, DM}; GEMM_CALL(pg8::EpiPlain, g, S, E); }
            XBAR();
            { KArgsP A = KA(); rowpass(A, (const GAS float*)A->in[I_MPOST] + l * DM, 1.0f, false, GW, NGW, LANE); }
            XBAR();
        }
    }
}

extern "C" void kernel_launch(void* const* d_in, const int* in_sizes, int n_in, void* d_out, int out_size, void* d_ws, size_t ws_size, hipStream_t stream) {
    static int grid = 0;
    if (grid == 0) {
        if (n_in != 25 || ws_size < WS_END) { fprintf(stderr, "kernel_launch: need 25 inputs and %zu B of workspace (got %d, %zu)\n", (size_t)WS_END, n_in, ws_size); grid = -1; return; }
        int dev = 0, cus = 0, per_cu = 0;
        if (hipGetDevice(&dev) != hipSuccess || hipDeviceGetAttribute(&cus, hipDeviceAttributeMultiprocessorCount, dev) != hipSuccess) { grid = -1; return; }
        if (hipFuncSetAttribute((const void*)mk_fwd, hipFuncAttributeMaxDynamicSharedMemorySize, LDS_BYTES) != hipSuccess) { fprintf(stderr, "kernel_launch: hipFuncSetAttribute failed\n"); grid = -1; return; }
        if (hipOccupancyMaxActiveBlocksPerMultiprocessor(&per_cu, (const void*)mk_fwd, NTHR, LDS_BYTES) != hipSuccess || per_cu < 1) { fprintf(stderr, "kernel_launch: occupancy query says %d\n", per_cu); }
        (void)hipGetLastError();
        grid = cus;
    }
    if (grid < 0) return;
    if (hipMemsetAsync((char*)d_ws + WS_CTL, 0, 32768, stream) != hipSuccess) return;
    Args a{};
    for (int i = 0; i < 25; ++i) a.in[i] = (const float*)d_in[i];
    a.out = (float*)d_out; a.ws = (unsigned char*)d_ws;
    void* args[] = {&a};
    hipError_t e = hipLaunchCooperativeKernel((const void*)mk_fwd, dim3(grid), dim3(NTHR), args, LDS_BYTES, stream);
    if (e != hipSuccess) fprintf(stderr, "kernel_launch: cooperative launch failed: %s\n", hipGetErrorString(e));
}
```

```cpp
#include <hip/hip_runtime.h>
#include <hip/hip_cooperative_groups.h>
#include <cstdio>
#include <cstdint>
namespace cg = cooperative_groups;
#define GAS __attribute__((address_space(1)))
namespace pg8 {
#define PG8_LAS __attribute__((address_space(3)))
typedef unsigned short bf16_t;
typedef short bf16x8 __attribute__((ext_vector_type(8)));
typedef float f32x4 __attribute__((ext_vector_type(4)));
typedef unsigned u32x4 __attribute__((ext_vector_type(4)));
constexpr int BM = 256, BK = 64, HALF = 128, HTB = HALF * BK * 2  , STAGE_BYTES = 8 * HTB, NXCD = 8, WGM = 8;

__host__ __device__ __forceinline__ int lds_byte(int r, int c) { const int st = (r >> 4) * 2 + (c >> 5), rr = r & 15, cc = c & 31, ob = rr * 64 + cc * 2; return st * 1024 + (ob ^ (((ob >> 9) & 1) << 5)); }
__host__ __device__ __forceinline__ void stage_rc(int b, int& R, int& C) { const int st = b / 1024, sb = b % 1024, swz = sb ^ (((sb >> 9) & 1) << 5); R = (st >> 1) * 16 + swz / 64; C = (st & 1) * 32 + (swz % 64) / 2; }
__host__ __device__ __forceinline__ int perm32(int rho) { const int n = rho >> 4, i = rho & 15; return 8 * (i >> 2) + 4 * n + (i & 3); }

struct Unit { int pm, pn; };
struct Gemm { const bf16_t* A; const bf16_t* Bt; int M, N, K, lda, ldb; };

struct StaticOrder {
    int nM, nN, nwg, G, c;
    __host__ __device__ void init(int M, int N, int G_, int c_, int shift = 0) { nM = M / BM; nN = N / BM; nwg = nM * nN; G = G_; c = (c_ + shift) % G_; }
    __host__ __device__ bool next(int i, Unit& u) const {
        const long L = (long)i * G + c; if (L >= nwg) return false;
        int wgid = (int)L; { const int q = nwg / NXCD, r = nwg % NXCD, xcd = wgid % NXCD, off = wgid / NXCD; wgid = (xcd < r ? xcd * (q + 1) : r * (q + 1) + (xcd - r) * q) + off; }
        const int nig = WGM * nN, gid = wgid / nig, fm = gid * WGM, gsz = (nM - fm) < WGM ? (nM - fm) : WGM;
        u.pm = fm + ((wgid % nig) % gsz); u.pn = (wgid % nig) / gsz; return true;
    }
    __device__ __forceinline__ void a_ready(const Unit&) const {}
    __device__ __forceinline__ void done(const Unit&) const {}
};
struct LinearOrder {
    int first, count, nN, G, vc;
    __host__ __device__ void init(int first_, int count_, int nN_, int G_, int bx) { first = first_; count = count_; nN = nN_; G = G_; vc = (G_ % 8 == 0) ? (bx % 8) * (G_ / 8) + bx / 8 : bx; }
    __host__ __device__ bool next(int i, Unit& u) const { const int L = i * G + vc; if (L >= count) return false; const int w = first + L; u.pm = w / nN; u.pn = w % nN; return true; }
    __device__ __forceinline__ void a_ready(const Unit&) const {}
    __device__ __forceinline__ void done(const Unit&) const {}
};
__device__ __forceinline__ unsigned cvt_pk_bf16(float lo, float hi) { typedef float f2 __attribute__((ext_vector_type(2))); typedef __bf16 b2 __attribute__((ext_vector_type(2))); f2 v = {lo, hi}; b2 b = __builtin_convertvector(v, b2); return __builtin_bit_cast(unsigned, b); }
constexpr float LOG2E = 1.4426950408889634f;
constexpr float RMS_EPS = 1e-6f;
#define EPI_STORE8(ptr, v0, v1) do { u32x4 w_; w_.x = cvt_pk_bf16((v0)[0], (v0)[1]); w_.y = cvt_pk_bf16((v0)[2], (v0)[3]); w_.z = cvt_pk_bf16((v1)[0], (v1)[1]); w_.w = cvt_pk_bf16((v1)[2], (v1)[3]); *(GAS u32x4*)(ptr) = w_; } while (0)
struct EpiPlain {
    static constexpr bool PERM = true, AFTER_DRAIN = false;
    GAS bf16_t* O; int ldc;
    __device__ __forceinline__ void operator()(const f32x4 (&acc)[2][2][4][2], const Unit& u, int wr, int wc, int fr, int fq) const {
        const int row0 = u.pm * BM + wr * 64 + fr, col0 = u.pn * BM + wc * 32 + 8 * fq;
#pragma unroll
        for (int ai = 0; ai < 2; ++ai)
#pragma unroll
            for (int m = 0; m < 4; ++m) { GAS bf16_t* rowp = O + (size_t)(row0 + ai * HALF + m * 16) * ldc + col0;
#pragma unroll
                for (int bj = 0; bj < 2; ++bj) EPI_STORE8(rowp + bj * HALF, acc[ai][bj][m][0], acc[ai][bj][m][1]); }
    }
};
__device__ __forceinline__ float silu_mul(float g, float u) { return g * u * __builtin_amdgcn_rcpf(1.0f + __builtin_amdgcn_exp2f(-g * LOG2E)); }
struct EpiSwiGLU {
    static constexpr bool PERM = true, AFTER_DRAIN = false;
    GAS bf16_t* O; int ldc; const GAS float* rinv; PG8_LAS float* tab;
    __device__ __forceinline__ void operator()(const f32x4 (&acc)[2][2][4][2], const Unit& u, int wr, int wc, int fr, int fq) const {
        const int row0 = u.pm * BM + wr * 64 + fr, col0 = u.pn * HALF + wc * 32 + 8 * fq;
        __builtin_amdgcn_s_barrier();
        { const int t = threadIdx.x; if (t < 256) tab[t] = rinv[u.pm * BM + t]; }
        asm volatile("s_waitcnt lgkmcnt(0)" ::: "memory"); __builtin_amdgcn_s_barrier(); asm volatile("" ::: "memory");
#pragma unroll
        for (int ai = 0; ai < 2; ++ai)
#pragma unroll
            for (int m = 0; m < 4; ++m) { GAS bf16_t* rowp = O + (size_t)(row0 + ai * HALF + m * 16) * ldc + col0; const float rs = tab[ai * HALF + wr * 64 + m * 16 + fr];
                f32x4 v0, v1;
#pragma unroll
                for (int e = 0; e < 4; ++e) { v0[e] = silu_mul(acc[ai][0][m][0][e] * rs, acc[ai][1][m][0][e] * rs); v1[e] = silu_mul(acc[ai][0][m][1][e] * rs, acc[ai][1][m][1][e] * rs); }
                EPI_STORE8(rowp, v0, v1); }
    }
};
struct EpiInProj {
    static constexpr bool PERM = true, AFTER_DRAIN = false;
    GAS bf16_t* Z; GAS float* SSP; const GAS float* rinv; PG8_LAS float* tab;
    __device__ __forceinline__ void operator()(const f32x4 (&acc)[2][2][4][2], const Unit& u, int wr, int wc, int fr, int fq) const {
        const int row0 = u.pm * BM + wr * 64 + fr;
        __builtin_amdgcn_s_barrier();
        { const int t = threadIdx.x; if (t < 256) tab[t] = rinv[u.pm * BM + t]; }
        asm volatile("s_waitcnt lgkmcnt(0)" ::: "memory"); __builtin_amdgcn_s_barrier(); asm volatile("" ::: "memory");
#pragma unroll
        for (int bj = 0; bj < 2; ++bj) {
            const int G = 8 * u.pn + 4 * bj + wc, col0 = 32 * G;
            if (col0 >= 2592) continue;
            const float sc = (col0 >= 768 && col0 < 1024) ? 0.125f * LOG2E : 1.0f;
            const bool doss = (G >= 48 && G < 80); const int slot = G - 48;
#pragma unroll
            for (int ai = 0; ai < 2; ++ai)
#pragma unroll
                for (int m = 0; m < 4; ++m) { const int row = row0 + ai * HALF + m * 16; const float rs = tab[ai * HALF + wr * 64 + m * 16 + fr] * sc;
                    const f32x4 v0 = acc[ai][bj][m][0] * rs, v1 = acc[ai][bj][m][1] * rs;
                    if (doss) { float s = (v0[0] * v0[0] + v0[1] * v0[1]) + (v0[2] * v0[2] + v0[3] * v0[3]) + (v1[0] * v1[0] + v1[1] * v1[1]) + (v1[2] * v1[2] + v1[3] * v1[3]);
                        s += __shfl_xor(s, 16); s += __shfl_xor(s, 32); if (fq == 0) SSP[(size_t)row * 32 + slot] = s; }
                    EPI_STORE8(Z + (size_t)row * 2592 + col0 + 8 * fq, v0, v1); }
        }
    }
};
struct EpiRowScale {
    static constexpr bool PERM = true, AFTER_DRAIN = false;
    GAS bf16_t* O; int ldo; const GAS float* SSP; int slot0, nslot4; float invn, extra; int kmap; PG8_LAS float* tab;
    __device__ __forceinline__ void operator()(const f32x4 (&acc)[2][2][4][2], const Unit& u, int wr, int wc, int fr, int fq) const {
        const int row0 = u.pm * BM + wr * 64 + fr;
        __builtin_amdgcn_s_barrier();
        { const int t = threadIdx.x; if (t < 256) { const GAS f32x4* sp = (const GAS f32x4*)(SSP + (size_t)(u.pm * BM + t) * 32 + slot0); float s = 0.f;
            for (int k = 0; k < nslot4; ++k) { const f32x4 v = sp[k]; s += (v[0] + v[1]) + (v[2] + v[3]); }
            tab[t] = __builtin_amdgcn_rsqf(s * invn + RMS_EPS) * extra; } }
        asm volatile("s_waitcnt lgkmcnt(0)" ::: "memory"); __builtin_amdgcn_s_barrier(); asm volatile("" ::: "memory");
#pragma unroll
        for (int ai = 0; ai < 2; ++ai)
#pragma unroll
            for (int m = 0; m < 4; ++m) { const float rs = tab[ai * HALF + wr * 64 + m * 16 + fr];
#pragma unroll
                for (int bj = 0; bj < 2; ++bj) { const int c0 = u.pn * BM + bj * HALF + wc * 32; const int dc = (kmap ? 96 * (c0 >> 6) + (c0 & 63) : c0) + 8 * fq;
                    const f32x4 v0 = acc[ai][bj][m][0] * rs, v1 = acc[ai][bj][m][1] * rs;
                    EPI_STORE8(O + (size_t)(row0 + ai * HALF + m * 16) * ldo + dc, v0, v1); } }
    }
};
struct EpiColScale {
    static constexpr bool PERM = true, AFTER_DRAIN = false;
    GAS bf16_t* O; int ldo; const GAS float* SSP; PG8_LAS float* tab;
    __device__ __forceinline__ void operator()(const f32x4 (&acc)[2][2][4][2], const Unit& u, int wr, int wc, int fr, int fq) const {
        const int row0 = u.pm * BM + wr * 64 + fr;
        __builtin_amdgcn_s_barrier();
        { const int t = threadIdx.x; if (t < 256) { const GAS f32x4* sp = (const GAS f32x4*)(SSP + (size_t)(u.pn * BM + t) * 32 + 24); const f32x4 a = sp[0], b = sp[1];
            tab[t] = __builtin_amdgcn_rsqf(((a[0] + a[1]) + (a[2] + a[3]) + (b[0] + b[1]) + (b[2] + b[3])) * (1.0f / 256.0f) + RMS_EPS); } }
        asm volatile("s_waitcnt lgkmcnt(0)" ::: "memory"); __builtin_amdgcn_s_barrier(); asm volatile("" ::: "memory");
#pragma unroll
        for (int bj = 0; bj < 2; ++bj) { const int cl = bj * HALF + wc * 32 + 8 * fq, c0 = u.pn * BM + cl;
            const f32x4 s0 = *(const PG8_LAS f32x4*)(tab + cl), s1 = *(const PG8_LAS f32x4*)(tab + cl + 4);
#pragma unroll
            for (int ai = 0; ai < 2; ++ai)
#pragma unroll
                for (int m = 0; m < 4; ++m) { const f32x4 v0 = acc[ai][bj][m][0] * s0, v1 = acc[ai][bj][m][1] * s1;
                    EPI_STORE8(O + (size_t)(row0 + ai * HALF + m * 16) * ldo + c0, v0, v1); } }
    }
};
template <class Epi, class Sched, bool ALIGN_EPI = false, bool SP2 = false>
__device__ __forceinline__ void gemm_phase(PG8_LAS unsigned char* lds, const Gemm g, const Sched& S, const Epi& E) {
    int tid_l = threadIdx.x; asm volatile("" : "+v"(tid_l)); const int tid = tid_l, wid = __builtin_amdgcn_readfirstlane(tid >> 6), lane = tid & 63, wr = wid >> 2, wc = wid & 3, fr = lane & 15, fq = lane >> 4;
    int K_l = g.K; asm volatile("" : "+s"(K_l)); const int K = K_l, nt = K / BK;
    unsigned voffA[2], voffB[2];
#pragma unroll
    for (int i = 0; i < 2; ++i) { int R, C; stage_rc(tid * 16 + i * 8192, R, C); const int Rb = Epi::PERM ? ((R & ~31) + perm32(R & 31)) : R;
        voffA[i] = (unsigned)(R * g.lda + C) * 2u; voffB[i] = (unsigned)(Rb * g.ldb + C) * 2u; }
    const size_t kstep = (size_t)(BK * 2);
    const size_t hstepA = (size_t)HALF * g.lda * 2, hstepB = (size_t)HALF * g.ldb * 2;
    const size_t tstepA = 2 * hstepA, tstepB = 2 * hstepB;
    const unsigned ldsw = (unsigned)wid * 1024u;
    const int aoff = lds_byte(wr * 64 + fr, fq * 8), boff = lds_byte(wc * 32 + fr, fq * 8);
#define PG8_SA(b, h) (((b) * 2 + (h)) * HTB)
#define PG8_SB(b, h) ((4 + (b) * 2 + (h)) * HTB)
#define PG8_STAGE(bufoff, gbase, voff) do { _Pragma("unroll") for (int _i = 0; _i < 2; ++_i) \
        __builtin_amdgcn_global_load_lds((const unsigned*)((const char*)(gbase) + (voff)[_i]), (PG8_LAS unsigned*)(lds + (bufoff) + ldsw + _i * 8192), 16, 0, 0); } while (0)
#define PG8_LDA(dst, b, h) do { _Pragma("unroll") for (int m = 0; m < 4; ++m) _Pragma("unroll") for (int k = 0; k < 2; ++k) dst[m][k] = *(const PG8_LAS bf16x8*)(lds + PG8_SA(b, h) + aoff + m * 2048 + k * 1024); } while (0)
#define PG8_LDB(dst, b, h) do { _Pragma("unroll") for (int n = 0; n < 2; ++n) _Pragma("unroll") for (int k = 0; k < 2; ++k) dst[n][k] = *(const PG8_LAS bf16x8*)(lds + PG8_SB(b, h) + boff + n * 2048 + k * 1024); } while (0)
#define PG8_MMA(ai, bj, At, Bt) do { __builtin_amdgcn_s_setprio(1); _Pragma("unroll") for (int m = 0; m < 4; ++m) _Pragma("unroll") for (int n = 0; n < 2; ++n) _Pragma("unroll") for (int k = 0; k < 2; ++k) \
        acc[ai][bj][m][n] = __builtin_amdgcn_mfma_f32_16x16x32_bf16(Bt[n][k], At[m][k], acc[ai][bj][m][n], 0, 0, 0); __builtin_amdgcn_s_setprio(0); } while (0)
#define PG8_WAIT_V(n) asm volatile("s_waitcnt vmcnt(" #n ")" ::: "memory")
#define PG8_WAIT_L(n) asm volatile("s_waitcnt lgkmcnt(" #n ")" ::: "memory")
#define PG8_BAR __builtin_amdgcn_s_barrier()
#define PG8_SCHED __builtin_amdgcn_sched_barrier(0)
    Unit cur, nxt; int ui = 0;
    if (!S.next(0, cur)) return;
    f32x4 acc[2][2][4][2];
#pragma unroll
    for (int a = 0; a < 2; ++a)
#pragma unroll
        for (int b = 0; b < 2; ++b)
#pragma unroll
            for (int m = 0; m < 4; ++m)
#pragma unroll
                for (int n = 0; n < 2; ++n) acc[a][b][m][n] = (f32x4){0.f, 0.f, 0.f, 0.f};
    bf16x8 At[4][2], B0[2][2], B1[2][2];
    const char* cA = (const char*)g.A + (size_t)cur.pm * tstepA; const char* cB = (const char*)g.Bt + (size_t)cur.pn * tstepB;
    S.a_ready(cur);
    if constexpr (SP2) {
        PG8_STAGE(PG8_SB(0, 0), cB, voffB); PG8_STAGE(PG8_SB(0, 1), cB + hstepB, voffB); PG8_STAGE(PG8_SA(0, 0), cA, voffA); PG8_STAGE(PG8_SA(0, 1), cA + hstepA, voffA);
        if (wr == 1) PG8_BAR;
        PG8_WAIT_V(2); PG8_BAR;
        PG8_STAGE(PG8_SB(1, 0), cB + kstep, voffB); PG8_STAGE(PG8_SA(1, 0), cA + kstep, voffA); PG8_STAGE(PG8_SB(1, 1), cB + hstepB + kstep, voffB);
        PG8_WAIT_V(6); PG8_BAR;
    } else {
        PG8_STAGE(PG8_SB(0, 0), cB, voffB); PG8_STAGE(PG8_SA(0, 0), cA, voffA); PG8_STAGE(PG8_SB(0, 1), cB + hstepB, voffB); PG8_STAGE(PG8_SA(0, 1), cA + hstepA, voffA);
        if (wr == 1) PG8_BAR;
        PG8_WAIT_V(4); PG8_BAR;
        PG8_STAGE(PG8_SB(1, 0), cB + kstep, voffB); PG8_STAGE(PG8_SA(1, 0), cA + kstep, voffA); PG8_STAGE(PG8_SB(1, 1), cB + hstepB + kstep, voffB);
        PG8_WAIT_V(6); PG8_BAR;
    }
    for (;;) {
        const bool has_next = S.next(ui + 1, nxt);
        const char* nA = has_next ? (const char*)g.A + (size_t)nxt.pm * tstepA : cA; const char* nB = has_next ? (const char*)g.Bt + (size_t)nxt.pn * tstepB : cB;
        for (int t = 0; t < nt; t += 2) {
            const bool last = (t == nt - 2);
            const char* a1 = cA + (size_t)(t + 1) * kstep;
            const char* a2 = last ? nA : cA + (size_t)(t + 2) * kstep; const char* b2 = last ? nB : cB + (size_t)(t + 2) * kstep;
            const char* a3 = a2 + kstep; const char* b3 = b2 + kstep;
            if (last && has_next) S.a_ready(nxt);
            if constexpr (SP2) {
            PG8_LDB(B0, 0, 0); PG8_LDB(B1, 0, 1); PG8_SCHED; PG8_LDA(At, 0, 0); PG8_STAGE(PG8_SA(1, 1), a1 + hstepA, voffA);
            PG8_WAIT_V(8); PG8_WAIT_L(0); PG8_BAR; PG8_MMA(0, 0, At, B0); PG8_MMA(0, 1, At, B1); PG8_BAR; PG8_SCHED;
            PG8_LDA(At, 0, 1); PG8_STAGE(PG8_SB(0, 0), b2, voffB); PG8_STAGE(PG8_SB(0, 1), b2 + hstepB, voffB); PG8_STAGE(PG8_SA(0, 0), a2, voffA);
            PG8_WAIT_V(8); PG8_WAIT_L(0); PG8_BAR; PG8_MMA(1, 0, At, B0); PG8_MMA(1, 1, At, B1); PG8_BAR; PG8_SCHED;
            PG8_LDB(B0, 1, 0); PG8_LDB(B1, 1, 1); PG8_SCHED; PG8_LDA(At, 1, 0); PG8_STAGE(PG8_SA(0, 1), a2 + hstepA, voffA);
            PG8_WAIT_V(8); PG8_WAIT_L(0); PG8_BAR; PG8_MMA(0, 0, At, B0); PG8_MMA(0, 1, At, B1); PG8_BAR; PG8_SCHED;
            PG8_LDA(At, 1, 1); PG8_STAGE(PG8_SB(1, 0), b3, voffB); PG8_STAGE(PG8_SB(1, 1), b3 + hstepB, voffB); PG8_STAGE(PG8_SA(1, 0), a3, voffA);
            PG8_WAIT_V(8); PG8_WAIT_L(0); PG8_BAR; PG8_MMA(1, 0, At, B0); PG8_MMA(1, 1, At, B1); PG8_BAR; PG8_SCHED;
            } else {
            PG8_LDB(B0, 0, 0); PG8_SCHED; PG8_LDA(At, 0, 0); PG8_STAGE(PG8_SA(1, 1), a1 + hstepA, voffA);
            PG8_WAIT_L(8); PG8_BAR; PG8_WAIT_L(0); PG8_MMA(0, 0, At, B0); PG8_BAR; PG8_SCHED;
            PG8_LDB(B1, 0, 1); PG8_STAGE(PG8_SB(0, 0), b2, voffB);
            PG8_BAR; PG8_WAIT_L(0); PG8_MMA(0, 1, At, B1); PG8_BAR;
            PG8_LDA(At, 0, 1); PG8_STAGE(PG8_SA(0, 0), a2, voffA);
            PG8_BAR; PG8_WAIT_L(0); PG8_MMA(1, 0, At, B0); PG8_BAR; PG8_SCHED;
            PG8_STAGE(PG8_SB(0, 1), b2 + hstepB, voffB);
            PG8_WAIT_V(6); PG8_BAR; PG8_MMA(1, 1, At, B1); PG8_BAR;
            PG8_LDB(B0, 1, 0); PG8_SCHED; PG8_LDA(At, 1, 0); PG8_STAGE(PG8_SA(0, 1), a2 + hstepA, voffA);
            PG8_WAIT_L(8); PG8_BAR; PG8_WAIT_L(0); PG8_MMA(0, 0, At, B0); PG8_BAR; PG8_SCHED;
            PG8_LDB(B1, 1, 1); PG8_STAGE(PG8_SB(1, 0), b3, voffB);
            PG8_BAR; PG8_WAIT_L(0); PG8_MMA(0, 1, At, B1); PG8_BAR;
            PG8_LDA(At, 1, 1); PG8_STAGE(PG8_SA(1, 0), a3, voffA);
            PG8_BAR; PG8_WAIT_L(0); PG8_MMA(1, 0, At, B0); PG8_BAR; PG8_SCHED;
            PG8_STAGE(PG8_SB(1, 1), b3 + hstepB, voffB);
            PG8_WAIT_V(6); PG8_BAR; PG8_MMA(1, 1, At, B1); PG8_BAR;
            }
        }
        if constexpr (ALIGN_EPI) { if (wr == 0) PG8_BAR; }
        if constexpr (!Epi::AFTER_DRAIN) { E(acc, cur, wr, wc, fr, fq); S.done(cur); }
        if (!has_next) break;
#pragma unroll
        for (int a = 0; a < 2; ++a)
#pragma unroll
            for (int b = 0; b < 2; ++b)
#pragma unroll
                for (int m = 0; m < 4; ++m)
#pragma unroll
                    for (int n = 0; n < 2; ++n) acc[a][b][m][n] = (f32x4){0.f, 0.f, 0.f, 0.f};
        cur = nxt; cA = nA; cB = nB; ++ui;
        if constexpr (ALIGN_EPI) { if (wr == 1) PG8_BAR; }
    }
    PG8_WAIT_V(0);
    if constexpr (!ALIGN_EPI) { if (wr == 0) PG8_BAR; }
    PG8_BAR;
    if constexpr (Epi::AFTER_DRAIN) { E.fused(acc, cur, wr, wc, fr, fq, lds, wid, lane); S.done(cur); }
#undef PG8_SA
#undef PG8_SB
#undef PG8_STAGE
#undef PG8_LDA
#undef PG8_LDB
#undef PG8_MMA
#undef PG8_WAIT_V
#undef PG8_WAIT_L
#undef PG8_BAR
#undef PG8_SCHED
}
}
#define LAS __attribute__((address_space(3)))
typedef unsigned short bf16;
typedef unsigned u32x4 __attribute__((ext_vector_type(4)));
typedef unsigned u32x2 __attribute__((ext_vector_type(2)));
typedef float f32x4 __attribute__((ext_vector_type(4)));
typedef float f32x16 __attribute__((ext_vector_type(16)));
typedef short bf16x8 __attribute__((ext_vector_type(8)));
typedef short s16x4 __attribute__((ext_vector_type(4)));
using pg8::cvt_pk_bf16; using pg8::LOG2E; using pg8::RMS_EPS;

constexpr int NWAVES = 8, NTHR = 512;
constexpr int DM = 1024, FF = 2816, ZP = 2592, NINP = 2816, DEPTH = 4;
constexpr int MP = 67072;
constexpr int G0_ROWS = 33792, G1_ROWS = 33280;
constexpr size_t MiB = 1u << 20;
constexpr size_t WS_RINV = 1 * MiB + 640 * 1024;
constexpr size_t WS_CTL = 0, WS_ROPE = 1 * MiB, WS_SSP = 2 * MiB, WS_METAH = 11 * MiB, WS_W = 13 * MiB, WS_XY = 61 * MiB, WS_BIG = 192 * MiB, WS_END = 574 * MiB;
constexpr size_t W_GU1 = 0, W_DN1 = 11 * MiB, W_GU2 = 33 * MiB / 2, W_DN2 = 55 * MiB / 2, W_IN = 33 * MiB, W_UQ = 77 * MiB / 2, W_UK = 40 * MiB, W_UV = 40 * MiB + MiB / 4, W_O = 40 * MiB + MiB / 2;
constexpr size_t B_Z = 0, B_K = 168 * MiB, B_VT = 218 * MiB, B_YC = 251 * MiB;
constexpr int LDS_BYTES = 147456;
constexpr int A_K = 0, A_KBUF = 64 * 208, A_V = 2 * A_KBUF, A_VBUF = 64 * 144, A_WSF = A_V + 2 * A_VBUF, A_STG = A_WSF + 8 * 256, A_TAB = A_STG + 8 * 4096, A_UW = A_TAB + 4 * 640 * 4 + 256;
static_assert(A_UW + 64 <= 131072, "attention LDS");

struct Args { const float* in[25]; float* out; unsigned char* ws; };
typedef const __attribute__((address_space(4))) Args KArgs;
typedef KArgs* KArgsP;
enum { I_XP = 0, I_XS, I_META, I_F1PRE, I_F1GU, I_F1DN, I_F1POST, I_MPRE, I_WIN, I_CONVW, I_RPB, I_MB, I_QN, I_WUQ, I_KVN, I_WUKV, I_CON, I_NON, I_MON, I_WO, I_MPOST, I_F2PRE, I_F2GU, I_F2DN, I_F2POST };

__device__ __forceinline__ float bf2f(unsigned short b) { return __uint_as_float((unsigned)b << 16); }
__device__ __forceinline__ float bflo(unsigned w) { return __uint_as_float(w << 16); }
__device__ __forceinline__ float bfhi(unsigned w) { return __uint_as_float(w & 0xffff0000u); }
__device__ __forceinline__ float wave_sum(float v) {
#pragma unroll
    for (int o = 1; o < 64; o <<= 1) v += __shfl_xor(v, o);
    return v;
}
__device__ __forceinline__ void row_decode(int row, int& s, int& i, int& T) {
    if (row < G0_ROWS) { s = row / 2112; i = row - s * 2112; T = 2048; } else { const int r = row - G0_ROWS, q = r / 4160; s = 16 + q; i = r - q * 4160; T = 4096; }
}
__device__ __forceinline__ GAS float* hptr(GAS float* out, GAS float* metah, int s, int i, int T) {
    if (i < T) { const size_t ob = s < 16 ? (size_t)s * 2048 : (size_t)32768 + (size_t)(s - 16) * 4096; return out + (ob + i) * DM; }
    return metah + (size_t)(s * 16 + (i - T)) * DM;
}
__device__ __forceinline__ void wt_item(const GAS float* W, int ldw, int K, GAS bf16* WT, const GAS float* gain, int k0, int srcn0, int dstn0, LAS float* scr, int lane) {
    const int c = lane & 7;
    if (srcn0 < 0) {
#pragma unroll
        for (int j = 0; j < 4; ++j) { const int n = (lane >> 3) + 8 * j; *(GAS u32x4*)(WT + (size_t)(dstn0 + n) * K + k0 + 8 * c) = (u32x4){0u, 0u, 0u, 0u}; }
        return;
    }
#pragma unroll 8
    for (int i = 0; i < 32; ++i) { const int kk = 2 * i + (lane >> 5); float v = W[(size_t)(k0 + kk) * ldw + srcn0 + (lane & 31)]; if (gain) v *= gain[k0 + kk]; scr[kk * 33 + (lane & 31)] = v; }
    asm volatile("s_waitcnt lgkmcnt(0)" ::: "memory");
#pragma unroll
    for (int j = 0; j < 4; ++j) { const int n = (lane >> 3) + 8 * j; const LAS float* s = scr + (8 * c) * 33 + n;
        u32x4 o; o.x = cvt_pk_bf16(s[0 * 33], s[1 * 33]); o.y = cvt_pk_bf16(s[2 * 33], s[3 * 33]); o.z = cvt_pk_bf16(s[4 * 33], s[5 * 33]); o.w = cvt_pk_bf16(s[6 * 33], s[7 * 33]);
        *(GAS u32x4*)(WT + (size_t)(dstn0 + n) * K + k0 + 8 * c) = o; }
    asm volatile("s_waitcnt lgkmcnt(0)" ::: "memory");
}
__device__ __forceinline__ void convert_layer(KArgsP ap, int l, LAS float* scr, int gw, int NGW, int lane) {
    const KArgs& a = *ap;
    GAS unsigned char* wb = (GAS unsigned char*)(a.ws + WS_W);
    constexpr int N_GU = 16 * 176, N_DN = 44 * 32, N_IN = 16 * 88, N_UQ = 12 * 24, N_UK = 4 * 16, N_WO = 16 * 32;
    constexpr int TOT = 2 * N_GU + 2 * N_DN + N_IN + N_UQ + 2 * N_UK + N_WO;
    for (int it = gw; it < TOT; it += NGW) {
        int r = it;
        if (r < 2 * N_GU) { const int f = r / N_GU; r -= f * N_GU; const int kb = r / 176, nb = r % 176; const int sb = ((nb >> 2) & 1) * 88 + 4 * (nb >> 3) + (nb & 3);
            wt_item((const GAS float*)a.in[f ? I_F2GU : I_F1GU] + (size_t)l * 1024 * 5632, 5632, 1024, (GAS bf16*)(wb + (f ? W_GU2 : W_GU1)), (const GAS float*)a.in[f ? I_F2PRE : I_F1PRE] + l * 1024, 64 * kb, 32 * sb, 32 * nb, scr, lane); continue; }
        r -= 2 * N_GU;
        if (r < 2 * N_DN) { const int f = r / N_DN; r -= f * N_DN; const int kb = r / 32, nb = r % 32;
            wt_item((const GAS float*)a.in[f ? I_F2DN : I_F1DN] + (size_t)l * 2816 * 1024, 1024, 2816, (GAS bf16*)(wb + (f ? W_DN2 : W_DN1)), nullptr, 64 * kb, 32 * nb, 32 * nb, scr, lane); continue; }
        r -= 2 * N_DN;
        if (r < N_IN) { const int kb = r / 88, nb = r % 88;
            wt_item((const GAS float*)a.in[I_WIN] + (size_t)l * 1024 * 2592, 2592, 1024, (GAS bf16*)(wb + W_IN), (const GAS float*)a.in[I_MPRE] + l * 1024, 64 * kb, nb < 81 ? 32 * nb : -1, 32 * nb, scr, lane); continue; }
        r -= N_IN;
        if (r < N_UQ) { const int kb = r / 24, nb = r % 24;
            wt_item((const GAS float*)a.in[I_WUQ] + (size_t)l * 768 * 768, 768, 768, (GAS bf16*)(wb + W_UQ), (const GAS float*)a.in[I_QN] + l * 768, 64 * kb, 32 * nb, 32 * nb, scr, lane); continue; }
        r -= N_UQ;
        if (r < 2 * N_UK) { const int v = r / N_UK; r -= v * N_UK; const int kb = r / 16, nb = r % 16; const int sb = (nb >> 1) * 4 + 2 * v + (nb & 1);
            wt_item((const GAS float*)a.in[I_WUKV] + (size_t)l * 256 * 1024, 1024, 256, (GAS bf16*)(wb + (v ? W_UV : W_UK)), (const GAS float*)a.in[I_KVN] + l * 256, 64 * kb, 32 * sb, 32 * nb, scr, lane); continue; }
        r -= 2 * N_UK;
        { const int kb = r / 32, nb = r % 32; const int k0 = 64 * kb;
            const GAS float* gain = k0 < 256 ? (const GAS float*)a.in[I_CON] + l * 256 : (k0 < 512 ? (const GAS float*)a.in[I_NON] + l * 256 - 256 : (const GAS float*)a.in[I_MON] + l * 512 - 512);
            wt_item((const GAS float*)a.in[I_WO] + (size_t)l * 1024 * 1024, 1024, 1024, (GAS bf16*)(wb + W_O), gain, k0, 32 * nb, 32 * nb, scr, lane); }
    }
}
__device__ __forceinline__ void wave_sum2(float& a, float& b) {
#pragma unroll
    for (int o = 1; o < 64; o <<= 1) { const float ta = __shfl_xor(a, o), tb = __shfl_xor(b, o); a += ta; b += tb; }
}
__device__ __forceinline__ void rowpass(KArgsP ap, const GAS float* gpost, float coef, bool init, int row_lo, int row_hi, int gw, int NGW, int lane) {
    const KArgs& a = *ap;
    GAS bf16* XY = (GAS bf16*)(a.ws + WS_XY); const GAS bf16* YB = (const GAS bf16*)a.out; GAS float* RINV = (GAS float*)(a.ws + WS_RINV);
    f32x4 g[4];
#pragma unroll
    for (int j = 0; j < 4; ++j) g[j] = init ? (f32x4){0.f, 0.f, 0.f, 0.f} : ((const GAS f32x4*)gpost)[lane + 64 * j] * coef;
    for (int row0 = row_lo + gw; row0 < row_hi; row0 += 2 * NGW) {
        GAS unsigned long long* xy8[2]; bool val[2], ex[2]; int rw[2]; f32x4 h[2][4]; unsigned long long yw[2][4];
#pragma unroll
        for (int k = 0; k < 2; ++k) {
            const int row = row0 + k * NGW; ex[k] = row < row_hi; rw[k] = ex[k] ? row : 0; int s = 0, i = 0, T = 1; row_decode(rw[k], s, i, T);
            val[k] = ex[k] && (i < T + 16);
            xy8[k] = (GAS unsigned long long*)(XY + (size_t)rw[k] * DM) + lane;
#pragma unroll
            for (int j = 0; j < 4; ++j) { h[k][j] = (f32x4){0.f, 0.f, 0.f, 0.f}; yw[k][j] = 0ull; }
            if (val[k]) {
                if (init) { const GAS float* src = (i < T) ? (s < 16 ? (const GAS float*)a.in[I_XP] + ((size_t)s * 2048 + i) * DM : (const GAS float*)a.in[I_XS] + ((size_t)(s - 16) * 4096 + i) * DM) : (const GAS float*)a.in[I_META] + (size_t)(i - T) * DM;
#pragma unroll
                    for (int j = 0; j < 4; ++j) h[k][j] = ((const GAS f32x4*)src)[lane + 64 * j]; }
                else { const GAS unsigned long long* y8 = (const GAS unsigned long long*)(YB + (size_t)rw[k] * DM) + lane;
#pragma unroll
                    for (int j = 0; j < 4; ++j) { yw[k][j] = y8[64 * j]; const unsigned long long hw = xy8[k][64 * j]; const unsigned lo = (unsigned)hw, hi = (unsigned)(hw >> 32); h[k][j] = (f32x4){bflo(lo), bfhi(lo), bflo(hi), bfhi(hi)}; } }
            }
        }
        f32x4 y[2][4]; float ss[2] = {0.f, 0.f};
#pragma unroll
        for (int k = 0; k < 2; ++k)
#pragma unroll
            for (int j = 0; j < 4; ++j) { const unsigned lo = (unsigned)yw[k][j], hi = (unsigned)(yw[k][j] >> 32);
                y[k][j] = (f32x4){bflo(lo), bfhi(lo), bflo(hi), bfhi(hi)}; ss[k] += (y[k][j][0] * y[k][j][0] + y[k][j][1] * y[k][j][1]) + (y[k][j][2] * y[k][j][2] + y[k][j][3] * y[k][j][3]); }
        if (!init) wave_sum2(ss[0], ss[1]);
        float s2[2] = {0.f, 0.f}; unsigned long long ow[2][4];
#pragma unroll
        for (int k = 0; k < 2; ++k) { const float ry = __builtin_amdgcn_rsqf(ss[k] * (1.0f / DM) + RMS_EPS);
#pragma unroll
            for (int j = 0; j < 4; ++j) { if (!init) h[k][j] = h[k][j] + y[k][j] * g[j] * ry;
                const unsigned lo = cvt_pk_bf16(h[k][j][0], h[k][j][1]), hi = cvt_pk_bf16(h[k][j][2], h[k][j][3]); ow[k][j] = (unsigned long long)lo | ((unsigned long long)hi << 32);
                const f32x4 hr = (f32x4){bflo(lo), bfhi(lo), bflo(hi), bfhi(hi)};
                s2[k] += (hr[0] * hr[0] + hr[1] * hr[1]) + (hr[2] * hr[2] + hr[3] * hr[3]); } }
        wave_sum2(s2[0], s2[1]);
#pragma unroll
        for (int k = 0; k < 2; ++k) if (ex[k]) {
#pragma unroll
            for (int j = 0; j < 4; ++j) xy8[k][64 * j] = val[k] ? ow[k][j] : 0ull;
            if (lane == 0) RINV[rw[k]] = val[k] ? __builtin_amdgcn_rsqf(s2[k] * (1.0f / DM) + RMS_EPS) : 0.f; }
    }
}
__device__ __forceinline__ void output_pass(KArgsP ap, int gw, int NGW, int lane) {
    const KArgs& a = *ap; const GAS bf16* XY = (const GAS bf16*)(a.ws + WS_XY); GAS float* out = (GAS float*)a.out;
    for (int row = gw; row < MP; row += NGW) {
        int s, i, T; row_decode(row, s, i, T); if (i >= T) continue;
        const size_t ob = s < 16 ? (size_t)s * 2048 : (size_t)32768 + (size_t)(s - 16) * 4096;
        const GAS unsigned long long* x8 = (const GAS unsigned long long*)(XY + (size_t)row * DM) + lane; GAS f32x4* o = (GAS f32x4*)(out + (ob + i) * DM) + lane;
#pragma unroll
        for (int j = 0; j < 4; ++j) { const unsigned long long w = x8[64 * j]; const unsigned lo = (unsigned)w, hi = (unsigned)(w >> 32); o[64 * j] = (f32x4){bflo(lo), bfhi(lo), bflo(hi), bfhi(hi)}; }
    }
}
__device__ __forceinline__ void rope_table(GAS float* tab, int gt, int NGT) {
    for (int e = gt; e < 4112 * 16; e += NGT) { const int pos = e >> 4, j = e & 15; double f = 1.0; for (int k = 0; k < j; ++k) f *= 0.56234132519034907;
        double rev = (double)pos * f * 0.15915494309189535; rev -= __builtin_floor(rev); const float rv = (float)rev;
        tab[2 * e] = __builtin_amdgcn_cosf(rv); tab[2 * e + 1] = __builtin_amdgcn_sinf(rv); }
}
struct Grp { int row0, rows, T, Lp, nseq; };
__device__ __forceinline__ Grp grp_of(int g) { Grp r; if (g == 0) { r.row0 = 0; r.rows = G0_ROWS; r.T = 2048; r.Lp = 2112; r.nseq = 16; } else { r.row0 = G0_ROWS; r.rows = G1_ROWS; r.T = 4096; r.Lp = 4160; r.nseq = 8; } return r; }
__device__ __forceinline__ f32x4 cprod(unsigned long long c, unsigned long long u) {
    return (f32x4){bflo((unsigned)c) * bflo((unsigned)u), bfhi((unsigned)c) * bfhi((unsigned)u), bflo((unsigned)(c >> 32)) * bflo((unsigned)(u >> 32)), bfhi((unsigned)(c >> 32)) * bfhi((unsigned)(u >> 32))};
}
__device__ __forceinline__ void conv_kpe_pass(KArgsP ap, int l, const Grp& G, int gw, int NGW, int lane) {
    const KArgs& a = *ap;
    const GAS bf16* Z = (const GAS bf16*)(a.ws + WS_BIG + B_Z); GAS bf16* KB = (GAS bf16*)(a.ws + WS_BIG + B_K); GAS bf16* YC = (GAS bf16*)(a.ws + WS_BIG + B_YC) + (size_t)G.row0 * DM;
    const GAS float* cw = (const GAS float*)a.in[I_CONVW] + (size_t)l * 3 * 256; const GAS float* rope = (const GAS float*)(a.ws + WS_ROPE);
    const f32x4 w0 = ((const GAS f32x4*)cw)[lane], w1 = ((const GAS f32x4*)(cw + 256))[lane], w2 = ((const GAS f32x4*)(cw + 512))[lane];
    const int T = G.T;
    for (int gr0 = gw; gr0 < G.rows; gr0 += 2 * NGW) {
        bool ex[2], val[2]; int grr[2], pp[2]; unsigned long long cb[2], cc[2], cu[2], lc[2], lu[2], rc[2], ru[2]; unsigned short x1[2], x2[2]; float rcs[2], rsn[2];
#pragma unroll
        for (int k = 0; k < 2; ++k) {
            const int gr = gr0 + k * NGW; ex[k] = gr < G.rows; grr[k] = ex[k] ? gr : 0;
            const int sq = grr[k] / G.Lp, i = grr[k] - sq * G.Lp; val[k] = ex[k] && (i < T + 16);
            const int p = (i < T) ? 16 + i : i - T; pp[k] = val[k] ? p : 0;
            const int il = (p == 0) ? -1 : ((p - 1 >= 16) ? p - 17 : T + p - 1), ir = (p == T + 15) ? -1 : ((p + 1 >= 16) ? p - 15 : T + p + 1);
            cb[k] = cc[k] = cu[k] = lc[k] = lu[k] = rc[k] = ru[k] = 0ull; x1[k] = x2[k] = 0; rcs[k] = 1.f; rsn[k] = 0.f;
            if (val[k]) {
                const GAS bf16* zr = Z + (size_t)grr[k] * ZP;
                cb[k] = *((const GAS unsigned long long*)zr + lane); cc[k] = *((const GAS unsigned long long*)(zr + 256) + lane); cu[k] = *((const GAS unsigned long long*)(zr + 512) + lane);
                if (il >= 0) { const GAS bf16* z2 = Z + (size_t)(sq * G.Lp + il) * ZP; lc[k] = *((const GAS unsigned long long*)(z2 + 256) + lane); lu[k] = *((const GAS unsigned long long*)(z2 + 512) + lane); }
                if (ir >= 0) { const GAS bf16* z2 = Z + (size_t)(sq * G.Lp + ir) * ZP; rc[k] = *((const GAS unsigned long long*)(z2 + 256) + lane); ru[k] = *((const GAS unsigned long long*)(z2 + 512) + lane); }
                if (lane < 16) { x1[k] = zr[2560 + lane]; x2[k] = zr[2576 + lane]; rcs[k] = rope[(size_t)p * 32 + 2 * lane]; rsn[k] = rope[(size_t)p * 32 + 2 * lane + 1]; }
            }
        }
        f32x4 y[2]; float ss[2];
#pragma unroll
        for (int k = 0; k < 2; ++k) { const f32x4 cbv = (f32x4){bflo((unsigned)cb[k]), bfhi((unsigned)cb[k]), bflo((unsigned)(cb[k] >> 32)), bfhi((unsigned)(cb[k] >> 32))};
            y[k] = cbv * (w0 * cprod(lc[k], lu[k]) + w1 * cprod(cc[k], cu[k]) + w2 * cprod(rc[k], ru[k]));
            ss[k] = (y[k][0] * y[k][0] + y[k][1] * y[k][1]) + (y[k][2] * y[k][2] + y[k][3] * y[k][3]); }
        wave_sum2(ss[0], ss[1]);
#pragma unroll
        for (int k = 0; k < 2; ++k) if (ex[k]) {
            const float rn = __builtin_amdgcn_rsqf(ss[k] * (1.0f / 256.0f) + RMS_EPS); const f32x4 o = y[k] * rn;
            *((GAS unsigned long long*)(YC + (size_t)grr[k] * DM) + lane) = (unsigned long long)cvt_pk_bf16(o[0], o[1]) | ((unsigned long long)cvt_pk_bf16(o[2], o[3]) << 32);
            if (lane < 16) { const float a1 = bf2f(x1[k]), a2 = bf2f(x2[k]); const unsigned pk = cvt_pk_bf16(a1 * rcs[k] - a2 * rsn[k], a1 * rsn[k] + a2 * rcs[k]); const bf16 o1 = (bf16)(pk & 0xffffu), o2 = (bf16)(pk >> 16);
#pragma unroll
                for (int h = 0; h < 8; ++h) { KB[(size_t)grr[k] * 768 + 96 * h + 64 + lane] = o1; KB[(size_t)grr[k] * 768 + 96 * h + 80 + lane] = o2; } }
        }
    }
}
__device__ __forceinline__ void ynorm_pass(KArgsP ap, int gw, int NGW, int lane) {
    const KArgs& a = *ap;
    GAS bf16* YC = (GAS bf16*)(a.ws + WS_BIG + B_YC);
    for (int gr0 = gw; gr0 < MP; gr0 += 2 * NGW) {
        bool ex[2], val[2]; GAS unsigned long long* p1[2]; GAS u32x4* p2[2]; unsigned long long w[2]; u32x4 v[2];
#pragma unroll
        for (int k = 0; k < 2; ++k) { const int gr = gr0 + k * NGW; ex[k] = gr < MP; const int g2 = ex[k] ? gr : 0; int sq, i, T; row_decode(g2, sq, i, T); val[k] = ex[k] && (i < T + 16);
            p1[k] = (GAS unsigned long long*)(YC + (size_t)g2 * DM + 256) + lane; p2[k] = (GAS u32x4*)(YC + (size_t)g2 * DM + 512) + lane;
            w[k] = 0ull; v[k] = (u32x4){0u, 0u, 0u, 0u}; if (val[k]) { w[k] = *p1[k]; v[k] = *p2[k]; } }
        float y[2][4], z[2][8], s1[2], s2[2];
#pragma unroll
        for (int k = 0; k < 2; ++k) { y[k][0] = bflo((unsigned)w[k]); y[k][1] = bfhi((unsigned)w[k]); y[k][2] = bflo((unsigned)(w[k] >> 32)); y[k][3] = bfhi((unsigned)(w[k] >> 32));
            z[k][0] = bflo(v[k].x); z[k][1] = bfhi(v[k].x); z[k][2] = bflo(v[k].y); z[k][3] = bfhi(v[k].y); z[k][4] = bflo(v[k].z); z[k][5] = bfhi(v[k].z); z[k][6] = bflo(v[k].w); z[k][7] = bfhi(v[k].w);
            s1[k] = (y[k][0] * y[k][0] + y[k][1] * y[k][1]) + (y[k][2] * y[k][2] + y[k][3] * y[k][3]); s2[k] = 0.f;
#pragma unroll
            for (int e = 0; e < 8; ++e) s2[k] += z[k][e] * z[k][e]; }
        wave_sum2(s1[0], s1[1]); wave_sum2(s2[0], s2[1]);
#pragma unroll
        for (int k = 0; k < 2; ++k) if (ex[k]) {
            const float r1 = val[k] ? __builtin_amdgcn_rsqf(s1[k] * (1.0f / 256.0f) + RMS_EPS) : 0.f, r2 = val[k] ? __builtin_amdgcn_rsqf(s2[k] * (1.0f / 512.0f) + RMS_EPS) : 0.f;
            *p1[k] = (unsigned long long)cvt_pk_bf16(y[k][0] * r1, y[k][1] * r1) | ((unsigned long long)cvt_pk_bf16(y[k][2] * r1, y[k][3] * r1) << 32);
            u32x4 o; o.x = cvt_pk_bf16(z[k][0] * r2, z[k][1] * r2); o.y = cvt_pk_bf16(z[k][2] * r2, z[k][3] * r2); o.z = cvt_pk_bf16(z[k][4] * r2, z[k][5] * r2); o.w = cvt_pk_bf16(z[k][6] * r2, z[k][7] * r2); *p2[k] = o; }
    }
}
struct AttG { const GAS bf16 *Q, *K, *VT, *Z; GAS bf16* YC; const GAS float* rope; int rows, T, Lp; };
__device__ __forceinline__ int crow(int r, int hi) { return (r & 3) + 8 * (r >> 2) + 4 * hi; }
#define MFMA32(a, b, c) __builtin_amdgcn_mfma_f32_32x32x16_bf16((a), (b), (c), 0, 0, 0)
template <int MODE>
__device__ __forceinline__ void attn_unit(const AttG& P, int seq, int head, int qb, LAS unsigned char* lds, int tid, int wid, int lane) {
    constexpr int DQK = MODE == 0 ? 96 : 64, NDK = DQK / 16, KP = DQK * 2 + 16, VP = 144;
    const int r32 = lane & 31, hi = lane >> 5;
    const int T = P.T, Lp = P.Lp, nqbr = T >> 8; const bool metablk = (qb == nqbr);
    const int sbase = seq * Lp;
    const int qi = qb * 256 + wid * 32 + r32; const int qic = qi < Lp - 1 ? qi : Lp - 1;
    bf16x8 qr[NDK];
    { const GAS bf16* qsrc = MODE == 0 ? P.Q + (size_t)(sbase + qic) * 768 + 96 * head : P.Z + (size_t)(sbase + qic) * ZP + 768 + 64 * head;
#pragma unroll
      for (int d0 = 0; d0 < NDK; ++d0) qr[d0] = *(const GAS bf16x8*)(qsrc + 16 * d0 + 8 * hi); }
    if constexpr (MODE == 0) {
        const int pos = qic < T ? 16 + qic : (qic - T < 15 ? qic - T : 15);
        const GAS f32x4* rp = (const GAS f32x4*)(P.rope + (size_t)pos * 32 + 16 * hi);
#pragma unroll
        for (int e2 = 0; e2 < 4; ++e2) { const f32x4 cs = rp[e2];
#pragma unroll
            for (int q = 0; q < 2; ++q) { const int e = 2 * e2 + q; const float c = cs[2 * q], s = cs[2 * q + 1];
                const float x1 = bf2f((unsigned short)qr[4][e]), x2 = bf2f((unsigned short)qr[5][e]);
                const unsigned pk = cvt_pk_bf16(x1 * c - x2 * s, x1 * s + x2 * c); qr[4][e] = (short)(pk & 0xffffu); qr[5][e] = (short)(pk >> 16); } }
    }
    int nt, kr_lo = 0; const int rows_total = T >> 6;
    int na_r = 0, na_c = 0, na_rs = 0, na_cs = 0;
    if constexpr (MODE == 0) nt = rows_total + 1;
    else {
        if (metablk) nt = 1;
        else { const int r0 = 4 * qb; int lo = r0 - 4; lo = lo < 0 ? 0 : (lo > rows_total - 8 ? rows_total - 8 : lo); int h2 = r0 - 1; h2 = h2 < 0 ? 0 : (h2 > rows_total - 8 ? rows_total - 8 : h2);
            kr_lo = lo; nt = (h2 + 7 - lo + 1) + 1; }
        na_r = 4 * qb + (wid >> 1); na_c = 32 * (wid & 1) + r32;
        na_rs = na_r - 4; na_rs = na_rs < 0 ? 0 : (na_rs > rows_total - 8 ? rows_total - 8 : na_rs);
        na_cs = na_c - 8; na_cs = na_cs < 0 ? 0 : (na_cs > 48 ? 48 : na_cs);
    }
    const LAS float* tabL = (const LAS float*)(lds + A_TAB) + head * 640 + 64;
    const LAS float* mbL = (const LAS float*)(lds + A_TAB + 4 * 640 * 4) + head * 16;
    LAS float* wsf = (LAS float*)(lds + A_WSF) + wid * 64;
    u32x4 kst0, kst1 = {0u, 0u, 0u, 0u}, vst;
    const int kc0 = tid, kc1 = 512 + tid;
#define TILE_KB(t) ((t) == nt - 1 ? T : 64 * (kr_lo + (t)))
#define GLOAD(t) do { const int kb_ = TILE_KB(t); \
      if constexpr (MODE == 0) { { const int krow = kc0 / 12, part = kc0 % 12; kst0 = *(const GAS u32x4*)(P.K + (size_t)(sbase + kb_ + krow) * 768 + 96 * head + 8 * part); } \
          if (tid < 256) { const int krow = kc1 / 12, part = kc1 % 12; kst1 = *(const GAS u32x4*)(P.K + (size_t)(sbase + kb_ + krow) * 768 + 96 * head + 8 * part); } \
          { const int d = tid >> 3, part = tid & 7; vst = *(const GAS u32x4*)(P.VT + (size_t)(64 * head + d) * P.rows + sbase + kb_ + 8 * part); } } \
      else { const int krow = tid >> 3, part = tid & 7; const GAS bf16* zr_ = P.Z + (size_t)(sbase + kb_ + krow) * ZP + 64 * head + 8 * part; kst0 = *(const GAS u32x4*)(zr_ + 1024); vst = *(const GAS u32x4*)(zr_ + 1280); } } while (0)
#define LSTORE(buf) do { LAS unsigned char* Kb_ = lds + A_K + (buf) * A_KBUF; LAS unsigned char* Vb_ = lds + A_V + (buf) * A_VBUF; \
      if constexpr (MODE == 0) { { const int krow = kc0 / 12, part = kc0 % 12; *(LAS u32x4*)(Kb_ + krow * KP + part * 16) = kst0; } \
          if (tid < 256) { const int krow = kc1 / 12, part = kc1 % 12; *(LAS u32x4*)(Kb_ + krow * KP + part * 16) = kst1; } \
          { const int d = tid >> 3, part = tid & 7; *(LAS u32x4*)(Vb_ + d * VP + part * 16) = vst; } } \
      else { const int krow = tid >> 3, part = tid & 7; *(LAS u32x4*)(Kb_ + krow * KP + part * 16) = kst0; \
          LAS unsigned short* vt_ = (LAS unsigned short*)(Vb_ + (8 * part) * VP + krow * 2); \
          vt_[0 * (VP / 2)] = (unsigned short)(vst.x & 0xffffu); vt_[1 * (VP / 2)] = (unsigned short)(vst.x >> 16); vt_[2 * (VP / 2)] = (unsigned short)(vst.y & 0xffffu); vt_[3 * (VP / 2)] = (unsigned short)(vst.y >> 16); \
          vt_[4 * (VP / 2)] = (unsigned short)(vst.z & 0xffffu); vt_[5 * (VP / 2)] = (unsigned short)(vst.z >> 16); vt_[6 * (VP / 2)] = (unsigned short)(vst.w & 0xffffu); vt_[7 * (VP / 2)] = (unsigned short)(vst.w >> 16); } } while (0)
    GLOAD(0); LSTORE(0);
    __syncthreads();
    float l_reg = 0.f; bool have_m0 = false;
    f32x16 o0, o1, negm;
#pragma unroll
    for (int r = 0; r < 16; ++r) { o0[r] = 0.f; o1[r] = 0.f; negm[r] = 0.f; }
    for (int t = 0; t < nt; ++t) {
        const int buf = t & 1; const bool more = (t + 1 < nt);
        if (more) GLOAD(t + 1);
        const bool is_meta = (t == nt - 1);
        bool active = true;
        if constexpr (MODE == 1) { if (!is_meta) { const int kr = kr_lo + t; active = (kr >= na_rs && kr <= na_rs + 7); } }
        if (active) {
            const LAS unsigned char* Kb = lds + A_K + buf * A_KBUF; const LAS unsigned char* Vb = lds + A_V + buf * A_VBUF;
            f32x16 p0 = negm, p1 = negm;
            bf16x8 kf[2 * NDK]; s16x4 vf[16];
#pragma unroll
            for (int d0 = 0; d0 < NDK; ++d0) {
                kf[2 * d0] = *(const LAS bf16x8*)(Kb + r32 * KP + d0 * 32 + hi * 16);
                kf[2 * d0 + 1] = *(const LAS bf16x8*)(Kb + (32 + r32) * KP + d0 * 32 + hi * 16);
            }
            __builtin_amdgcn_sched_barrier(0);
#pragma unroll
            for (int d0 = 0; d0 < NDK; ++d0) { p0 = MFMA32(kf[2 * d0], qr[d0], p0); p1 = MFMA32(kf[2 * d0 + 1], qr[d0], p1); }
            __builtin_amdgcn_sched_barrier(0);
#pragma unroll
            for (int ks = 0; ks < 4; ++ks) {
                const LAS unsigned char* vp0 = Vb + r32 * VP + (16 * ks + 4 * hi) * 2; const LAS unsigned char* vp1 = vp0 + 32 * VP;
                vf[4 * ks + 0] = *(const LAS s16x4*)vp0; vf[4 * ks + 1] = *(const LAS s16x4*)(vp0 + 16); vf[4 * ks + 2] = *(const LAS s16x4*)vp1; vf[4 * ks + 3] = *(const LAS s16x4*)(vp1 + 16);
            }
            __builtin_amdgcn_sched_barrier(0);
            if (is_meta) {
#pragma unroll
                for (int r = 0; r < 16; ++r) { const int kv = crow(r, hi); float b = 0.f; if constexpr (MODE == 1) b = mbL[kv & 15]; p0[r] = kv < 16 ? p0[r] + b : -INFINITY; p1[r] = -INFINITY; }
            } else if constexpr (MODE == 1) {
                const int kr = kr_lo + t; const LAS float* rp = tabL + (kr - na_r + 7) * 31 + (15 - na_c);
#pragma unroll
                for (int r = 0; r < 16; ++r) { const int kc = crow(r, hi);
                    p0[r] = (kc >= na_cs && kc < na_cs + 16) ? p0[r] + rp[kc] : -INFINITY;
                    p1[r] = (kc + 32 >= na_cs && kc + 32 < na_cs + 16) ? p1[r] + rp[kc + 32] : -INFINITY; }
            }
            if (!have_m0) {
                float mx = fmaxf(p0[0], p1[0]);
#pragma unroll
                for (int r = 1; r < 16; ++r) mx = fmaxf(mx, fmaxf(p0[r], p1[r]));
                mx = fmaxf(mx, __shfl_xor(mx, 32));
#pragma unroll
                for (int r = 0; r < 16; ++r) { p0[r] -= mx; p1[r] -= mx; negm[r] = -mx; }
                have_m0 = true;
            }
            { typedef float f32x2 __attribute__((ext_vector_type(2)));
              f32x2 accA = {0.f, 0.f}, accB = {0.f, 0.f};
#pragma unroll
              for (int r = 0; r < 16; r += 2) {
                  f32x2 a, b;
                  a.x = __builtin_amdgcn_exp2f(fminf(p0[r], 100.0f)); a.y = __builtin_amdgcn_exp2f(fminf(p0[r + 1], 100.0f));
                  b.x = __builtin_amdgcn_exp2f(fminf(p1[r], 100.0f)); b.y = __builtin_amdgcn_exp2f(fminf(p1[r + 1], 100.0f));
                  accA += a; accB += b; p0[r] = a.x; p0[r + 1] = a.y; p1[r] = b.x; p1[r + 1] = b.y; }
              const f32x2 acc = accA + accB; l_reg += acc.x + acc.y; }
            bf16x8 pa[4];
#pragma unroll
            for (int ks = 0; ks < 4; ++ks) { u32x4 w;
                if (ks < 2) { w.x = cvt_pk_bf16(p0[8 * ks + 0], p0[8 * ks + 1]); w.y = cvt_pk_bf16(p0[8 * ks + 2], p0[8 * ks + 3]); w.z = cvt_pk_bf16(p0[8 * ks + 4], p0[8 * ks + 5]); w.w = cvt_pk_bf16(p0[8 * ks + 6], p0[8 * ks + 7]); }
                else { const int b = 8 * (ks - 2); w.x = cvt_pk_bf16(p1[b + 0], p1[b + 1]); w.y = cvt_pk_bf16(p1[b + 2], p1[b + 3]); w.z = cvt_pk_bf16(p1[b + 4], p1[b + 5]); w.w = cvt_pk_bf16(p1[b + 6], p1[b + 7]); }
                pa[ks] = __builtin_bit_cast(bf16x8, w); }
#pragma unroll
            for (int ks = 0; ks < 4; ++ks) {
                const s16x4 a0 = vf[4 * ks + 0], a1 = vf[4 * ks + 1], b0 = vf[4 * ks + 2], b1 = vf[4 * ks + 3];
                const bf16x8 v0 = (bf16x8){a0[0], a0[1], a0[2], a0[3], a1[0], a1[1], a1[2], a1[3]}, v1 = (bf16x8){b0[0], b0[1], b0[2], b0[3], b1[0], b1[1], b1[2], b1[3]};
                o0 = MFMA32(pa[ks], v0, o0); o1 = MFMA32(pa[ks], v1, o1);
            }
        }
        if (more) LSTORE(buf ^ 1);
        __syncthreads();
    }
#undef GLOAD
#undef LSTORE
#undef TILE_KB
    l_reg += __shfl_xor(l_reg, 32);
    if (hi == 0) wsf[32 + r32] = l_reg;
    asm volatile("s_waitcnt lgkmcnt(0)" ::: "memory");
    LAS unsigned short* stg = (LAS unsigned short*)(lds + A_STG) + wid * 2048;
#pragma unroll
    for (int j = 0; j < 4; ++j) { const f32x4 lv = *(const LAS f32x4*)(wsf + 32 + 8 * j + 4 * hi);
#pragma unroll
        for (int e = 0; e < 4; ++e) { const int r = 4 * j + e; const float rl = __builtin_amdgcn_rcpf(lv[e]); const int orow = crow(r, hi);
            const unsigned pk = cvt_pk_bf16(o0[r] * rl, o1[r] * rl); stg[orow * 64 + r32] = (unsigned short)(pk & 0xffffu); stg[orow * 64 + 32 + r32] = (unsigned short)(pk >> 16); } }
    asm volatile("s_waitcnt lgkmcnt(0)" ::: "memory");
    { const int coloff = (MODE == 0 ? 512 : 256) + 64 * head;
#pragma unroll
      for (int i = 0; i < 4; ++i) { const int row = i * 8 + (lane >> 3), ch = lane & 7; const u32x4 v = *(const LAS u32x4*)(stg + row * 64 + ch * 8);
          const int qrow = qb * 256 + wid * 32 + row; const bool valid = metablk ? (wid == 0 && row < 16) : true;
          if (valid) *(GAS u32x4*)(P.YC + (size_t)(sbase + qrow) * DM + coloff + ch * 8) = v; } }
    asm volatile("s_waitcnt lgkmcnt(0)" ::: "memory");
}
__device__ __forceinline__ void mla_scores(const GAS bf16* Kh, int kb, int r32, const bf16x8 (&qr)[6], f32x16& p0, f32x16& p1) {
#pragma unroll
    for (int r = 0; r < 16; ++r) { p0[r] = 0.f; p1[r] = 0.f; }
    bf16x8 kf[12];
#pragma unroll
    for (int d0 = 0; d0 < 6; ++d0) { kf[2 * d0] = *(const GAS bf16x8*)(Kh + (size_t)(kb + r32) * 768 + 16 * d0); kf[2 * d0 + 1] = *(const GAS bf16x8*)(Kh + (size_t)(kb + 32 + r32) * 768 + 16 * d0); }
#pragma unroll
    for (int d0 = 0; d0 < 6; ++d0) { p0 = MFMA32(kf[2 * d0], qr[d0], p0); p1 = MFMA32(kf[2 * d0 + 1], qr[d0], p1); }
}
__device__ __forceinline__ void attn_meta_mla(const AttG& P, int seq, int head, LAS unsigned char* lds, int tid_in, int wid, int lane_in) {
    int lane = lane_in, tid = tid_in; asm volatile("" : "+v"(lane), "+v"(tid));
    const int r32 = lane & 31, hi = lane >> 5;
    const int T = P.T, Lp = P.Lp, sbase = seq * Lp, nt = (T >> 6) + 1;
    bf16x8 qr[6];
    { const GAS bf16* qsrc = P.Q + (size_t)(sbase + T + r32) * 768 + 96 * head;
#pragma unroll
      for (int d0 = 0; d0 < 6; ++d0) qr[d0] = *(const GAS bf16x8*)(qsrc + 16 * d0 + 8 * hi);
      const int pos = r32 < 15 ? r32 : 15; const GAS f32x4* rp = (const GAS f32x4*)(P.rope + (size_t)pos * 32 + 16 * hi);
#pragma unroll
      for (int e2 = 0; e2 < 4; ++e2) { const f32x4 cs = rp[e2];
#pragma unroll
          for (int q = 0; q < 2; ++q) { const int e = 2 * e2 + q; const float c = cs[2 * q], sn = cs[2 * q + 1];
              const float x1 = bf2f((unsigned short)qr[4][e]), x2 = bf2f((unsigned short)qr[5][e]);
              const unsigned pk = cvt_pk_bf16(x1 * c - x2 * sn, x1 * sn + x2 * c); qr[4][e] = (short)(pk & 0xffffu); qr[5][e] = (short)(pk >> 16); } } }
    float m0, l_reg = 0.f; f32x16 o0, o1;
#pragma unroll
    for (int r = 0; r < 16; ++r) { o0[r] = 0.f; o1[r] = 0.f; }
    const GAS bf16* Kh = P.K + (size_t)sbase * 768 + 96 * head + 8 * hi;
    const GAS bf16* Vh = P.VT + (size_t)(64 * head + r32) * P.rows + sbase + 4 * hi;
    { f32x16 p0, p1; mla_scores(Kh, 0, r32, qr, p0, p1);
      float mx = fmaxf(p0[0], p1[0]);
#pragma unroll
      for (int r = 1; r < 16; ++r) mx = fmaxf(mx, fmaxf(p0[r], p1[r]));
      m0 = fmaxf(mx, __shfl_xor(mx, 32)); }
#pragma unroll 1
    for (int t = wid; t < nt; t += 8) {
        const int kb = (t == nt - 1) ? T : 64 * t;
        f32x16 p0, p1; mla_scores(Kh, kb, r32, qr, p0, p1);
        s16x4 vf[16];
#pragma unroll
        for (int ks = 0; ks < 4; ++ks) { const GAS bf16* v0 = Vh + kb + 16 * ks; const GAS bf16* v1 = v0 + (size_t)32 * P.rows;
            vf[4 * ks + 0] = *(const GAS s16x4*)v0; vf[4 * ks + 1] = *(const GAS s16x4*)(v0 + 8); vf[4 * ks + 2] = *(const GAS s16x4*)v1; vf[4 * ks + 3] = *(const GAS s16x4*)(v1 + 8); }
        if (t == nt - 1) {
#pragma unroll
            for (int r = 0; r < 16; ++r) { if (crow(r, hi) >= 16) p0[r] = -INFINITY; p1[r] = -INFINITY; }
        }
        float ls = 0.f;
#pragma unroll
        for (int r = 0; r < 16; ++r) { p0[r] = __builtin_amdgcn_exp2f(fminf(p0[r] - m0, 100.0f)); p1[r] = __builtin_amdgcn_exp2f(fminf(p1[r] - m0, 100.0f)); ls += p0[r] + p1[r]; }
        l_reg += ls;
#pragma unroll
        for (int ks = 0; ks < 4; ++ks) { u32x4 w;
            if (ks < 2) { w.x = cvt_pk_bf16(p0[8 * ks + 0], p0[8 * ks + 1]); w.y = cvt_pk_bf16(p0[8 * ks + 2], p0[8 * ks + 3]); w.z = cvt_pk_bf16(p0[8 * ks + 4], p0[8 * ks + 5]); w.w = cvt_pk_bf16(p0[8 * ks + 6], p0[8 * ks + 7]); }
            else { const int b = 8 * (ks - 2); w.x = cvt_pk_bf16(p1[b + 0], p1[b + 1]); w.y = cvt_pk_bf16(p1[b + 2], p1[b + 3]); w.z = cvt_pk_bf16(p1[b + 4], p1[b + 5]); w.w = cvt_pk_bf16(p1[b + 6], p1[b + 7]); }
            const bf16x8 pa = __builtin_bit_cast(bf16x8, w);
            const s16x4 a0 = vf[4 * ks + 0], a1 = vf[4 * ks + 1], b0 = vf[4 * ks + 2], b1 = vf[4 * ks + 3];
            const bf16x8 v0 = (bf16x8){a0[0], a0[1], a0[2], a0[3], a1[0], a1[1], a1[2], a1[3]}, v1 = (bf16x8){b0[0], b0[1], b0[2], b0[3], b1[0], b1[1], b1[2], b1[3]};
            o0 = MFMA32(pa, v0, o0); o1 = MFMA32(pa, v1, o1); }
    }
    l_reg += __shfl_xor(l_reg, 32);
    LAS float* red = (LAS float*)lds; LAS float* lred = (LAS float*)(lds + 65536);
#pragma unroll
    for (int r = 0; r < 16; ++r) { red[wid * 2048 + (r * 2 + 0) * 64 + lane] = o0[r]; red[wid * 2048 + (r * 2 + 1) * 64 + lane] = o1[r]; }
    if (hi == 0) lred[wid * 32 + r32] = l_reg;
    asm volatile("s_waitcnt lgkmcnt(0)" ::: "memory"); __syncthreads();
#pragma unroll 1
    for (int e = tid; e < 2048; e += NTHR) { float a = 0.f;
#pragma unroll
        for (int w = 0; w < 8; ++w) a += red[w * 2048 + e];
        red[e] = a; }
    if (tid < 32) { float a = 0.f;
#pragma unroll
        for (int w = 0; w < 8; ++w) a += lred[w * 32 + tid];
        lred[tid] = a; }
    asm volatile("s_waitcnt lgkmcnt(0)" ::: "memory"); __syncthreads();
    if (wid == 0) {
#pragma unroll
        for (int r = 0; r < 16; ++r) { o0[r] = red[(r * 2 + 0) * 64 + lane]; o1[r] = red[(r * 2 + 1) * 64 + lane]; }
        LAS float* lsum = lred;
        float rl[16];
#pragma unroll
        for (int j = 0; j < 4; ++j) { const f32x4 lv = *(const LAS f32x4*)(lsum + 8 * j + 4 * hi);
#pragma unroll
            for (int e = 0; e < 4; ++e) rl[4 * j + e] = __builtin_amdgcn_rcpf(lv[e]); }
        asm volatile("s_waitcnt lgkmcnt(0)" ::: "memory");
        LAS unsigned short* stg = (LAS unsigned short*)(lds + A_STG);
#pragma unroll
        for (int r = 0; r < 16; ++r) { const int orow = crow(r, hi); const unsigned pk = cvt_pk_bf16(o0[r] * rl[r], o1[r] * rl[r]); stg[orow * 64 + r32] = (unsigned short)(pk & 0xffffu); stg[orow * 64 + 32 + r32] = (unsigned short)(pk >> 16); }
        asm volatile("s_waitcnt lgkmcnt(0)" ::: "memory");
#pragma unroll
        for (int i = 0; i < 2; ++i) { const int row = i * 8 + (lane >> 3), ch = lane & 7; const u32x4 v = *(const LAS u32x4*)(stg + row * 64 + ch * 8);
            *(GAS u32x4*)(P.YC + (size_t)(sbase + T + row) * DM + 512 + 64 * head + ch * 8) = v; }
        asm volatile("s_waitcnt lgkmcnt(0)" ::: "memory");
    }
}
__device__ __forceinline__ void attn_phase(KArgsP ap, int l, const Grp& G, unsigned* ctr, LAS unsigned char* lds, int tid, int wid, int lane) {
    const KArgs& a = *ap;
    AttG P; P.Q = (const GAS bf16*)a.out + (size_t)G.row0 * DM; P.K = (const GAS bf16*)(a.ws + WS_BIG + B_K); P.VT = (const GAS bf16*)(a.ws + WS_BIG + B_VT); P.Z = (const GAS bf16*)(a.ws + WS_BIG + B_Z);
    P.YC = (GAS bf16*)(a.ws + WS_BIG + B_YC) + (size_t)G.row0 * DM; P.rope = (const GAS float*)(a.ws + WS_ROPE); P.rows = G.rows; P.T = G.T; P.Lp = G.Lp;
    { LAS float* tab = (LAS float*)(lds + A_TAB); const GAS float* rpb = (const GAS float*)a.in[I_RPB] + (size_t)l * 4 * 465; const GAS float* mb = (const GAS float*)a.in[I_MB] + (size_t)l * 64;
      for (int e = tid; e < 4 * 640; e += NTHR) { const int h = e / 640, j = e - h * 640 - 64; tab[e] = (j >= 0 && j < 465) ? rpb[h * 465 + j] * LOG2E : 0.f; }
      if (tid < 64) tab[4 * 640 + tid] = mb[tid] * LOG2E; }
    const int nqb = (G.T >> 8) + 1; const int P8 = G.nseq, P4 = G.nseq >> 1; const int nq_mla = P8 * nqb, nq_tot = nq_mla + P4 * nqb;
    LAS volatile unsigned* uw = (LAS volatile unsigned*)(lds + A_UW);
    int q = (int)(__builtin_amdgcn_s_getreg((3 << 11) | 20) & 7u), tried = 0;
    for (;;) {
        __syncthreads();
        if (tid == 0) { unsigned j; for (;;) { j = atomicAdd(ctr + q, 1u); if (j < (unsigned)nq_tot || tried >= 7) break; q = (q + 1) & 7; ++tried; }
            *uw = (j < (unsigned)nq_tot) ? (((unsigned)q << 16) | j) : 0xffffffffu; }
        __syncthreads();
        const unsigned w = *uw;
        if (w == 0xffffffffu) break;
        const int qq = (int)(w >> 16), j = (int)(w & 0xffffu);
        if (j < nq_mla) { const int pair = qq * P8 + j / nqb, qb = j % nqb; if (qb == nqb - 1) attn_meta_mla(P, pair >> 3, pair & 7, lds, tid, wid, lane); else attn_unit<0>(P, pair >> 3, pair & 7, qb, lds, tid, wid, lane); }
        else { const int v = j - nq_mla; const int pair = qq * P4 + v / nqb, qb = v % nqb; attn_unit<1>(P, pair >> 2, pair & 3, qb, lds, tid, wid, lane); }
    }
}
#define XB_TMO      128
#define XB_XCNT(j)  (256  + 64 * (j))
#define XB_XSUB(j)  (1280 + 64 * (j))
#define XB_XGEN(j)  (2304 + 64 * (j))
#define XB_TOP      3328
#define XB_TOPGEN   3392
#define XCD_BAR_WORDS 3456
#define XB_SPIN_CAP (1u << 18)

__device__ __forceinline__ unsigned xb_ld(unsigned* p)              { return __hip_atomic_load(p, __ATOMIC_RELAXED, __HIP_MEMORY_SCOPE_AGENT); }
__device__ __forceinline__ unsigned xb_add(unsigned* p, unsigned v) { return __hip_atomic_fetch_add(p, v, __ATOMIC_RELAXED, __HIP_MEMORY_SCOPE_AGENT); }
__device__ __forceinline__ unsigned xb_xcc_id() { return (unsigned)__builtin_amdgcn_s_getreg((3 << 11) | 20) & 0xFu; }
#define XB_SPIN(cond, bar) do { unsigned _sp = 0; while (cond) { __builtin_amdgcn_s_sleep(1); \
    if ((++_sp & 255u) == 0u) { if (xb_ld(&(bar)[XB_TMO])) break; if (_sp > XB_SPIN_CAP) { atomicAdd(&(bar)[XB_TMO], 1u); break; } } } } while (0)

struct XcdBarrier {
    unsigned* bar; unsigned x;
    volatile LAS unsigned* st;
};

__device__ __forceinline__ XcdBarrier xcd_barrier_post(unsigned* bar, volatile LAS unsigned* st) {
    XcdBarrier b; b.bar = bar; b.x = xb_xcc_id(); b.st = st;
    if (threadIdx.x == 0) (void)xb_add(&bar[XB_XCNT(b.x)], 1u);
    return b;
}
__device__ __forceinline__ void xcd_barrier_complete(unsigned* bar, unsigned x, unsigned& nloc, unsigned& nx) {
    const unsigned G = gridDim.x * gridDim.y * gridDim.z;
    unsigned sum, cnt, mine, sp = 0u;
    for (;;) {
        sum = 0u; cnt = 0u; mine = 0u;
#pragma unroll
        for (unsigned j = 0; j < 16; ++j) { const unsigned c = xb_ld(&bar[XB_XCNT(j)]); sum += c; cnt += (c > 0u) ? 1u : 0u; mine = (j == x) ? c : mine; }
        if (sum == G) break;
        __builtin_amdgcn_s_sleep(1);
        if ((++sp & 255u) == 0u) { if (xb_ld(&bar[XB_TMO])) break; if (sp > XB_SPIN_CAP) { atomicAdd(&bar[XB_TMO], 1u); break; } }
    }
    nloc = mine > 0u ? mine : 1u; nx = cnt > 0u ? cnt : 1u;
}

__device__ __forceinline__ void xcd_barrier(const XcdBarrier& b) {
    asm volatile("s_waitcnt vmcnt(0)" ::: "memory");
    __syncthreads();
    if (threadIdx.x == 0) {
        unsigned* bar = b.bar;
        __builtin_amdgcn_s_waitcnt(0);
        unsigned nloc = b.st[0], nx = b.st[1];
        if (nloc == 0u) { xcd_barrier_complete(bar, b.x, nloc, nx); b.st[0] = nloc; b.st[1] = nx; }
        const unsigned old = xb_add(&bar[XB_XSUB(b.x)], 1u);
        const unsigned gen = old / nloc;
        if (old + 1u == (gen + 1u) * nloc) {
            __builtin_amdgcn_fence(__ATOMIC_RELEASE, "agent");
            asm volatile("s_waitcnt vmcnt(0)" ::: "memory");
            const unsigned og = xb_add(&bar[XB_TOP], 1u);
            const unsigned tg = og / nx;
            if (og + 1u == (tg + 1u) * nx) xb_add(&bar[XB_TOPGEN], 1u);
            else XB_SPIN(xb_ld(&bar[XB_TOPGEN]) == tg, bar);
            __builtin_amdgcn_fence(__ATOMIC_ACQUIRE, "agent");
            xb_add(&bar[XB_XGEN(b.x)], 1u);
            asm volatile("s_waitcnt vmcnt(0)" ::: "memory");
        } else {
            XB_SPIN(xb_ld(&bar[XB_XGEN(b.x)]) == gen, bar);
            __builtin_amdgcn_fence(__ATOMIC_ACQUIRE, "agent");
            asm volatile("s_waitcnt vmcnt(0)" ::: "memory");
        }
    }
    __syncthreads();
}

constexpr int CW_BAR = 1024;
#define XBAR() do { KArgsP A_ = KA(); XcdBarrier b_; b_.bar = (unsigned*)(A_->ws + WS_CTL) + CW_BAR; b_.x = xb_xcc_id(); b_.st = (volatile LAS unsigned*)(L + 133120); xcd_barrier(b_); } while (0)

#ifndef REP_GEMM
#define REP_GEMM 1
#endif
#ifndef REP_ATT
#define REP_ATT 1
#endif
#ifndef REP_FFN
#define REP_FFN 1
#endif
#define GEMM_CALL1(EpiT, gobj, sobj, eobj) pg8::gemm_phase<EpiT, pg8::StaticOrder, true, true>(L, gobj, sobj, eobj)
#define GEMM_CALL2(EpiT, gobj, sobj, eobj) do { GEMM_CALL1(EpiT, gobj, sobj, eobj); asm volatile("" ::: "memory"); GEMM_CALL1(EpiT, gobj, sobj, eobj); } while (0)
#if REP_FFN == 1
#define GEMM_CALL_F GEMM_CALL1
#else
#define GEMM_CALL_F GEMM_CALL2
#endif
#if REP_GEMM == 1
#define GEMM_CALL(EpiT, gobj, sobj, eobj) pg8::gemm_phase<EpiT, pg8::StaticOrder, true, true>(L, gobj, sobj, eobj)
#else
#define GEMM_CALL(EpiT, gobj, sobj, eobj) do { pg8::gemm_phase<EpiT, pg8::StaticOrder, true, true>(L, gobj, sobj, eobj); asm volatile("" ::: "memory"); pg8::gemm_phase<EpiT, pg8::StaticOrder, true, true>(L, gobj, sobj, eobj); } while (0)
#endif
#define KA() ({ KArgsP p_ = (KArgsP)__builtin_amdgcn_kernarg_segment_ptr(); asm volatile("" : "+s"(p_)); p_; })
__global__ void __launch_bounds__(NTHR, 2) mk_fwd(Args a_unused) {
    extern __shared__ __attribute__((aligned(16))) unsigned char lds_raw[];
    cg::grid_group grid = cg::this_grid();
    LAS unsigned char* L = (LAS unsigned char*)lds_raw;
#define TID ({ int t_ = (int)threadIdx.x; asm volatile("" : "+v"(t_)); t_; })
#define LANE (TID & 63)
#define WID (__builtin_amdgcn_readfirstlane(TID >> 6))
#define NG ((int)gridDim.x)
#define BX ((int)blockIdx.x)
#define GW (BX * NWAVES + WID)
#define NGW (NG * NWAVES)
#define SCR ((LAS float*)(L + WID * 8448))
    if (threadIdx.x < 2) ((volatile LAS unsigned*)(L + 133120))[threadIdx.x] = 0u;
    __syncthreads();
    { KArgsP A = KA(); (void)xcd_barrier_post((unsigned*)(A->ws + WS_CTL) + CW_BAR, (volatile LAS unsigned*)(L + 133120)); }
    { KArgsP A = KA(); rope_table((GAS float*)(A->ws + WS_ROPE), BX * NTHR + TID, NG * NTHR); }
    { KArgsP A = KA(); convert_layer(A, 0, SCR, GW, NGW, LANE); }
    { KArgsP A = KA(); rowpass(A, nullptr, 0.f, true, 0, MP, GW, NGW, LANE); }
    grid.sync();
    for (int st = 0; st < 3 * DEPTH; ++st) {
        const int l = st / 3, k = st - 3 * l;
        if (k != 1) {
            const int f = k >> 1;
            { KArgsP A = KA(); unsigned char* ws = A->ws; pg8::Gemm g{(const bf16*)(ws + WS_XY), (const bf16*)(ws + WS_W + (f ? W_GU2 : W_GU1)), MP, 2 * FF, DM, DM, DM}; pg8::StaticOrder S; S.init(MP, 2 * FF, NG, BX);
              pg8::EpiSwiGLU E{(GAS bf16*)(ws + WS_BIG), FF, (const GAS float*)(ws + WS_RINV), (LAS float*)(L + 132096)}; GEMM_CALL_F(pg8::EpiSwiGLU, g, S, E); }
            XBAR();
            constexpr int DN_MAIN = 1024, DN_REST = (MP / 256) * 4 - DN_MAIN, ROWS_MAIN = (DN_MAIN / 4) * 256;
            { KArgsP A = KA(); unsigned char* ws = A->ws; pg8::Gemm g{(const bf16*)(ws + WS_BIG), (const bf16*)(ws + WS_W + (f ? W_DN2 : W_DN1)), MP, DM, FF, FF, FF}; pg8::LinearOrder S; S.init(0, DN_MAIN, 4, NG, BX);
              pg8::EpiPlain E{(GAS bf16*)A->out, DM}; pg8::gemm_phase<pg8::EpiPlain, pg8::LinearOrder, true, true>(L, g, S, E); }
            XBAR();
            const bool last = (l == DEPTH - 1 && f == 1);
            { const int vc = (BX % 8) * (NG / 8) + BX / 8;
              if (vc < DN_REST) { KArgsP A = KA(); unsigned char* ws = A->ws; pg8::Gemm g{(const bf16*)(ws + WS_BIG), (const bf16*)(ws + WS_W + (f ? W_DN2 : W_DN1)), MP, DM, FF, FF, FF}; pg8::LinearOrder S; S.init(DN_MAIN, DN_REST, 4, NG, BX);
                  pg8::EpiPlain E{(GAS bf16*)A->out, DM}; pg8::gemm_phase<pg8::EpiPlain, pg8::LinearOrder, true, true>(L, g, S, E); }
              else { KArgsP A = KA(); rowpass(A, (const GAS float*)A->in[f ? I_F2POST : I_F1POST] + l * DM, 0.5f, false, 0, ROWS_MAIN, (vc - DN_REST) * NWAVES + WID, (NG - DN_REST) * NWAVES, LANE); } }
            XBAR();
            { KArgsP A = KA(); rowpass(A, (const GAS float*)A->in[f ? I_F2POST : I_F1POST] + l * DM, 0.5f, false, ROWS_MAIN, MP, GW, NGW, LANE); }
            if (f == 1 && !last) { KArgsP A = KA(); convert_layer(A, l + 1, SCR, GW, NGW, LANE); }
            XBAR();
            if (last) { KArgsP A = KA(); output_pass(A, GW, NGW, LANE); }
        } else {
            for (int gi = 0; gi < 2; ++gi) {
                { KArgsP A = KA(); unsigned char* ws = A->ws; const Grp G = grp_of(gi);
                  pg8::Gemm g{(const bf16*)(ws + WS_XY) + (size_t)G.row0 * DM, (const bf16*)(ws + WS_W + W_IN), G.rows, NINP, DM, DM, DM}; pg8::StaticOrder S; S.init(G.rows, NINP, NG, BX);
                  pg8::EpiInProj E{(GAS bf16*)(ws + WS_BIG + B_Z), (GAS float*)(ws + WS_SSP) + (size_t)G.row0 * 32, (const GAS float*)(ws + WS_RINV) + G.row0, (LAS float*)(L + 132096)}; GEMM_CALL(pg8::EpiInProj, g, S, E); }
                XBAR();
                { KArgsP A = KA(); unsigned char* ws = A->ws; const Grp G = grp_of(gi);
                  pg8::Gemm g{(const bf16*)(ws + WS_BIG + B_Z) + 1536, (const bf16*)(ws + WS_W + W_UQ), G.rows, 768, 768, ZP, 768}; pg8::StaticOrder S; S.init(G.rows, 768, NG, BX);
                  pg8::EpiRowScale E{(GAS bf16*)A->out + (size_t)G.row0 * DM, 768, (const GAS float*)(ws + WS_SSP) + (size_t)G.row0 * 32, 0, 6, 1.0f / 768.0f, 0.10206207261596575f * LOG2E, 0, (LAS float*)(L + 132096)}; GEMM_CALL(pg8::EpiRowScale, g, S, E); }
                { KArgsP A = KA(); unsigned char* ws = A->ws; const Grp G = grp_of(gi);
                  pg8::Gemm g{(const bf16*)(ws + WS_BIG + B_Z) + 2304, (const bf16*)(ws + WS_W + W_UK), G.rows, 512, 256, ZP, 256}; pg8::StaticOrder S; S.init(G.rows, 512, NG, BX, NG - 140 % NG);
                  pg8::EpiRowScale E{(GAS bf16*)(ws + WS_BIG + B_K), 768, (const GAS float*)(ws + WS_SSP) + (size_t)G.row0 * 32, 24, 2, 1.0f / 256.0f, 1.0f, 1, (LAS float*)(L + 132096)}; GEMM_CALL(pg8::EpiRowScale, g, S, E); }
                { KArgsP A = KA(); unsigned char* ws = A->ws; const Grp G = grp_of(gi);
                  pg8::Gemm g{(const bf16*)(ws + WS_W + W_UV), (const bf16*)(ws + WS_BIG + B_Z) + 2304, 512, G.rows, 256, 256, ZP}; pg8::StaticOrder S; S.init(512, G.rows, NG, BX, NG - 148 % NG);
                  pg8::EpiColScale E{(GAS bf16*)(ws + WS_BIG + B_VT), G.rows, (const GAS float*)(ws + WS_SSP) + (size_t)G.row0 * 32, (LAS float*)(L + 132096)}; GEMM_CALL(pg8::EpiColScale, g, S, E); }
                { KArgsP A = KA(); const Grp G = grp_of(gi); conv_kpe_pass(A, l, G, GW, NGW, LANE); }
                XBAR();
                { KArgsP A = KA(); const Grp G = grp_of(gi); for (int rep_ = 0; rep_ < REP_ATT; ++rep_) attn_phase(A, l, G, (unsigned*)(A->ws + WS_CTL) + 64 * (l * 2 + gi) + 32 * rep_, L, TID, WID, LANE); }
                XBAR();
            }
            { KArgsP A = KA(); ynorm_pass(A, GW, NGW, LANE); }
            XBAR();
            { KArgsP A = KA(); unsigned char* ws = A->ws;
              pg8::Gemm g{(const bf16*)(ws + WS_BIG + B_YC), (const bf16*)(ws + WS_W + W_O), MP, DM, DM, DM, DM}; pg8::StaticOrder S; S.init(MP, DM, NG, BX);
              pg8::EpiPlain E{(GAS bf16*)A->out, DM}; GEMM_CALL(pg8::EpiPlain, g, S, E); }
            XBAR();
            { KArgsP A = KA(); rowpass(A, (const GAS float*)A->in[I_MPOST] + l * DM, 1.0f, false, 0, MP, GW, NGW, LANE); }
            XBAR();
        }
    }
}

extern "C" void kernel_launch(void* const* d_in, const int* in_sizes, int n_in, void* d_out, int out_size, void* d_ws, size_t ws_size, hipStream_t stream) {
    static int grid = 0;
    if (grid == 0) {
        if (n_in != 25 || ws_size < WS_END) { fprintf(stderr, "kernel_launch: need 25 inputs and %zu B of workspace (got %d, %zu)\n", (size_t)WS_END, n_in, ws_size); grid = -1; return; }
        int dev = 0, cus = 0, per_cu = 0;
        if (hipGetDevice(&dev) != hipSuccess || hipDeviceGetAttribute(&cus, hipDeviceAttributeMultiprocessorCount, dev) != hipSuccess) { grid = -1; return; }
        if (hipFuncSetAttribute((const void*)mk_fwd, hipFuncAttributeMaxDynamicSharedMemorySize, LDS_BYTES) != hipSuccess) { fprintf(stderr, "kernel_launch: hipFuncSetAttribute failed\n"); grid = -1; return; }
        if (hipOccupancyMaxActiveBlocksPerMultiprocessor(&per_cu, (const void*)mk_fwd, NTHR, LDS_BYTES) != hipSuccess || per_cu < 1) { fprintf(stderr, "kernel_launch: occupancy query says %d\n", per_cu); }
        (void)hipGetLastError();
        grid = cus;
    }
    if (grid < 0) return;
    if (hipMemsetAsync((char*)d_ws + WS_CTL, 0, 32768, stream) != hipSuccess) return;
    Args a{};
    for (int i = 0; i < 25; ++i) a.in[i] = (const float*)d_in[i];
    a.out = (float*)d_out; a.ws = (unsigned char*)d_ws;
    void* args[] = {&a};
    hipError_t e = hipLaunchCooperativeKernel((const void*)mk_fwd, dim3(grid), dim3(NTHR), args, LDS_BYTES, stream);
    if (e != hipSuccess) fprintf(stderr, "kernel_launch: cooperative launch failed: %s\n", hipGetErrorString(e));
}
```

```cpp
#include <hip/hip_runtime.h>
#include <hip/hip_cooperative_groups.h>
#include <cstdio>
#include <cstdint>
namespace cg = cooperative_groups;
#define GAS __attribute__((address_space(1)))
namespace pg8 {
#define PG8_LAS __attribute__((address_space(3)))
typedef unsigned short bf16_t;
typedef short bf16x8 __attribute__((ext_vector_type(8)));
typedef float f32x4 __attribute__((ext_vector_type(4)));
typedef unsigned u32x4 __attribute__((ext_vector_type(4)));
constexpr int BM = 256, BK = 64, HALF = 128, HTB = HALF * BK * 2  , STAGE_BYTES = 8 * HTB, NXCD = 8, WGM = 8;

__host__ __device__ __forceinline__ int lds_byte(int r, int c) { const int st = (r >> 4) * 2 + (c >> 5), rr = r & 15, cc = c & 31, ob = rr * 64 + cc * 2; return st * 1024 + (ob ^ (((ob >> 9) & 1) << 5)); }
__host__ __device__ __forceinline__ void stage_rc(int b, int& R, int& C) { const int st = b / 1024, sb = b % 1024, swz = sb ^ (((sb >> 9) & 1) << 5); R = (st >> 1) * 16 + swz / 64; C = (st & 1) * 32 + (swz % 64) / 2; }
__host__ __device__ __forceinline__ int perm32(int rho) { const int n = rho >> 4, i = rho & 15; return 8 * (i >> 2) + 4 * n + (i & 3); }

struct Unit { int pm, pn; };
struct Gemm { const bf16_t* A; const bf16_t* Bt; int M, N, K, lda, ldb; };

struct StaticOrder {
    int nM, nN, nwg, G, c;
    __host__ __device__ void init(int M, int N, int G_, int c_, int shift = 0) { nM = M / BM; nN = N / BM; nwg = nM * nN; G = G_; c = (c_ + shift) % G_; }
    __host__ __device__ bool next(int i, Unit& u) const {
        const long L = (long)i * G + c; if (L >= nwg) return false;
        int wgid = (int)L; { const int q = nwg / NXCD, r = nwg % NXCD, xcd = wgid % NXCD, off = wgid / NXCD; wgid = (xcd < r ? xcd * (q + 1) : r * (q + 1) + (xcd - r) * q) + off; }
        const int nig = WGM * nN, gid = wgid / nig, fm = gid * WGM, gsz = (nM - fm) < WGM ? (nM - fm) : WGM;
        u.pm = fm + ((wgid % nig) % gsz); u.pn = (wgid % nig) / gsz; return true;
    }
    __device__ __forceinline__ void a_ready(const Unit&) const {}
    __device__ __forceinline__ void done(const Unit&) const {}
};
struct LinearOrder {
    int first, count, nN, G, vc;
    __host__ __device__ void init(int first_, int count_, int nN_, int G_, int bx) { first = first_; count = count_; nN = nN_; G = G_; vc = (G_ % 8 == 0) ? (bx % 8) * (G_ / 8) + bx / 8 : bx; }
    __host__ __device__ bool next(int i, Unit& u) const { const int L = i * G + vc; if (L >= count) return false; const int w = first + L; u.pm = w / nN; u.pn = w % nN; return true; }
    __device__ __forceinline__ void a_ready(const Unit&) const {}
    __device__ __forceinline__ void done(const Unit&) const {}
};
__device__ __forceinline__ unsigned cvt_pk_bf16(float lo, float hi) { typedef float f2 __attribute__((ext_vector_type(2))); typedef __bf16 b2 __attribute__((ext_vector_type(2))); f2 v = {lo, hi}; b2 b = __builtin_convertvector(v, b2); return __builtin_bit_cast(unsigned, b); }
typedef unsigned u32x2 __attribute__((ext_vector_type(2)));
constexpr float LOG2E = 1.4426950408889634f;
constexpr float RMS_EPS = 1e-6f;
#define EPI_STORE8(ptr, v0, v1) do { u32x4 w_; w_.x = cvt_pk_bf16((v0)[0], (v0)[1]); w_.y = cvt_pk_bf16((v0)[2], (v0)[3]); w_.z = cvt_pk_bf16((v1)[0], (v1)[1]); w_.w = cvt_pk_bf16((v1)[2], (v1)[3]); *(GAS u32x4*)(ptr) = w_; } while (0)
struct EpiPlain {
    static constexpr bool PERM = true, AFTER_DRAIN = false;
    GAS bf16_t* O; int ldc;
    __device__ __forceinline__ void operator()(const f32x4 (&acc)[2][2][4][2], const Unit& u, int wr, int wc, int fr, int fq) const {
        const int row0 = u.pm * BM + wr * 64 + fr, col0 = u.pn * BM + wc * 32 + 8 * fq;
#pragma unroll
        for (int ai = 0; ai < 2; ++ai)
#pragma unroll
            for (int m = 0; m < 4; ++m) { GAS bf16_t* rowp = O + (size_t)(row0 + ai * HALF + m * 16) * ldc + col0;
#pragma unroll
                for (int bj = 0; bj < 2; ++bj) EPI_STORE8(rowp + bj * HALF, acc[ai][bj][m][0], acc[ai][bj][m][1]); }
    }
};
__device__ __forceinline__ float silu_mul(float g, float u) { return g * u * __builtin_amdgcn_rcpf(1.0f + __builtin_amdgcn_exp2f(-g * LOG2E)); }
struct EpiSwiGLU {
    static constexpr bool PERM = true, AFTER_DRAIN = false;
    GAS bf16_t* O; int ldc; const GAS float* rinv; PG8_LAS float* tab;
    __device__ __forceinline__ void operator()(const f32x4 (&acc)[2][2][4][2], const Unit& u, int wr, int wc, int fr, int fq) const {
        const int row0 = u.pm * BM + wr * 64 + fr, col0 = u.pn * HALF + wc * 32 + 8 * fq;
        __builtin_amdgcn_s_barrier();
        { const int t = threadIdx.x; if (t < 256) tab[t] = rinv[u.pm * BM + t]; }
        asm volatile("s_waitcnt lgkmcnt(0)" ::: "memory"); __builtin_amdgcn_s_barrier(); asm volatile("" ::: "memory");
#pragma unroll
        for (int ai = 0; ai < 2; ++ai)
#pragma unroll
            for (int m = 0; m < 4; ++m) { GAS bf16_t* rowp = O + (size_t)(row0 + ai * HALF + m * 16) * ldc + col0; const float rs = tab[ai * HALF + wr * 64 + m * 16 + fr];
                f32x4 v0, v1;
#pragma unroll
                for (int e = 0; e < 4; ++e) { v0[e] = silu_mul(acc[ai][0][m][0][e] * rs, acc[ai][1][m][0][e] * rs); v1[e] = silu_mul(acc[ai][0][m][1][e] * rs, acc[ai][1][m][1][e] * rs); }
                EPI_STORE8(rowp, v0, v1); }
    }
};
struct EpiInProj {
    static constexpr bool PERM = true, AFTER_DRAIN = false;
    GAS bf16_t* Z; GAS float* SSP; const GAS float* rinv; PG8_LAS float* tab;
    __device__ __forceinline__ void operator()(const f32x4 (&acc)[2][2][4][2], const Unit& u, int wr, int wc, int fr, int fq) const {
        const int row0 = u.pm * BM + wr * 64 + fr;
        __builtin_amdgcn_s_barrier();
        { const int t = threadIdx.x; if (t < 256) tab[t] = rinv[u.pm * BM + t]; }
        asm volatile("s_waitcnt lgkmcnt(0)" ::: "memory"); __builtin_amdgcn_s_barrier(); asm volatile("" ::: "memory");
#pragma unroll
        for (int bj = 0; bj < 2; ++bj) {
            const int G = 8 * u.pn + 4 * bj + wc, col0 = 32 * G;
            if (col0 >= 2592) continue;
            const float sc = (col0 >= 768 && col0 < 1024) ? 0.125f * LOG2E : 1.0f;
            const bool doss = (G >= 48 && G < 80); const int slot = G - 48;
#pragma unroll
            for (int ai = 0; ai < 2; ++ai)
#pragma unroll
                for (int m = 0; m < 4; ++m) { const int row = row0 + ai * HALF + m * 16; const float rs = tab[ai * HALF + wr * 64 + m * 16 + fr] * sc;
                    const f32x4 v0 = acc[ai][bj][m][0] * rs, v1 = acc[ai][bj][m][1] * rs;
                    if (doss) { float s = (v0[0] * v0[0] + v0[1] * v0[1]) + (v0[2] * v0[2] + v0[3] * v0[3]) + (v1[0] * v1[0] + v1[1] * v1[1]) + (v1[2] * v1[2] + v1[3] * v1[3]);
                        s += __shfl_xor(s, 16); s += __shfl_xor(s, 32); if (fq == 0) SSP[(size_t)row * 32 + slot] = s; }
                    EPI_STORE8(Z + (size_t)row * 2592 + col0 + 8 * fq, v0, v1); }
        }
    }
};
struct EpiRowScale {
    static constexpr bool PERM = true, AFTER_DRAIN = false;
    GAS bf16_t* O; int ldo; const GAS float* SSP; int slot0, nslot4; float invn, extra; int kmap; PG8_LAS float* tab;
    __device__ __forceinline__ void operator()(const f32x4 (&acc)[2][2][4][2], const Unit& u, int wr, int wc, int fr, int fq) const {
        const int row0 = u.pm * BM + wr * 64 + fr;
        __builtin_amdgcn_s_barrier();
        { const int t = threadIdx.x; if (t < 256) { const GAS f32x4* sp = (const GAS f32x4*)(SSP + (size_t)(u.pm * BM + t) * 32 + slot0); float s = 0.f;
            for (int k = 0; k < nslot4; ++k) { const f32x4 v = sp[k]; s += (v[0] + v[1]) + (v[2] + v[3]); }
            tab[t] = __builtin_amdgcn_rsqf(s * invn + RMS_EPS) * extra; } }
        asm volatile("s_waitcnt lgkmcnt(0)" ::: "memory"); __builtin_amdgcn_s_barrier(); asm volatile("" ::: "memory");
#pragma unroll
        for (int ai = 0; ai < 2; ++ai)
#pragma unroll
            for (int m = 0; m < 4; ++m) { const float rs = tab[ai * HALF + wr * 64 + m * 16 + fr];
#pragma unroll
                for (int bj = 0; bj < 2; ++bj) { const int c0 = u.pn * BM + bj * HALF + wc * 32; const int dc = (kmap ? 96 * (c0 >> 6) + (c0 & 63) : c0) + 8 * fq;
                    const f32x4 v0 = acc[ai][bj][m][0] * rs, v1 = acc[ai][bj][m][1] * rs;
                    EPI_STORE8(O + (size_t)(row0 + ai * HALF + m * 16) * ldo + dc, v0, v1); } }
    }
};
struct EpiColScale {
    static constexpr bool PERM = true, AFTER_DRAIN = false;
    GAS bf16_t* O; int ldo; const GAS float* SSP; PG8_LAS float* tab;
    __device__ __forceinline__ void operator()(const f32x4 (&acc)[2][2][4][2], const Unit& u, int wr, int wc, int fr, int fq) const {
        const int row0 = u.pm * BM + wr * 64 + fr;
        __builtin_amdgcn_s_barrier();
        { const int t = threadIdx.x; if (t < 256) { const GAS f32x4* sp = (const GAS f32x4*)(SSP + (size_t)(u.pn * BM + t) * 32 + 24); const f32x4 a = sp[0], b = sp[1];
            tab[t] = __builtin_amdgcn_rsqf(((a[0] + a[1]) + (a[2] + a[3]) + (b[0] + b[1]) + (b[2] + b[3])) * (1.0f / 256.0f) + RMS_EPS); } }
        asm volatile("s_waitcnt lgkmcnt(0)" ::: "memory"); __builtin_amdgcn_s_barrier(); asm volatile("" ::: "memory");
#pragma unroll
        for (int bj = 0; bj < 2; ++bj) { const int cl = bj * HALF + wc * 32 + 8 * fq, c0 = u.pn * BM + cl;
            const f32x4 s0 = *(const PG8_LAS f32x4*)(tab + cl), s1 = *(const PG8_LAS f32x4*)(tab + cl + 4);
#pragma unroll
            for (int ai = 0; ai < 2; ++ai)
#pragma unroll
                for (int m = 0; m < 4; ++m) { const f32x4 v0 = acc[ai][bj][m][0] * s0, v1 = acc[ai][bj][m][1] * s1;
                    GAS bf16_t* op = O + (size_t)(row0 + ai * HALF + m * 16) * ldo + (c0 & ~15) + ((c0 >> 3) & 1) * 4;
                    u32x2 w0, w1; w0.x = cvt_pk_bf16(v0[0], v0[1]); w0.y = cvt_pk_bf16(v0[2], v0[3]); w1.x = cvt_pk_bf16(v1[0], v1[1]); w1.y = cvt_pk_bf16(v1[2], v1[3]);
                    *(GAS u32x2*)op = w0; *(GAS u32x2*)(op + 8) = w1; } }
    }
};
template <class Epi, class Sched, bool ALIGN_EPI = false, bool SP2 = false>
__device__ __forceinline__ void gemm_phase(PG8_LAS unsigned char* lds, const Gemm g, const Sched& S, const Epi& E) {
    int tid_l = threadIdx.x; asm volatile("" : "+v"(tid_l)); const int tid = tid_l, wid = __builtin_amdgcn_readfirstlane(tid >> 6), lane = tid & 63, wr = wid >> 2, wc = wid & 3, fr = lane & 15, fq = lane >> 4;
    int K_l = g.K; asm volatile("" : "+s"(K_l)); const int K = K_l, nt = K / BK;
    unsigned voffA[2], voffB[2];
#pragma unroll
    for (int i = 0; i < 2; ++i) { int R, C; stage_rc(tid * 16 + i * 8192, R, C); const int Rb = Epi::PERM ? ((R & ~31) + perm32(R & 31)) : R;
        voffA[i] = (unsigned)(R * g.lda + C) * 2u; voffB[i] = (unsigned)(Rb * g.ldb + C) * 2u; }
    const size_t kstep = (size_t)(BK * 2);
    const size_t hstepA = (size_t)HALF * g.lda * 2, hstepB = (size_t)HALF * g.ldb * 2;
    const size_t tstepA = 2 * hstepA, tstepB = 2 * hstepB;
    const unsigned ldsw = (unsigned)wid * 1024u;
    const int aoff = lds_byte(wr * 64 + fr, fq * 8), boff = lds_byte(wc * 32 + fr, fq * 8);
#define PG8_SA(b, h) (((b) * 2 + (h)) * HTB)
#define PG8_SB(b, h) ((4 + (b) * 2 + (h)) * HTB)
#define PG8_STAGE(bufoff, gbase, voff) do { _Pragma("unroll") for (int _i = 0; _i < 2; ++_i) \
        __builtin_amdgcn_global_load_lds((const unsigned*)((const char*)(gbase) + (voff)[_i]), (PG8_LAS unsigned*)(lds + (bufoff) + ldsw + _i * 8192), 16, 0, 0); } while (0)
#define PG8_LDA(dst, b, h) do { _Pragma("unroll") for (int m = 0; m < 4; ++m) _Pragma("unroll") for (int k = 0; k < 2; ++k) dst[m][k] = *(const PG8_LAS bf16x8*)(lds + PG8_SA(b, h) + aoff + m * 2048 + k * 1024); } while (0)
#define PG8_LDB(dst, b, h) do { _Pragma("unroll") for (int n = 0; n < 2; ++n) _Pragma("unroll") for (int k = 0; k < 2; ++k) dst[n][k] = *(const PG8_LAS bf16x8*)(lds + PG8_SB(b, h) + boff + n * 2048 + k * 1024); } while (0)
#define PG8_MMA(ai, bj, At, Bt) do { __builtin_amdgcn_s_setprio(1); _Pragma("unroll") for (int m = 0; m < 4; ++m) _Pragma("unroll") for (int n = 0; n < 2; ++n) _Pragma("unroll") for (int k = 0; k < 2; ++k) \
        acc[ai][bj][m][n] = __builtin_amdgcn_mfma_f32_16x16x32_bf16(Bt[n][k], At[m][k], acc[ai][bj][m][n], 0, 0, 0); __builtin_amdgcn_s_setprio(0); } while (0)
#define PG8_WAIT_V(n) asm volatile("s_waitcnt vmcnt(" #n ")" ::: "memory")
#define PG8_WAIT_L(n) asm volatile("s_waitcnt lgkmcnt(" #n ")" ::: "memory")
#define PG8_BAR __builtin_amdgcn_s_barrier()
#define PG8_SCHED __builtin_amdgcn_sched_barrier(0)
    Unit cur, nxt; int ui = 0;
    if (!S.next(0, cur)) return;
    f32x4 acc[2][2][4][2];
#pragma unroll
    for (int a = 0; a < 2; ++a)
#pragma unroll
        for (int b = 0; b < 2; ++b)
#pragma unroll
            for (int m = 0; m < 4; ++m)
#pragma unroll
                for (int n = 0; n < 2; ++n) acc[a][b][m][n] = (f32x4){0.f, 0.f, 0.f, 0.f};
    bf16x8 At[4][2], B0[2][2], B1[2][2];
    const char* cA = (const char*)g.A + (size_t)cur.pm * tstepA; const char* cB = (const char*)g.Bt + (size_t)cur.pn * tstepB;
    S.a_ready(cur);
    if constexpr (SP2) {
        PG8_STAGE(PG8_SB(0, 0), cB, voffB); PG8_STAGE(PG8_SB(0, 1), cB + hstepB, voffB); PG8_STAGE(PG8_SA(0, 0), cA, voffA); PG8_STAGE(PG8_SA(0, 1), cA + hstepA, voffA);
        if (wr == 1) PG8_BAR;
        PG8_WAIT_V(2); PG8_BAR;
        PG8_STAGE(PG8_SB(1, 0), cB + kstep, voffB); PG8_STAGE(PG8_SA(1, 0), cA + kstep, voffA); PG8_STAGE(PG8_SB(1, 1), cB + hstepB + kstep, voffB);
        PG8_WAIT_V(6); PG8_BAR;
    } else {
        PG8_STAGE(PG8_SB(0, 0), cB, voffB); PG8_STAGE(PG8_SA(0, 0), cA, voffA); PG8_STAGE(PG8_SB(0, 1), cB + hstepB, voffB); PG8_STAGE(PG8_SA(0, 1), cA + hstepA, voffA);
        if (wr == 1) PG8_BAR;
        PG8_WAIT_V(4); PG8_BAR;
        PG8_STAGE(PG8_SB(1, 0), cB + kstep, voffB); PG8_STAGE(PG8_SA(1, 0), cA + kstep, voffA); PG8_STAGE(PG8_SB(1, 1), cB + hstepB + kstep, voffB);
        PG8_WAIT_V(6); PG8_BAR;
    }
    for (;;) {
        const bool has_next = S.next(ui + 1, nxt);
        const char* nA = has_next ? (const char*)g.A + (size_t)nxt.pm * tstepA : cA; const char* nB = has_next ? (const char*)g.Bt + (size_t)nxt.pn * tstepB : cB;
        for (int t = 0; t < nt; t += 2) {
            const bool last = (t == nt - 2);
            const char* a1 = cA + (size_t)(t + 1) * kstep;
            const char* a2 = last ? nA : cA + (size_t)(t + 2) * kstep; const char* b2 = last ? nB : cB + (size_t)(t + 2) * kstep;
            const char* a3 = a2 + kstep; const char* b3 = b2 + kstep;
            if (last && has_next) S.a_ready(nxt);
            if constexpr (SP2) {
            PG8_LDB(B0, 0, 0); PG8_LDB(B1, 0, 1); PG8_SCHED; PG8_LDA(At, 0, 0); PG8_STAGE(PG8_SA(1, 1), a1 + hstepA, voffA);
            PG8_WAIT_V(8); PG8_WAIT_L(0); PG8_BAR; PG8_MMA(0, 0, At, B0); PG8_MMA(0, 1, At, B1); PG8_BAR; PG8_SCHED;
            PG8_LDA(At, 0, 1); PG8_STAGE(PG8_SB(0, 0), b2, voffB); PG8_STAGE(PG8_SB(0, 1), b2 + hstepB, voffB); PG8_STAGE(PG8_SA(0, 0), a2, voffA);
            PG8_WAIT_V(8); PG8_WAIT_L(0); PG8_BAR; PG8_MMA(1, 0, At, B0); PG8_MMA(1, 1, At, B1); PG8_BAR; PG8_SCHED;
            PG8_LDB(B0, 1, 0); PG8_LDB(B1, 1, 1); PG8_SCHED; PG8_LDA(At, 1, 0); PG8_STAGE(PG8_SA(0, 1), a2 + hstepA, voffA);
            PG8_WAIT_V(8); PG8_WAIT_L(0); PG8_BAR; PG8_MMA(0, 0, At, B0); PG8_MMA(0, 1, At, B1); PG8_BAR; PG8_SCHED;
            PG8_LDA(At, 1, 1); PG8_STAGE(PG8_SB(1, 0), b3, voffB); PG8_STAGE(PG8_SB(1, 1), b3 + hstepB, voffB); PG8_STAGE(PG8_SA(1, 0), a3, voffA);
            PG8_WAIT_V(8); PG8_WAIT_L(0); PG8_BAR; PG8_MMA(1, 0, At, B0); PG8_MMA(1, 1, At, B1); PG8_BAR; PG8_SCHED;
            } else {
            PG8_LDB(B0, 0, 0); PG8_SCHED; PG8_LDA(At, 0, 0); PG8_STAGE(PG8_SA(1, 1), a1 + hstepA, voffA);
            PG8_WAIT_L(8); PG8_BAR; PG8_WAIT_L(0); PG8_MMA(0, 0, At, B0); PG8_BAR; PG8_SCHED;
            PG8_LDB(B1, 0, 1); PG8_STAGE(PG8_SB(0, 0), b2, voffB);
            PG8_BAR; PG8_WAIT_L(0); PG8_MMA(0, 1, At, B1); PG8_BAR;
            PG8_LDA(At, 0, 1); PG8_STAGE(PG8_SA(0, 0), a2, voffA);
            PG8_BAR; PG8_WAIT_L(0); PG8_MMA(1, 0, At, B0); PG8_BAR; PG8_SCHED;
            PG8_STAGE(PG8_SB(0, 1), b2 + hstepB, voffB);
            PG8_WAIT_V(6); PG8_BAR; PG8_MMA(1, 1, At, B1); PG8_BAR;
            PG8_LDB(B0, 1, 0); PG8_SCHED; PG8_LDA(At, 1, 0); PG8_STAGE(PG8_SA(0, 1), a2 + hstepA, voffA);
            PG8_WAIT_L(8); PG8_BAR; PG8_WAIT_L(0); PG8_MMA(0, 0, At, B0); PG8_BAR; PG8_SCHED;
            PG8_LDB(B1, 1, 1); PG8_STAGE(PG8_SB(1, 0), b3, voffB);
            PG8_BAR; PG8_WAIT_L(0); PG8_MMA(0, 1, At, B1); PG8_BAR;
            PG8_LDA(At, 1, 1); PG8_STAGE(PG8_SA(1, 0), a3, voffA);
            PG8_BAR; PG8_WAIT_L(0); PG8_MMA(1, 0, At, B0); PG8_BAR; PG8_SCHED;
            PG8_STAGE(PG8_SB(1, 1), b3 + hstepB, voffB);
            PG8_WAIT_V(6); PG8_BAR; PG8_MMA(1, 1, At, B1); PG8_BAR;
            }
        }
        if constexpr (ALIGN_EPI) { if (wr == 0) PG8_BAR; }
        if constexpr (!Epi::AFTER_DRAIN) { E(acc, cur, wr, wc, fr, fq); S.done(cur); }
        if (!has_next) break;
#pragma unroll
        for (int a = 0; a < 2; ++a)
#pragma unroll
            for (int b = 0; b < 2; ++b)
#pragma unroll
                for (int m = 0; m < 4; ++m)
#pragma unroll
                    for (int n = 0; n < 2; ++n) acc[a][b][m][n] = (f32x4){0.f, 0.f, 0.f, 0.f};
        cur = nxt; cA = nA; cB = nB; ++ui;
        if constexpr (ALIGN_EPI) { if (wr == 1) PG8_BAR; }
    }
    PG8_WAIT_V(0);
    if constexpr (!ALIGN_EPI) { if (wr == 0) PG8_BAR; }
    PG8_BAR;
    if constexpr (Epi::AFTER_DRAIN) { E.fused(acc, cur, wr, wc, fr, fq, lds, wid, lane); S.done(cur); }
#undef PG8_SA
#undef PG8_SB
#undef PG8_STAGE
#undef PG8_LDA
#undef PG8_LDB
#undef PG8_MMA
#undef PG8_WAIT_V
#undef PG8_WAIT_L
#undef PG8_BAR
#undef PG8_SCHED
}
}
#define LAS __attribute__((address_space(3)))
typedef unsigned short bf16;
typedef unsigned u32x4 __attribute__((ext_vector_type(4)));
typedef unsigned u32x2 __attribute__((ext_vector_type(2)));
typedef float f32x4 __attribute__((ext_vector_type(4)));
typedef float f32x16 __attribute__((ext_vector_type(16)));
typedef short bf16x8 __attribute__((ext_vector_type(8)));
typedef short s16x4 __attribute__((ext_vector_type(4)));
using pg8::cvt_pk_bf16; using pg8::LOG2E; using pg8::RMS_EPS;

constexpr int NWAVES = 8, NTHR = 512;
constexpr int DM = 1024, FF = 2816, ZP = 2592, NINP = 2816, DEPTH = 4;
constexpr int MP = 67072;
constexpr int G0_ROWS = 33792, G1_ROWS = 33280;
constexpr size_t MiB = 1u << 20;
constexpr size_t WS_RINV = 1 * MiB + 640 * 1024;
constexpr size_t WS_CTL = 0, WS_ROPE = 1 * MiB, WS_SSP = 2 * MiB, WS_METAH = 11 * MiB, WS_W = 13 * MiB, WS_XY = 61 * MiB, WS_BIG = 192 * MiB, WS_END = 574 * MiB;
constexpr size_t W_GU1 = 0, W_DN1 = 11 * MiB, W_GU2 = 33 * MiB / 2, W_DN2 = 55 * MiB / 2, W_IN = 33 * MiB, W_UQ = 77 * MiB / 2, W_UK = 40 * MiB, W_UV = 40 * MiB + MiB / 4, W_O = 40 * MiB + MiB / 2;
constexpr size_t B_Z = 0, B_K = 168 * MiB, B_VT = 218 * MiB, B_YC = 251 * MiB;
constexpr int LDS_BYTES = 147456;
constexpr int A_K = 0, A_KBUF = 64 * 208, A_V = 2 * A_KBUF, A_VBUF = 64 * 144, A_WSF = 61440, A_STG = A_WSF + 8 * 256, A_TAB = A_STG + 8 * 4096, A_UW = A_TAB + 4 * 640 * 4 + 256;
constexpr int D_K = 0, D_KBUF = 64 * 192, D_V = 3 * D_KBUF, D_VBUF = 64 * 128;
static_assert(D_V + 3 * D_VBUF <= A_WSF && A_V + 2 * A_VBUF <= A_WSF, "attention LDS rings");
static_assert(A_UW + 64 <= 131072, "attention LDS");

struct Args { const float* in[25]; float* out; unsigned char* ws; };
typedef const __attribute__((address_space(4))) Args KArgs;
typedef KArgs* KArgsP;
enum { I_XP = 0, I_XS, I_META, I_F1PRE, I_F1GU, I_F1DN, I_F1POST, I_MPRE, I_WIN, I_CONVW, I_RPB, I_MB, I_QN, I_WUQ, I_KVN, I_WUKV, I_CON, I_NON, I_MON, I_WO, I_MPOST, I_F2PRE, I_F2GU, I_F2DN, I_F2POST };

__device__ __forceinline__ float bf2f(unsigned short b) { return __uint_as_float((unsigned)b << 16); }
__device__ __forceinline__ float bflo(unsigned w) { return __uint_as_float(w << 16); }
__device__ __forceinline__ float bfhi(unsigned w) { return __uint_as_float(w & 0xffff0000u); }
__device__ __forceinline__ float wave_sum(float v) {
#pragma unroll
    for (int o = 1; o < 64; o <<= 1) v += __shfl_xor(v, o);
    return v;
}
__device__ __forceinline__ void row_decode(int row, int& s, int& i, int& T) {
    if (row < G0_ROWS) { s = row / 2112; i = row - s * 2112; T = 2048; } else { const int r = row - G0_ROWS, q = r / 4160; s = 16 + q; i = r - q * 4160; T = 4096; }
}
__device__ __forceinline__ GAS float* hptr(GAS float* out, GAS float* metah, int s, int i, int T) {
    if (i < T) { const size_t ob = s < 16 ? (size_t)s * 2048 : (size_t)32768 + (size_t)(s - 16) * 4096; return out + (ob + i) * DM; }
    return metah + (size_t)(s * 16 + (i - T)) * DM;
}
__device__ __forceinline__ void wt_item(const GAS float* W, int ldw, int K, GAS bf16* WT, const GAS float* gain, int k0, int srcn0, int dstn0, LAS float* scr, int lane) {
    const int c = lane & 7;
    if (srcn0 < 0) {
#pragma unroll
        for (int j = 0; j < 4; ++j) { const int n = (lane >> 3) + 8 * j; *(GAS u32x4*)(WT + (size_t)(dstn0 + n) * K + k0 + 8 * c) = (u32x4){0u, 0u, 0u, 0u}; }
        return;
    }
#pragma unroll 8
    for (int i = 0; i < 32; ++i) { const int kk = 2 * i + (lane >> 5); float v = W[(size_t)(k0 + kk) * ldw + srcn0 + (lane & 31)]; if (gain) v *= gain[k0 + kk]; scr[kk * 33 + (lane & 31)] = v; }
    asm volatile("s_waitcnt lgkmcnt(0)" ::: "memory");
#pragma unroll
    for (int j = 0; j < 4; ++j) { const int n = (lane >> 3) + 8 * j; const LAS float* s = scr + (8 * c) * 33 + n;
        u32x4 o; o.x = cvt_pk_bf16(s[0 * 33], s[1 * 33]); o.y = cvt_pk_bf16(s[2 * 33], s[3 * 33]); o.z = cvt_pk_bf16(s[4 * 33], s[5 * 33]); o.w = cvt_pk_bf16(s[6 * 33], s[7 * 33]);
        *(GAS u32x4*)(WT + (size_t)(dstn0 + n) * K + k0 + 8 * c) = o; }
    asm volatile("s_waitcnt lgkmcnt(0)" ::: "memory");
}
__device__ __forceinline__ void convert_layer(KArgsP ap, int l, LAS float* scr, int gw, int NGW, int lane) {
    const KArgs& a = *ap;
    GAS unsigned char* wb = (GAS unsigned char*)(a.ws + WS_W);
    constexpr int N_GU = 16 * 176, N_DN = 44 * 32, N_IN = 16 * 88, N_UQ = 12 * 24, N_UK = 4 * 16, N_WO = 16 * 32;
    constexpr int TOT = 2 * N_GU + 2 * N_DN + N_IN + N_UQ + 2 * N_UK + N_WO;
    for (int it = gw; it < TOT; it += NGW) {
        int r = it;
        if (r < 2 * N_GU) { const int f = r / N_GU; r -= f * N_GU; const int kb = r / 176, nb = r % 176; const int sb = ((nb >> 2) & 1) * 88 + 4 * (nb >> 3) + (nb & 3);
            wt_item((const GAS float*)a.in[f ? I_F2GU : I_F1GU] + (size_t)l * 1024 * 5632, 5632, 1024, (GAS bf16*)(wb + (f ? W_GU2 : W_GU1)), (const GAS float*)a.in[f ? I_F2PRE : I_F1PRE] + l * 1024, 64 * kb, 32 * sb, 32 * nb, scr, lane); continue; }
        r -= 2 * N_GU;
        if (r < 2 * N_DN) { const int f = r / N_DN; r -= f * N_DN; const int kb = r / 32, nb = r % 32;
            wt_item((const GAS float*)a.in[f ? I_F2DN : I_F1DN] + (size_t)l * 2816 * 1024, 1024, 2816, (GAS bf16*)(wb + (f ? W_DN2 : W_DN1)), nullptr, 64 * kb, 32 * nb, 32 * nb, scr, lane); continue; }
        r -= 2 * N_DN;
        if (r < N_IN) { const int kb = r / 88, nb = r % 88;
            wt_item((const GAS float*)a.in[I_WIN] + (size_t)l * 1024 * 2592, 2592, 1024, (GAS bf16*)(wb + W_IN), (const GAS float*)a.in[I_MPRE] + l * 1024, 64 * kb, nb < 81 ? 32 * nb : -1, 32 * nb, scr, lane); continue; }
        r -= N_IN;
        if (r < N_UQ) { const int kb = r / 24, nb = r % 24;
            wt_item((const GAS float*)a.in[I_WUQ] + (size_t)l * 768 * 768, 768, 768, (GAS bf16*)(wb + W_UQ), (const GAS float*)a.in[I_QN] + l * 768, 64 * kb, 32 * nb, 32 * nb, scr, lane); continue; }
        r -= N_UQ;
        if (r < 2 * N_UK) { const int v = r / N_UK; r -= v * N_UK; const int kb = r / 16, nb = r % 16; const int sb = (nb >> 1) * 4 + 2 * v + (nb & 1);
            wt_item((const GAS float*)a.in[I_WUKV] + (size_t)l * 256 * 1024, 1024, 256, (GAS bf16*)(wb + (v ? W_UV : W_UK)), (const GAS float*)a.in[I_KVN] + l * 256, 64 * kb, 32 * sb, 32 * nb, scr, lane); continue; }
        r -= 2 * N_UK;
        { const int kb = r / 32, nb = r % 32; const int k0 = 64 * kb;
            const GAS float* gain = k0 < 256 ? (const GAS float*)a.in[I_CON] + l * 256 : (k0 < 512 ? (const GAS float*)a.in[I_NON] + l * 256 - 256 : (const GAS float*)a.in[I_MON] + l * 512 - 512);
            wt_item((const GAS float*)a.in[I_WO] + (size_t)l * 1024 * 1024, 1024, 1024, (GAS bf16*)(wb + W_O), gain, k0, 32 * nb, 32 * nb, scr, lane); }
    }
}
__device__ __forceinline__ void wave_sum2(float& a, float& b) {
#pragma unroll
    for (int o = 1; o < 64; o <<= 1) { const float ta = __shfl_xor(a, o), tb = __shfl_xor(b, o); a += ta; b += tb; }
}
__device__ __forceinline__ void rowpass(KArgsP ap, const GAS float* gpost, float coef, bool init, int row_lo, int row_hi, int gw, int NGW, int lane) {
    const KArgs& a = *ap;
    GAS bf16* XY = (GAS bf16*)(a.ws + WS_XY); const GAS bf16* YB = (const GAS bf16*)a.out; GAS float* RINV = (GAS float*)(a.ws + WS_RINV);
    f32x4 g[4];
#pragma unroll
    for (int j = 0; j < 4; ++j) g[j] = init ? (f32x4){0.f, 0.f, 0.f, 0.f} : ((const GAS f32x4*)gpost)[lane + 64 * j] * coef;
    for (int row0 = row_lo + gw; row0 < row_hi; row0 += 2 * NGW) {
        GAS unsigned long long* xy8[2]; bool val[2], ex[2]; int rw[2]; f32x4 h[2][4]; unsigned long long yw[2][4];
#pragma unroll
        for (int k = 0; k < 2; ++k) {
            const int row = row0 + k * NGW; ex[k] = row < row_hi; rw[k] = ex[k] ? row : 0; int s = 0, i = 0, T = 1; row_decode(rw[k], s, i, T);
            val[k] = ex[k] && (i < T + 16);
            xy8[k] = (GAS unsigned long long*)(XY + (size_t)rw[k] * DM) + lane;
#pragma unroll
            for (int j = 0; j < 4; ++j) { h[k][j] = (f32x4){0.f, 0.f, 0.f, 0.f}; yw[k][j] = 0ull; }
            if (val[k]) {
                if (init) { const GAS float* src = (i < T) ? (s < 16 ? (const GAS float*)a.in[I_XP] + ((size_t)s * 2048 + i) * DM : (const GAS float*)a.in[I_XS] + ((size_t)(s - 16) * 4096 + i) * DM) : (const GAS float*)a.in[I_META] + (size_t)(i - T) * DM;
#pragma unroll
                    for (int j = 0; j < 4; ++j) h[k][j] = ((const GAS f32x4*)src)[lane + 64 * j]; }
                else { const GAS unsigned long long* y8 = (const GAS unsigned long long*)(YB + (size_t)rw[k] * DM) + lane;
#pragma unroll
                    for (int j = 0; j < 4; ++j) { yw[k][j] = y8[64 * j]; const unsigned long long hw = xy8[k][64 * j]; const unsigned lo = (unsigned)hw, hi = (unsigned)(hw >> 32); h[k][j] = (f32x4){bflo(lo), bfhi(lo), bflo(hi), bfhi(hi)}; } }
            }
        }
        f32x4 y[2][4]; float ss[2] = {0.f, 0.f};
#pragma unroll
        for (int k = 0; k < 2; ++k)
#pragma unroll
            for (int j = 0; j < 4; ++j) { const unsigned lo = (unsigned)yw[k][j], hi = (unsigned)(yw[k][j] >> 32);
                y[k][j] = (f32x4){bflo(lo), bfhi(lo), bflo(hi), bfhi(hi)}; ss[k] += (y[k][j][0] * y[k][j][0] + y[k][j][1] * y[k][j][1]) + (y[k][j][2] * y[k][j][2] + y[k][j][3] * y[k][j][3]); }
        if (!init) wave_sum2(ss[0], ss[1]);
        float s2[2] = {0.f, 0.f}; unsigned long long ow[2][4];
#pragma unroll
        for (int k = 0; k < 2; ++k) { const float ry = __builtin_amdgcn_rsqf(ss[k] * (1.0f / DM) + RMS_EPS);
#pragma unroll
            for (int j = 0; j < 4; ++j) { if (!init) h[k][j] = h[k][j] + y[k][j] * g[j] * ry;
                const unsigned lo = cvt_pk_bf16(h[k][j][0], h[k][j][1]), hi = cvt_pk_bf16(h[k][j][2], h[k][j][3]); ow[k][j] = (unsigned long long)lo | ((unsigned long long)hi << 32);
                const f32x4 hr = (f32x4){bflo(lo), bfhi(lo), bflo(hi), bfhi(hi)};
                s2[k] += (hr[0] * hr[0] + hr[1] * hr[1]) + (hr[2] * hr[2] + hr[3] * hr[3]); } }
        wave_sum2(s2[0], s2[1]);
#pragma unroll
        for (int k = 0; k < 2; ++k) if (ex[k]) {
#pragma unroll
            for (int j = 0; j < 4; ++j) xy8[k][64 * j] = val[k] ? ow[k][j] : 0ull;
            if (lane == 0) RINV[rw[k]] = val[k] ? __builtin_amdgcn_rsqf(s2[k] * (1.0f / DM) + RMS_EPS) : 0.f; }
    }
}
__device__ __forceinline__ void output_pass(KArgsP ap, int gw, int NGW, int lane) {
    const KArgs& a = *ap; const GAS bf16* XY = (const GAS bf16*)(a.ws + WS_XY); GAS float* out = (GAS float*)a.out;
    for (int row = gw; row < MP; row += NGW) {
        int s, i, T; row_decode(row, s, i, T); if (i >= T) continue;
        const size_t ob = s < 16 ? (size_t)s * 2048 : (size_t)32768 + (size_t)(s - 16) * 4096;
        const GAS unsigned long long* x8 = (const GAS unsigned long long*)(XY + (size_t)row * DM) + lane; GAS f32x4* o = (GAS f32x4*)(out + (ob + i) * DM) + lane;
#pragma unroll
        for (int j = 0; j < 4; ++j) { const unsigned long long w = x8[64 * j]; const unsigned lo = (unsigned)w, hi = (unsigned)(w >> 32); o[64 * j] = (f32x4){bflo(lo), bfhi(lo), bflo(hi), bfhi(hi)}; }
    }
}
__device__ __forceinline__ void rope_table(GAS float* tab, int gt, int NGT) {
    for (int e = gt; e < 4112 * 16; e += NGT) { const int pos = e >> 4, j = e & 15; double f = 1.0; for (int k = 0; k < j; ++k) f *= 0.56234132519034907;
        double rev = (double)pos * f * 0.15915494309189535; rev -= __builtin_floor(rev); const float rv = (float)rev;
        tab[2 * e] = __builtin_amdgcn_cosf(rv); tab[2 * e + 1] = __builtin_amdgcn_sinf(rv); }
}
struct Grp { int row0, rows, T, Lp, nseq; };
__device__ __forceinline__ Grp grp_of(int g) { Grp r; if (g == 0) { r.row0 = 0; r.rows = G0_ROWS; r.T = 2048; r.Lp = 2112; r.nseq = 16; } else { r.row0 = G0_ROWS; r.rows = G1_ROWS; r.T = 4096; r.Lp = 4160; r.nseq = 8; } return r; }
__device__ __forceinline__ f32x4 cprod(unsigned long long c, unsigned long long u) {
    return (f32x4){bflo((unsigned)c) * bflo((unsigned)u), bfhi((unsigned)c) * bfhi((unsigned)u), bflo((unsigned)(c >> 32)) * bflo((unsigned)(u >> 32)), bfhi((unsigned)(c >> 32)) * bfhi((unsigned)(u >> 32))};
}
__device__ __forceinline__ void conv_kpe_pass(KArgsP ap, int l, const Grp& G, int gw, int NGW, int lane) {
    const KArgs& a = *ap;
    const GAS bf16* Z = (const GAS bf16*)(a.ws + WS_BIG + B_Z); GAS bf16* KB = (GAS bf16*)(a.ws + WS_BIG + B_K); GAS bf16* YC = (GAS bf16*)(a.ws + WS_BIG + B_YC) + (size_t)G.row0 * DM;
    const GAS float* cw = (const GAS float*)a.in[I_CONVW] + (size_t)l * 3 * 256; const GAS float* rope = (const GAS float*)(a.ws + WS_ROPE);
    const f32x4 w0 = ((const GAS f32x4*)cw)[lane], w1 = ((const GAS f32x4*)(cw + 256))[lane], w2 = ((const GAS f32x4*)(cw + 512))[lane];
    const int T = G.T;
    for (int gr0 = gw; gr0 < G.rows; gr0 += 2 * NGW) {
        bool ex[2], val[2]; int grr[2], pp[2]; unsigned long long cb[2], cc[2], cu[2], lc[2], lu[2], rc[2], ru[2]; unsigned short x1[2], x2[2]; float rcs[2], rsn[2];
#pragma unroll
        for (int k = 0; k < 2; ++k) {
            const int gr = gr0 + k * NGW; ex[k] = gr < G.rows; grr[k] = ex[k] ? gr : 0;
            const int sq = grr[k] / G.Lp, i = grr[k] - sq * G.Lp; val[k] = ex[k] && (i < T + 16);
            const int p = (i < T) ? 16 + i : i - T; pp[k] = val[k] ? p : 0;
            const int il = (p == 0) ? -1 : ((p - 1 >= 16) ? p - 17 : T + p - 1), ir = (p == T + 15) ? -1 : ((p + 1 >= 16) ? p - 15 : T + p + 1);
            cb[k] = cc[k] = cu[k] = lc[k] = lu[k] = rc[k] = ru[k] = 0ull; x1[k] = x2[k] = 0; rcs[k] = 1.f; rsn[k] = 0.f;
            if (val[k]) {
                const GAS bf16* zr = Z + (size_t)grr[k] * ZP;
                cb[k] = *((const GAS unsigned long long*)zr + lane); cc[k] = *((const GAS unsigned long long*)(zr + 256) + lane); cu[k] = *((const GAS unsigned long long*)(zr + 512) + lane);
                if (il >= 0) { const GAS bf16* z2 = Z + (size_t)(sq * G.Lp + il) * ZP; lc[k] = *((const GAS unsigned long long*)(z2 + 256) + lane); lu[k] = *((const GAS unsigned long long*)(z2 + 512) + lane); }
                if (ir >= 0) { const GAS bf16* z2 = Z + (size_t)(sq * G.Lp + ir) * ZP; rc[k] = *((const GAS unsigned long long*)(z2 + 256) + lane); ru[k] = *((const GAS unsigned long long*)(z2 + 512) + lane); }
                if (lane < 16) { x1[k] = zr[2560 + lane]; x2[k] = zr[2576 + lane]; rcs[k] = rope[(size_t)p * 32 + 2 * lane]; rsn[k] = rope[(size_t)p * 32 + 2 * lane + 1]; }
            }
        }
        f32x4 y[2]; float ss[2];
#pragma unroll
        for (int k = 0; k < 2; ++k) { const f32x4 cbv = (f32x4){bflo((unsigned)cb[k]), bfhi((unsigned)cb[k]), bflo((unsigned)(cb[k] >> 32)), bfhi((unsigned)(cb[k] >> 32))};
            y[k] = cbv * (w0 * cprod(lc[k], lu[k]) + w1 * cprod(cc[k], cu[k]) + w2 * cprod(rc[k], ru[k]));
            ss[k] = (y[k][0] * y[k][0] + y[k][1] * y[k][1]) + (y[k][2] * y[k][2] + y[k][3] * y[k][3]); }
        wave_sum2(ss[0], ss[1]);
#pragma unroll
        for (int k = 0; k < 2; ++k) if (ex[k]) {
            const float rn = __builtin_amdgcn_rsqf(ss[k] * (1.0f / 256.0f) + RMS_EPS); const f32x4 o = y[k] * rn;
            *((GAS unsigned long long*)(YC + (size_t)grr[k] * DM) + lane) = (unsigned long long)cvt_pk_bf16(o[0], o[1]) | ((unsigned long long)cvt_pk_bf16(o[2], o[3]) << 32);
            if (lane < 16) { const float a1 = bf2f(x1[k]), a2 = bf2f(x2[k]); const unsigned pk = cvt_pk_bf16(a1 * rcs[k] - a2 * rsn[k], a1 * rsn[k] + a2 * rcs[k]); const bf16 o1 = (bf16)(pk & 0xffffu), o2 = (bf16)(pk >> 16);
#pragma unroll
                for (int h = 0; h < 8; ++h) { KB[(size_t)grr[k] * 768 + 96 * h + 64 + lane] = o1; KB[(size_t)grr[k] * 768 + 96 * h + 80 + lane] = o2; } }
        }
    }
}
__device__ __forceinline__ void ynorm_pass(KArgsP ap, int gw, int NGW, int lane) {
    const KArgs& a = *ap;
    GAS bf16* YC = (GAS bf16*)(a.ws + WS_BIG + B_YC);
    for (int gr0 = gw; gr0 < MP; gr0 += 2 * NGW) {
        bool ex[2], val[2]; GAS unsigned long long* p1[2]; GAS u32x4* p2[2]; unsigned long long w[2]; u32x4 v[2];
#pragma unroll
        for (int k = 0; k < 2; ++k) { const int gr = gr0 + k * NGW; ex[k] = gr < MP; const int g2 = ex[k] ? gr : 0; int sq, i, T; row_decode(g2, sq, i, T); val[k] = ex[k] && (i < T + 16);
            p1[k] = (GAS unsigned long long*)(YC + (size_t)g2 * DM + 256) + lane; p2[k] = (GAS u32x4*)(YC + (size_t)g2 * DM + 512) + lane;
            w[k] = 0ull; v[k] = (u32x4){0u, 0u, 0u, 0u}; if (val[k]) { w[k] = *p1[k]; v[k] = *p2[k]; } }
        float y[2][4], z[2][8], s1[2], s2[2];
#pragma unroll
        for (int k = 0; k < 2; ++k) { y[k][0] = bflo((unsigned)w[k]); y[k][1] = bfhi((unsigned)w[k]); y[k][2] = bflo((unsigned)(w[k] >> 32)); y[k][3] = bfhi((unsigned)(w[k] >> 32));
            z[k][0] = bflo(v[k].x); z[k][1] = bfhi(v[k].x); z[k][2] = bflo(v[k].y); z[k][3] = bfhi(v[k].y); z[k][4] = bflo(v[k].z); z[k][5] = bfhi(v[k].z); z[k][6] = bflo(v[k].w); z[k][7] = bfhi(v[k].w);
            s1[k] = (y[k][0] * y[k][0] + y[k][1] * y[k][1]) + (y[k][2] * y[k][2] + y[k][3] * y[k][3]); s2[k] = 0.f;
#pragma unroll
            for (int e = 0; e < 8; ++e) s2[k] += z[k][e] * z[k][e]; }
        wave_sum2(s1[0], s1[1]); wave_sum2(s2[0], s2[1]);
#pragma unroll
        for (int k = 0; k < 2; ++k) if (ex[k]) {
            const float r1 = val[k] ? __builtin_amdgcn_rsqf(s1[k] * (1.0f / 256.0f) + RMS_EPS) : 0.f, r2 = val[k] ? __builtin_amdgcn_rsqf(s2[k] * (1.0f / 512.0f) + RMS_EPS) : 0.f;
            *p1[k] = (unsigned long long)cvt_pk_bf16(y[k][0] * r1, y[k][1] * r1) | ((unsigned long long)cvt_pk_bf16(y[k][2] * r1, y[k][3] * r1) << 32);
            u32x4 o; o.x = cvt_pk_bf16(z[k][0] * r2, z[k][1] * r2); o.y = cvt_pk_bf16(z[k][2] * r2, z[k][3] * r2); o.z = cvt_pk_bf16(z[k][4] * r2, z[k][5] * r2); o.w = cvt_pk_bf16(z[k][6] * r2, z[k][7] * r2); *p2[k] = o; }
    }
}
struct AttG { const GAS bf16 *Q, *K, *VT, *Z; GAS bf16* YC; const GAS float* rope; int rows, T, Lp; };
__device__ __forceinline__ int crow(int r, int hi) { return (r & 3) + 8 * (r >> 2) + 4 * hi; }
#define MFMA32(a, b, c) __builtin_amdgcn_mfma_f32_32x32x16_bf16((a), (b), (c), 0, 0, 0)
template <int MODE>
__device__ __forceinline__ void attn_unit(const AttG& P, int seq, int head, int qb, LAS unsigned char* lds, int tid, int wid, int lane) {
    constexpr int DQK = MODE == 0 ? 96 : 64, NDK = DQK / 16, KP = DQK * 2 + 16, VP = 144;
    const int r32 = lane & 31, hi = lane >> 5;
    const int T = P.T, Lp = P.Lp, nqbr = T >> 8; const bool metablk = (qb == nqbr);
    const int sbase = seq * Lp;
    const int qi = qb * 256 + wid * 32 + r32; const int qic = qi < Lp - 1 ? qi : Lp - 1;
    bf16x8 qr[NDK];
    { const GAS bf16* qsrc = MODE == 0 ? P.Q + (size_t)(sbase + qic) * 768 + 96 * head : P.Z + (size_t)(sbase + qic) * ZP + 768 + 64 * head;
#pragma unroll
      for (int d0 = 0; d0 < NDK; ++d0) qr[d0] = *(const GAS bf16x8*)(qsrc + 16 * d0 + 8 * hi); }
    if constexpr (MODE == 0) {
        const int pos = qic < T ? 16 + qic : (qic - T < 15 ? qic - T : 15);
        const GAS f32x4* rp = (const GAS f32x4*)(P.rope + (size_t)pos * 32 + 16 * hi);
#pragma unroll
        for (int e2 = 0; e2 < 4; ++e2) { const f32x4 cs = rp[e2];
#pragma unroll
            for (int q = 0; q < 2; ++q) { const int e = 2 * e2 + q; const float c = cs[2 * q], s = cs[2 * q + 1];
                const float x1 = bf2f((unsigned short)qr[4][e]), x2 = bf2f((unsigned short)qr[5][e]);
                const unsigned pk = cvt_pk_bf16(x1 * c - x2 * s, x1 * s + x2 * c); qr[4][e] = (short)(pk & 0xffffu); qr[5][e] = (short)(pk >> 16); } }
    }
    int nt, kr_lo = 0; const int rows_total = T >> 6;
    int na_r = 0, na_c = 0, na_rs = 0, na_cs = 0;
    if constexpr (MODE == 0) nt = rows_total + 1;
    else {
        if (metablk) nt = 1;
        else { const int r0 = 4 * qb; int lo = r0 - 4; lo = lo < 0 ? 0 : (lo > rows_total - 8 ? rows_total - 8 : lo); int h2 = r0 - 1; h2 = h2 < 0 ? 0 : (h2 > rows_total - 8 ? rows_total - 8 : h2);
            kr_lo = lo; nt = (h2 + 7 - lo + 1) + 1; }
        na_r = 4 * qb + (wid >> 1); na_c = 32 * (wid & 1) + r32;
        na_rs = na_r - 4; na_rs = na_rs < 0 ? 0 : (na_rs > rows_total - 8 ? rows_total - 8 : na_rs);
        na_cs = na_c - 8; na_cs = na_cs < 0 ? 0 : (na_cs > 48 ? 48 : na_cs);
    }
    const LAS float* tabL = (const LAS float*)(lds + A_TAB) + head * 640 + 64;
    const LAS float* mbL = (const LAS float*)(lds + A_TAB + 4 * 640 * 4) + head * 16;
    LAS float* wsf = (LAS float*)(lds + A_WSF) + wid * 64;
    u32x4 kst0, kst1 = {0u, 0u, 0u, 0u}, vst;
    const int kc0 = tid, kc1 = 512 + tid;
#define TILE_KB(t) ((t) == nt - 1 ? T : 64 * (kr_lo + (t)))
#define GLOAD(t) do { const int kb_ = TILE_KB(t); \
      if constexpr (MODE == 0) { { const int krow = kc0 / 12, part = kc0 % 12; kst0 = *(const GAS u32x4*)(P.K + (size_t)(sbase + kb_ + krow) * 768 + 96 * head + 8 * part); } \
          if (tid < 256) { const int krow = kc1 / 12, part = kc1 % 12; kst1 = *(const GAS u32x4*)(P.K + (size_t)(sbase + kb_ + krow) * 768 + 96 * head + 8 * part); } \
          { const int d = tid >> 3, part = tid & 7; vst = *(const GAS u32x4*)(P.VT + (size_t)(64 * head + d) * P.rows + sbase + kb_ + 8 * part); } } \
      else { const int krow = tid >> 3, part = tid & 7; const GAS bf16* zr_ = P.Z + (size_t)(sbase + kb_ + krow) * ZP + 64 * head + 8 * part; kst0 = *(const GAS u32x4*)(zr_ + 1024); vst = *(const GAS u32x4*)(zr_ + 1280); } } while (0)
#define LSTORE(buf) do { LAS unsigned char* Kb_ = lds + A_K + (buf) * A_KBUF; LAS unsigned char* Vb_ = lds + A_V + (buf) * A_VBUF; \
      if constexpr (MODE == 0) { { const int krow = kc0 / 12, part = kc0 % 12; *(LAS u32x4*)(Kb_ + krow * KP + part * 16) = kst0; } \
          if (tid < 256) { const int krow = kc1 / 12, part = kc1 % 12; *(LAS u32x4*)(Kb_ + krow * KP + part * 16) = kst1; } \
          { const int d = tid >> 3, part = tid & 7; *(LAS u32x4*)(Vb_ + d * VP + part * 16) = vst; } } \
      else { const int krow = tid >> 3, part = tid & 7; *(LAS u32x4*)(Kb_ + krow * KP + part * 16) = kst0; \
          const int kpos_ = (krow & ~12) | ((krow & 4) << 1) | ((krow & 8) >> 1); LAS unsigned short* vt_ = (LAS unsigned short*)(Vb_ + (8 * part) * VP + kpos_ * 2); \
          vt_[0 * (VP / 2)] = (unsigned short)(vst.x & 0xffffu); vt_[1 * (VP / 2)] = (unsigned short)(vst.x >> 16); vt_[2 * (VP / 2)] = (unsigned short)(vst.y & 0xffffu); vt_[3 * (VP / 2)] = (unsigned short)(vst.y >> 16); \
          vt_[4 * (VP / 2)] = (unsigned short)(vst.z & 0xffffu); vt_[5 * (VP / 2)] = (unsigned short)(vst.z >> 16); vt_[6 * (VP / 2)] = (unsigned short)(vst.w & 0xffffu); vt_[7 * (VP / 2)] = (unsigned short)(vst.w >> 16); } } while (0)
    GLOAD(0); LSTORE(0);
    __syncthreads();
    float l_reg = 0.f; bool have_m0 = false;
    f32x16 o0, o1, negm;
#pragma unroll
    for (int r = 0; r < 16; ++r) { o0[r] = 0.f; o1[r] = 0.f; negm[r] = 0.f; }
    for (int t = 0; t < nt; ++t) {
        const int buf = t & 1; const bool more = (t + 1 < nt);
        if (more) GLOAD(t + 1);
        const bool is_meta = (t == nt - 1);
        bool active = true;
        if constexpr (MODE == 1) { if (!is_meta) { const int kr = kr_lo + t; active = (kr >= na_rs && kr <= na_rs + 7); } }
        if (active) {
            const LAS unsigned char* Kb = lds + A_K + buf * A_KBUF; const LAS unsigned char* Vb = lds + A_V + buf * A_VBUF;
            f32x16 p0 = negm, p1 = negm;
            bf16x8 kf[2 * NDK]; bf16x8 vf[8];
#pragma unroll
            for (int d0 = 0; d0 < NDK; ++d0) {
                kf[2 * d0] = *(const LAS bf16x8*)(Kb + r32 * KP + d0 * 32 + hi * 16);
                kf[2 * d0 + 1] = *(const LAS bf16x8*)(Kb + (32 + r32) * KP + d0 * 32 + hi * 16);
            }
            __builtin_amdgcn_sched_barrier(0);
#pragma unroll
            for (int d0 = 0; d0 < NDK; ++d0) { p0 = MFMA32(kf[2 * d0], qr[d0], p0); p1 = MFMA32(kf[2 * d0 + 1], qr[d0], p1); }
            __builtin_amdgcn_sched_barrier(0);
#pragma unroll
            for (int ks = 0; ks < 4; ++ks) {
                const LAS unsigned char* vp0 = Vb + r32 * VP + (16 * ks + 8 * hi) * 2;
                vf[2 * ks] = *(const LAS bf16x8*)vp0; vf[2 * ks + 1] = *(const LAS bf16x8*)(vp0 + 32 * VP);
            }
            __builtin_amdgcn_sched_barrier(0);
            if (is_meta) {
#pragma unroll
                for (int r = 0; r < 16; ++r) { const int kv = crow(r, hi); float b = 0.f; if constexpr (MODE == 1) b = mbL[kv & 15]; p0[r] = kv < 16 ? p0[r] + b : -INFINITY; p1[r] = -INFINITY; }
            } else if constexpr (MODE == 1) {
                const int kr = kr_lo + t; const LAS float* rp = tabL + (kr - na_r + 7) * 31 + (15 - na_c);
#pragma unroll
                for (int r = 0; r < 16; ++r) { const int kc = crow(r, hi);
                    p0[r] = (kc >= na_cs && kc < na_cs + 16) ? p0[r] + rp[kc] : -INFINITY;
                    p1[r] = (kc + 32 >= na_cs && kc + 32 < na_cs + 16) ? p1[r] + rp[kc + 32] : -INFINITY; }
            }
            if (!have_m0) {
                float mx = fmaxf(p0[0], p1[0]);
#pragma unroll
                for (int r = 1; r < 16; ++r) mx = fmaxf(mx, fmaxf(p0[r], p1[r]));
                mx = fmaxf(mx, __shfl_xor(mx, 32));
#pragma unroll
                for (int r = 0; r < 16; ++r) { p0[r] -= mx; p1[r] -= mx; negm[r] = -mx; }
                have_m0 = true;
            }
            { typedef float f32x2 __attribute__((ext_vector_type(2)));
              f32x2 accA = {0.f, 0.f}, accB = {0.f, 0.f};
#pragma unroll
              for (int r = 0; r < 16; r += 2) {
                  f32x2 a, b;
                  a.x = __builtin_amdgcn_exp2f(fminf(p0[r], 100.0f)); a.y = __builtin_amdgcn_exp2f(fminf(p0[r + 1], 100.0f));
                  b.x = __builtin_amdgcn_exp2f(fminf(p1[r], 100.0f)); b.y = __builtin_amdgcn_exp2f(fminf(p1[r + 1], 100.0f));
                  accA += a; accB += b; p0[r] = a.x; p0[r + 1] = a.y; p1[r] = b.x; p1[r + 1] = b.y; }
              const f32x2 acc = accA + accB; l_reg += acc.x + acc.y; }
            bf16x8 pa[4];
#pragma unroll
            for (int ks = 0; ks < 4; ++ks) { u32x4 w;
                if (ks < 2) { w.x = cvt_pk_bf16(p0[8 * ks + 0], p0[8 * ks + 1]); w.y = cvt_pk_bf16(p0[8 * ks + 2], p0[8 * ks + 3]); w.z = cvt_pk_bf16(p0[8 * ks + 4], p0[8 * ks + 5]); w.w = cvt_pk_bf16(p0[8 * ks + 6], p0[8 * ks + 7]); }
                else { const int b = 8 * (ks - 2); w.x = cvt_pk_bf16(p1[b + 0], p1[b + 1]); w.y = cvt_pk_bf16(p1[b + 2], p1[b + 3]); w.z = cvt_pk_bf16(p1[b + 4], p1[b + 5]); w.w = cvt_pk_bf16(p1[b + 6], p1[b + 7]); }
                pa[ks] = __builtin_bit_cast(bf16x8, w); }
#pragma unroll
            for (int ks = 0; ks < 4; ++ks) {
                o0 = MFMA32(pa[ks], vf[2 * ks], o0); o1 = MFMA32(pa[ks], vf[2 * ks + 1], o1);
            }
        }
        if (more) LSTORE(buf ^ 1);
        __syncthreads();
    }
#undef GLOAD
#undef LSTORE
#undef TILE_KB
    l_reg += __shfl_xor(l_reg, 32);
    if (hi == 0) wsf[32 + r32] = l_reg;
    asm volatile("s_waitcnt lgkmcnt(0)" ::: "memory");
    LAS unsigned short* stg = (LAS unsigned short*)(lds + A_STG) + wid * 2048;
#pragma unroll
    for (int j = 0; j < 4; ++j) { const f32x4 lv = *(const LAS f32x4*)(wsf + 32 + 8 * j + 4 * hi);
#pragma unroll
        for (int e = 0; e < 4; ++e) { const int r = 4 * j + e; const float rl = __builtin_amdgcn_rcpf(lv[e]); const int orow = crow(r, hi);
            const unsigned pk = cvt_pk_bf16(o0[r] * rl, o1[r] * rl); stg[orow * 64 + r32] = (unsigned short)(pk & 0xffffu); stg[orow * 64 + 32 + r32] = (unsigned short)(pk >> 16); } }
    asm volatile("s_waitcnt lgkmcnt(0)" ::: "memory");
    { const int coloff = (MODE == 0 ? 512 : 256) + 64 * head;
#pragma unroll
      for (int i = 0; i < 4; ++i) { const int row = i * 8 + (lane >> 3), ch = lane & 7; const u32x4 v = *(const LAS u32x4*)(stg + row * 64 + ch * 8);
          const int qrow = qb * 256 + wid * 32 + row; const bool valid = metablk ? (wid == 0 && row < 16) : true;
          if (valid) *(GAS u32x4*)(P.YC + (size_t)(sbase + qrow) * DM + coloff + ch * 8) = v; } }
    asm volatile("s_waitcnt lgkmcnt(0)" ::: "memory");
}
__device__ __forceinline__ void glds16(const GAS void* gsrc, unsigned lds_dst) { unsigned keep;
    asm volatile("s_mov_b32 %0, m0\n\ts_mov_b32 m0, %2\n\ts_nop 0\n\tglobal_load_lds_dwordx4 %1, off\n\ts_mov_b32 m0, %0" : "=&s"(keep) : "v"(gsrc), "s"(lds_dst) : "memory"); }
__device__ __forceinline__ void attn_unit_mla(const AttG& P, int seq, int head, int qb, LAS unsigned char* lds, int tid_in, int wid, int lane_in) {
    int lane = lane_in, tid = tid_in; asm volatile("" : "+v"(lane), "+v"(tid));
    const int r32 = lane & 31, hi = lane >> 5;
    const int T = P.T, Lp = P.Lp, sbase = seq * Lp, nt = (T >> 6) + 1;
    const int qi = qb * 256 + wid * 32 + r32;
    bf16x8 qr[6];
    { const GAS bf16* qsrc = P.Q + (size_t)(sbase + qi) * 768 + 96 * head;
#pragma unroll
      for (int d0 = 0; d0 < 6; ++d0) qr[d0] = *(const GAS bf16x8*)(qsrc + 16 * d0 + 8 * hi);
      const GAS f32x4* rp = (const GAS f32x4*)(P.rope + (size_t)(16 + qi) * 32 + 16 * hi);
#pragma unroll
      for (int e2 = 0; e2 < 4; ++e2) { const f32x4 cs = rp[e2];
#pragma unroll
          for (int q = 0; q < 2; ++q) { const int e = 2 * e2 + q; const float c = cs[2 * q], sn = cs[2 * q + 1];
              const float x1 = bf2f((unsigned short)qr[4][e]), x2 = bf2f((unsigned short)qr[5][e]);
              const unsigned pk = cvt_pk_bf16(x1 * c - x2 * sn, x1 * sn + x2 * c); qr[4][e] = (short)(pk & 0xffffu); qr[5][e] = (short)(pk >> 16); } } }
    const unsigned lds0 = (unsigned)(unsigned long long)lds;
    int koffA, koffB, voff;
    { int s = 64 * wid + lane; int row = s / 12, pos = s - 12 * row; int part = pos - ((row >> 2) & 3); part = part < 0 ? part + 12 : part; koffA = row * 768 + 8 * part;
      s = 64 * (8 + wid) + lane; row = s / 12; pos = s - 12 * row; part = pos - ((row >> 2) & 3); part = part < 0 ? part + 12 : part; koffB = row * 768 + 8 * part;
      s = 64 * wid + lane; const int d = s >> 3, c = (s & 7) ^ ((d >> 1) & 7); voff = d * P.rows + 8 * c; }
    const GAS bf16* Kg = P.K + (size_t)sbase * 768 + 96 * head; const GAS bf16* Vg = P.VT + (size_t)(64 * head) * P.rows + sbase;
    const unsigned kdst = lds0 + D_K + wid * 1024, vdst = lds0 + D_V + wid * 1024;
#define DMA_TILE(t, b) do { const int kb_ = ((t) == nt - 1) ? T : 64 * (t); \
        glds16(Kg + (size_t)kb_ * 768 + koffA, (unsigned)__builtin_amdgcn_readfirstlane(kdst + (b) * D_KBUF)); \
        if (wid < 4) glds16(Kg + (size_t)kb_ * 768 + koffB, (unsigned)__builtin_amdgcn_readfirstlane(kdst + (b) * D_KBUF + 8192)); \
        glds16(Vg + voff + kb_, (unsigned)__builtin_amdgcn_readfirstlane(vdst + (b) * D_VBUF)); } while (0)
    int kpos[6], vpos[4];
    { const int f = (r32 >> 2) & 3;
#pragma unroll
      for (int d0 = 0; d0 < 6; ++d0) { int x = 2 * d0 + hi + f; x = x >= 12 ? x - 12 : x; kpos[d0] = r32 * 192 + x * 16; }
#pragma unroll
      for (int ks = 0; ks < 4; ++ks) vpos[ks] = r32 * 128 + (((2 * ks + hi) ^ ((r32 >> 1) & 7)) * 16); }
    asm volatile("s_waitcnt vmcnt(0)" ::: "memory");
    DMA_TILE(0, 0);
    DMA_TILE(1, 1);
    f32x16 o0, o1, o2, negm;
#pragma unroll
    for (int r = 0; r < 16; ++r) { o0[r] = 0.f; o1[r] = 0.f; o2[r] = 0.f; negm[r] = 0.f; }
    const bf16x8 ones = (bf16x8){0x3F80, 0x3F80, 0x3F80, 0x3F80, 0x3F80, 0x3F80, 0x3F80, 0x3F80};
    int b = 0;
    for (int t = 0; t < nt; ++t) {
        if (t + 1 < nt) { if (wid < 4) asm volatile("s_waitcnt vmcnt(3)" ::: "memory"); else asm volatile("s_waitcnt vmcnt(2)" ::: "memory"); }
        else asm volatile("s_waitcnt vmcnt(0)" ::: "memory");
        __builtin_amdgcn_s_barrier(); asm volatile("" ::: "memory");
        if (t + 2 < nt) { const int b2 = b >= 1 ? b - 1 : 2; DMA_TILE(t + 2, b2); }
        const LAS unsigned char* Kb = lds + D_K + b * D_KBUF; const LAS unsigned char* Vb = lds + D_V + b * D_VBUF;
        f32x16 p0 = negm, p1 = negm;
        bf16x8 kf[12], vf[8];
#pragma unroll
        for (int d0 = 0; d0 < 6; ++d0) { kf[2 * d0] = *(const LAS bf16x8*)(Kb + kpos[d0]); kf[2 * d0 + 1] = *(const LAS bf16x8*)(Kb + kpos[d0] + 32 * 192); }
        __builtin_amdgcn_sched_barrier(0);
#pragma unroll
        for (int d0 = 0; d0 < 6; ++d0) { p0 = MFMA32(kf[2 * d0], qr[d0], p0); p1 = MFMA32(kf[2 * d0 + 1], qr[d0], p1); }
        __builtin_amdgcn_sched_barrier(0);
#pragma unroll
        for (int ks = 0; ks < 4; ++ks) { vf[2 * ks] = *(const LAS bf16x8*)(Vb + vpos[ks]); vf[2 * ks + 1] = *(const LAS bf16x8*)(Vb + vpos[ks] + 32 * 128); }
        __builtin_amdgcn_sched_barrier(0);
        if (t == nt - 1) {
#pragma unroll
            for (int r = 0; r < 16; ++r) { if (crow(r, hi) >= 16) p0[r] = -INFINITY; p1[r] = -INFINITY; }
        }
        if (t == 0) { float mx = fmaxf(p0[0], p1[0]);
#pragma unroll
            for (int r = 1; r < 16; ++r) mx = fmaxf(mx, fmaxf(p0[r], p1[r]));
            mx = fmaxf(mx, __shfl_xor(mx, 32));
#pragma unroll
            for (int r = 0; r < 16; ++r) { p0[r] -= mx; p1[r] -= mx; negm[r] = -mx; } }
#pragma unroll
        for (int r = 0; r < 16; ++r) { p0[r] = __builtin_amdgcn_exp2f(p0[r]); p1[r] = __builtin_amdgcn_exp2f(p1[r]); }
#pragma unroll
        for (int ks = 0; ks < 4; ++ks) { u32x4 w;
            if (ks < 2) { w.x = cvt_pk_bf16(p0[8 * ks + 0], p0[8 * ks + 1]); w.y = cvt_pk_bf16(p0[8 * ks + 2], p0[8 * ks + 3]); w.z = cvt_pk_bf16(p0[8 * ks + 4], p0[8 * ks + 5]); w.w = cvt_pk_bf16(p0[8 * ks + 6], p0[8 * ks + 7]); }
            else { const int bb = 8 * (ks - 2); w.x = cvt_pk_bf16(p1[bb + 0], p1[bb + 1]); w.y = cvt_pk_bf16(p1[bb + 2], p1[bb + 3]); w.z = cvt_pk_bf16(p1[bb + 4], p1[bb + 5]); w.w = cvt_pk_bf16(p1[bb + 6], p1[bb + 7]); }
            const bf16x8 pa = __builtin_bit_cast(bf16x8, w);
            o0 = MFMA32(pa, vf[2 * ks], o0); o1 = MFMA32(pa, vf[2 * ks + 1], o1); o2 = MFMA32(pa, ones, o2); }
        b = b == 2 ? 0 : b + 1;
    }
#undef DMA_TILE
    LAS unsigned short* stg = (LAS unsigned short*)(lds + A_STG) + wid * 2048;
#pragma unroll
    for (int r = 0; r < 16; ++r) { const float rl = __builtin_amdgcn_rcpf(o2[r]); const int orow = crow(r, hi);
        const unsigned pk = cvt_pk_bf16(o0[r] * rl, o1[r] * rl); stg[orow * 64 + r32] = (unsigned short)(pk & 0xffffu); stg[orow * 64 + 32 + r32] = (unsigned short)(pk >> 16); }
    asm volatile("s_waitcnt lgkmcnt(0)" ::: "memory");
#pragma unroll
    for (int i = 0; i < 4; ++i) { const int row = i * 8 + (lane >> 3), ch = lane & 7; const u32x4 v = *(const LAS u32x4*)(stg + row * 64 + ch * 8);
        *(GAS u32x4*)(P.YC + (size_t)(sbase + qb * 256 + wid * 32 + row) * DM + 512 + 64 * head + ch * 8) = v; }
    asm volatile("s_waitcnt vmcnt(0) lgkmcnt(0)" ::: "memory");
}
__device__ __forceinline__ void mla_scores(const GAS bf16* Kh, int kb, int r32, const bf16x8 (&qr)[6], f32x16& p0, f32x16& p1) {
#pragma unroll
    for (int r = 0; r < 16; ++r) { p0[r] = 0.f; p1[r] = 0.f; }
    bf16x8 kf[12];
#pragma unroll
    for (int d0 = 0; d0 < 6; ++d0) { kf[2 * d0] = *(const GAS bf16x8*)(Kh + (size_t)(kb + r32) * 768 + 16 * d0); kf[2 * d0 + 1] = *(const GAS bf16x8*)(Kh + (size_t)(kb + 32 + r32) * 768 + 16 * d0); }
#pragma unroll
    for (int d0 = 0; d0 < 6; ++d0) { p0 = MFMA32(kf[2 * d0], qr[d0], p0); p1 = MFMA32(kf[2 * d0 + 1], qr[d0], p1); }
}
__device__ __forceinline__ void attn_meta_mla(const AttG& P, int seq, int head, LAS unsigned char* lds, int tid_in, int wid, int lane_in) {
    int lane = lane_in, tid = tid_in; asm volatile("" : "+v"(lane), "+v"(tid));
    const int r32 = lane & 31, hi = lane >> 5;
    const int T = P.T, Lp = P.Lp, sbase = seq * Lp, nt = (T >> 6) + 1;
    bf16x8 qr[6];
    { const GAS bf16* qsrc = P.Q + (size_t)(sbase + T + r32) * 768 + 96 * head;
#pragma unroll
      for (int d0 = 0; d0 < 6; ++d0) qr[d0] = *(const GAS bf16x8*)(qsrc + 16 * d0 + 8 * hi);
      const int pos = r32 < 15 ? r32 : 15; const GAS f32x4* rp = (const GAS f32x4*)(P.rope + (size_t)pos * 32 + 16 * hi);
#pragma unroll
      for (int e2 = 0; e2 < 4; ++e2) { const f32x4 cs = rp[e2];
#pragma unroll
          for (int q = 0; q < 2; ++q) { const int e = 2 * e2 + q; const float c = cs[2 * q], sn = cs[2 * q + 1];
              const float x1 = bf2f((unsigned short)qr[4][e]), x2 = bf2f((unsigned short)qr[5][e]);
              const unsigned pk = cvt_pk_bf16(x1 * c - x2 * sn, x1 * sn + x2 * c); qr[4][e] = (short)(pk & 0xffffu); qr[5][e] = (short)(pk >> 16); } } }
    float m0, l_reg = 0.f; f32x16 o0, o1;
#pragma unroll
    for (int r = 0; r < 16; ++r) { o0[r] = 0.f; o1[r] = 0.f; }
    const GAS bf16* Kh = P.K + (size_t)sbase * 768 + 96 * head + 8 * hi;
    const GAS bf16* Vh = P.VT + (size_t)(64 * head + r32) * P.rows + sbase + 8 * hi;
    { f32x16 p0, p1; mla_scores(Kh, 0, r32, qr, p0, p1);
      float mx = fmaxf(p0[0], p1[0]);
#pragma unroll
      for (int r = 1; r < 16; ++r) mx = fmaxf(mx, fmaxf(p0[r], p1[r]));
      m0 = fmaxf(mx, __shfl_xor(mx, 32)); }
#pragma unroll 1
    for (int t = wid; t < nt; t += 8) {
        const int kb = (t == nt - 1) ? T : 64 * t;
        f32x16 p0, p1; mla_scores(Kh, kb, r32, qr, p0, p1);
        bf16x8 vf[8];
#pragma unroll
        for (int ks = 0; ks < 4; ++ks) { const GAS bf16* v0 = Vh + kb + 16 * ks; vf[2 * ks] = *(const GAS bf16x8*)v0; vf[2 * ks + 1] = *(const GAS bf16x8*)(v0 + (size_t)32 * P.rows); }
        if (t == nt - 1) {
#pragma unroll
            for (int r = 0; r < 16; ++r) { if (crow(r, hi) >= 16) p0[r] = -INFINITY; p1[r] = -INFINITY; }
        }
        float ls = 0.f;
#pragma unroll
        for (int r = 0; r < 16; ++r) { p0[r] = __builtin_amdgcn_exp2f(fminf(p0[r] - m0, 100.0f)); p1[r] = __builtin_amdgcn_exp2f(fminf(p1[r] - m0, 100.0f)); ls += p0[r] + p1[r]; }
        l_reg += ls;
#pragma unroll
        for (int ks = 0; ks < 4; ++ks) { u32x4 w;
            if (ks < 2) { w.x = cvt_pk_bf16(p0[8 * ks + 0], p0[8 * ks + 1]); w.y = cvt_pk_bf16(p0[8 * ks + 2], p0[8 * ks + 3]); w.z = cvt_pk_bf16(p0[8 * ks + 4], p0[8 * ks + 5]); w.w = cvt_pk_bf16(p0[8 * ks + 6], p0[8 * ks + 7]); }
            else { const int b = 8 * (ks - 2); w.x = cvt_pk_bf16(p1[b + 0], p1[b + 1]); w.y = cvt_pk_bf16(p1[b + 2], p1[b + 3]); w.z = cvt_pk_bf16(p1[b + 4], p1[b + 5]); w.w = cvt_pk_bf16(p1[b + 6], p1[b + 7]); }
            const bf16x8 pa = __builtin_bit_cast(bf16x8, w);
            o0 = MFMA32(pa, vf[2 * ks], o0); o1 = MFMA32(pa, vf[2 * ks + 1], o1); }
    }
    l_reg += __shfl_xor(l_reg, 32);
    LAS float* red = (LAS float*)lds; LAS float* lred = (LAS float*)(lds + 108544);
#pragma unroll
    for (int r = 0; r < 16; ++r) { red[wid * 2048 + (r * 2 + 0) * 64 + lane] = o0[r]; red[wid * 2048 + (r * 2 + 1) * 64 + lane] = o1[r]; }
    if (hi == 0) lred[wid * 32 + r32] = l_reg;
    asm volatile("s_waitcnt lgkmcnt(0)" ::: "memory"); __syncthreads();
#pragma unroll 1
    for (int e = tid; e < 2048; e += NTHR) { float a = 0.f;
#pragma unroll
        for (int w = 0; w < 8; ++w) a += red[w * 2048 + e];
        red[e] = a; }
    if (tid < 32) { float a = 0.f;
#pragma unroll
        for (int w = 0; w < 8; ++w) a += lred[w * 32 + tid];
        lred[tid] = a; }
    asm volatile("s_waitcnt lgkmcnt(0)" ::: "memory"); __syncthreads();
    if (wid == 0) {
#pragma unroll
        for (int r = 0; r < 16; ++r) { o0[r] = red[(r * 2 + 0) * 64 + lane]; o1[r] = red[(r * 2 + 1) * 64 + lane]; }
        LAS float* lsum = lred;
        float rl[16];
#pragma unroll
        for (int j = 0; j < 4; ++j) { const f32x4 lv = *(const LAS f32x4*)(lsum + 8 * j + 4 * hi);
#pragma unroll
            for (int e = 0; e < 4; ++e) rl[4 * j + e] = __builtin_amdgcn_rcpf(lv[e]); }
        asm volatile("s_waitcnt lgkmcnt(0)" ::: "memory");
        LAS unsigned short* stg = (LAS unsigned short*)(lds + A_STG);
#pragma unroll
        for (int r = 0; r < 16; ++r) { const int orow = crow(r, hi); const unsigned pk = cvt_pk_bf16(o0[r] * rl[r], o1[r] * rl[r]); stg[orow * 64 + r32] = (unsigned short)(pk & 0xffffu); stg[orow * 64 + 32 + r32] = (unsigned short)(pk >> 16); }
        asm volatile("s_waitcnt lgkmcnt(0)" ::: "memory");
#pragma unroll
        for (int i = 0; i < 2; ++i) { const int row = i * 8 + (lane >> 3), ch = lane & 7; const u32x4 v = *(const LAS u32x4*)(stg + row * 64 + ch * 8);
            *(GAS u32x4*)(P.YC + (size_t)(sbase + T + row) * DM + 512 + 64 * head + ch * 8) = v; }
        asm volatile("s_waitcnt lgkmcnt(0)" ::: "memory");
    }
}
__device__ __forceinline__ void attn_phase(KArgsP ap, int l, const Grp& G, unsigned* ctr, LAS unsigned char* lds, int tid, int wid, int lane) {
    const KArgs& a = *ap;
    AttG P; P.Q = (const GAS bf16*)a.out + (size_t)G.row0 * DM; P.K = (const GAS bf16*)(a.ws + WS_BIG + B_K); P.VT = (const GAS bf16*)(a.ws + WS_BIG + B_VT); P.Z = (const GAS bf16*)(a.ws + WS_BIG + B_Z);
    P.YC = (GAS bf16*)(a.ws + WS_BIG + B_YC) + (size_t)G.row0 * DM; P.rope = (const GAS float*)(a.ws + WS_ROPE); P.rows = G.rows; P.T = G.T; P.Lp = G.Lp;
    { LAS float* tab = (LAS float*)(lds + A_TAB); const GAS float* rpb = (const GAS float*)a.in[I_RPB] + (size_t)l * 4 * 465; const GAS float* mb = (const GAS float*)a.in[I_MB] + (size_t)l * 64;
      for (int e = tid; e < 4 * 640; e += NTHR) { const int h = e / 640, j = e - h * 640 - 64; tab[e] = (j >= 0 && j < 465) ? rpb[h * 465 + j] * LOG2E : 0.f; }
      if (tid < 64) tab[4 * 640 + tid] = mb[tid] * LOG2E; }
    const int nqb = (G.T >> 8) + 1; const int P8 = G.nseq, P4 = G.nseq >> 1; const int nq_mla = P8 * nqb, nq_tot = nq_mla + P4 * nqb;
    LAS volatile unsigned* uw = (LAS volatile unsigned*)(lds + A_UW);
    int q = (int)(__builtin_amdgcn_s_getreg((3 << 11) | 20) & 7u), tried = 0;
    for (;;) {
        __syncthreads();
        if (tid == 0) { unsigned j; for (;;) { j = atomicAdd(ctr + q, 1u); if (j < (unsigned)nq_tot || tried >= 7) break; q = (q + 1) & 7; ++tried; }
            *uw = (j < (unsigned)nq_tot) ? (((unsigned)q << 16) | j) : 0xffffffffu; }
        __syncthreads();
        const unsigned w = *uw;
        if (w == 0xffffffffu) break;
        const int qq = (int)(w >> 16), j = (int)(w & 0xffffu);
        if (j < nq_mla) { const int pair = qq * P8 + j / nqb, qb = j % nqb; if (qb == nqb - 1) attn_meta_mla(P, pair >> 3, pair & 7, lds, tid, wid, lane); else attn_unit_mla(P, pair >> 3, pair & 7, qb, lds, tid, wid, lane); }
        else { const int v = j - nq_mla; const int pair = qq * P4 + v / nqb, qb = v % nqb; attn_unit<1>(P, pair >> 2, pair & 3, qb, lds, tid, wid, lane); }
    }
}
#define XB_TMO      128
#define XB_XCNT(j)  (256  + 64 * (j))
#define XB_XSUB(j)  (1280 + 64 * (j))
#define XB_XGEN(j)  (2304 + 64 * (j))
#define XB_TOP      3328
#define XB_TOPGEN   3392
#define XCD_BAR_WORDS 3456
#define XB_SPIN_CAP (1u << 18)

__device__ __forceinline__ unsigned xb_ld(unsigned* p)              { return __hip_atomic_load(p, __ATOMIC_RELAXED, __HIP_MEMORY_SCOPE_AGENT); }
__device__ __forceinline__ unsigned xb_add(unsigned* p, unsigned v) { return __hip_atomic_fetch_add(p, v, __ATOMIC_RELAXED, __HIP_MEMORY_SCOPE_AGENT); }
__device__ __forceinline__ unsigned xb_xcc_id() { return (unsigned)__builtin_amdgcn_s_getreg((3 << 11) | 20) & 0xFu; }
#define XB_SPIN(cond, bar) do { unsigned _sp = 0; while (cond) { __builtin_amdgcn_s_sleep(1); \
    if ((++_sp & 255u) == 0u) { if (xb_ld(&(bar)[XB_TMO])) break; if (_sp > XB_SPIN_CAP) { atomicAdd(&(bar)[XB_TMO], 1u); break; } } } } while (0)

struct XcdBarrier {
    unsigned* bar; unsigned x;
    volatile LAS unsigned* st;
};

__device__ __forceinline__ XcdBarrier xcd_barrier_post(unsigned* bar, volatile LAS unsigned* st) {
    XcdBarrier b; b.bar = bar; b.x = xb_xcc_id(); b.st = st;
    if (threadIdx.x == 0) (void)xb_add(&bar[XB_XCNT(b.x)], 1u);
    return b;
}
__device__ __forceinline__ void xcd_barrier_complete(unsigned* bar, unsigned x, unsigned& nloc, unsigned& nx) {
    const unsigned G = gridDim.x * gridDim.y * gridDim.z;
    unsigned sum, cnt, mine, sp = 0u;
    for (;;) {
        sum = 0u; cnt = 0u; mine = 0u;
#pragma unroll
        for (unsigned j = 0; j < 16; ++j) { const unsigned c = xb_ld(&bar[XB_XCNT(j)]); sum += c; cnt += (c > 0u) ? 1u : 0u; mine = (j == x) ? c : mine; }
        if (sum == G) break;
        __builtin_amdgcn_s_sleep(1);
        if ((++sp & 255u) == 0u) { if (xb_ld(&bar[XB_TMO])) break; if (sp > XB_SPIN_CAP) { atomicAdd(&bar[XB_TMO], 1u); break; } }
    }
    nloc = mine > 0u ? mine : 1u; nx = cnt > 0u ? cnt : 1u;
}

__device__ __forceinline__ void xcd_barrier(const XcdBarrier& b) {
    asm volatile("s_waitcnt vmcnt(0)" ::: "memory");
    __syncthreads();
    if (threadIdx.x == 0) {
        unsigned* bar = b.bar;
        __builtin_amdgcn_s_waitcnt(0);
        unsigned nloc = b.st[0], nx = b.st[1];
        if (nloc == 0u) { xcd_barrier_complete(bar, b.x, nloc, nx); b.st[0] = nloc; b.st[1] = nx; }
        const unsigned old = xb_add(&bar[XB_XSUB(b.x)], 1u);
        const unsigned gen = old / nloc;
        if (old + 1u == (gen + 1u) * nloc) {
            __builtin_amdgcn_fence(__ATOMIC_RELEASE, "agent");
            asm volatile("s_waitcnt vmcnt(0)" ::: "memory");
            const unsigned og = xb_add(&bar[XB_TOP], 1u);
            const unsigned tg = og / nx;
            if (og + 1u == (tg + 1u) * nx) xb_add(&bar[XB_TOPGEN], 1u);
            else XB_SPIN(xb_ld(&bar[XB_TOPGEN]) == tg, bar);
            __builtin_amdgcn_fence(__ATOMIC_ACQUIRE, "agent");
            xb_add(&bar[XB_XGEN(b.x)], 1u);
            asm volatile("s_waitcnt vmcnt(0)" ::: "memory");
        } else {
            XB_SPIN(xb_ld(&bar[XB_XGEN(b.x)]) == gen, bar);
            __builtin_amdgcn_fence(__ATOMIC_ACQUIRE, "agent");
            asm volatile("s_waitcnt vmcnt(0)" ::: "memory");
        }
    }
    __syncthreads();
}

constexpr int CW_BAR = 1024;
#define XBAR() do { KArgsP A_ = KA(); XcdBarrier b_; b_.bar = (unsigned*)(A_->ws + WS_CTL) + CW_BAR; b_.x = xb_xcc_id(); b_.st = (volatile LAS unsigned*)(L + 133120); xcd_barrier(b_); } while (0)

#ifndef REP_GEMM
#define REP_GEMM 1
#endif
#ifndef REP_ATT
#define REP_ATT 1
#endif
#ifndef REP_FFN
#define REP_FFN 1
#endif
#define GEMM_CALL1(EpiT, gobj, sobj, eobj) pg8::gemm_phase<EpiT, pg8::StaticOrder, true, true>(L, gobj, sobj, eobj)
#define GEMM_CALL2(EpiT, gobj, sobj, eobj) do { GEMM_CALL1(EpiT, gobj, sobj, eobj); asm volatile("" ::: "memory"); GEMM_CALL1(EpiT, gobj, sobj, eobj); } while (0)
#if REP_FFN == 1
#define GEMM_CALL_F GEMM_CALL1
#else
#define GEMM_CALL_F GEMM_CALL2
#endif
#if REP_GEMM == 1
#define GEMM_CALL(EpiT, gobj, sobj, eobj) pg8::gemm_phase<EpiT, pg8::StaticOrder, true, true>(L, gobj, sobj, eobj)
#else
#define GEMM_CALL(EpiT, gobj, sobj, eobj) do { pg8::gemm_phase<EpiT, pg8::StaticOrder, true, true>(L, gobj, sobj, eobj); asm volatile("" ::: "memory"); pg8::gemm_phase<EpiT, pg8::StaticOrder, true, true>(L, gobj, sobj, eobj); } while (0)
#endif
#define KA() ({ KArgsP p_ = (KArgsP)__builtin_amdgcn_kernarg_segment_ptr(); asm volatile("" : "+s"(p_)); p_; })
__global__ void __launch_bounds__(NTHR, 2) mk_fwd(Args a_unused) {
    extern __shared__ __attribute__((aligned(16))) unsigned char lds_raw[];
    cg::grid_group grid = cg::this_grid();
    LAS unsigned char* L = (LAS unsigned char*)lds_raw;
#define TID ({ int t_ = (int)threadIdx.x; asm volatile("" : "+v"(t_)); t_; })
#define LANE (TID & 63)
#define WID (__builtin_amdgcn_readfirstlane(TID >> 6))
#define NG ((int)gridDim.x)
#define BX ((int)blockIdx.x)
#define GW (BX * NWAVES + WID)
#define NGW (NG * NWAVES)
#define SCR ((LAS float*)(L + WID * 8448))
    if (threadIdx.x < 2) ((volatile LAS unsigned*)(L + 133120))[threadIdx.x] = 0u;
    __syncthreads();
    { KArgsP A = KA(); (void)xcd_barrier_post((unsigned*)(A->ws + WS_CTL) + CW_BAR, (volatile LAS unsigned*)(L + 133120)); }
    { KArgsP A = KA(); rope_table((GAS float*)(A->ws + WS_ROPE), BX * NTHR + TID, NG * NTHR); }
    { KArgsP A = KA(); convert_layer(A, 0, SCR, GW, NGW, LANE); }
    { KArgsP A = KA(); rowpass(A, nullptr, 0.f, true, 0, MP, GW, NGW, LANE); }
    grid.sync();
    for (int st = 0; st < 3 * DEPTH; ++st) {
        const int l = st / 3, k = st - 3 * l;
        if (k != 1) {
            const int f = k >> 1;
            { KArgsP A = KA(); unsigned char* ws = A->ws; pg8::Gemm g{(const bf16*)(ws + WS_XY), (const bf16*)(ws + WS_W + (f ? W_GU2 : W_GU1)), MP, 2 * FF, DM, DM, DM}; pg8::StaticOrder S; S.init(MP, 2 * FF, NG, BX);
              pg8::EpiSwiGLU E{(GAS bf16*)(ws + WS_BIG), FF, (const GAS float*)(ws + WS_RINV), (LAS float*)(L + 132096)}; GEMM_CALL_F(pg8::EpiSwiGLU, g, S, E); }
            XBAR();
            constexpr int DN_MAIN = 1024, DN_REST = (MP / 256) * 4 - DN_MAIN, ROWS_MAIN = (DN_MAIN / 4) * 256;
            { KArgsP A = KA(); unsigned char* ws = A->ws; pg8::Gemm g{(const bf16*)(ws + WS_BIG), (const bf16*)(ws + WS_W + (f ? W_DN2 : W_DN1)), MP, DM, FF, FF, FF}; pg8::LinearOrder S; S.init(0, DN_MAIN, 4, NG, BX);
              pg8::EpiPlain E{(GAS bf16*)A->out, DM}; pg8::gemm_phase<pg8::EpiPlain, pg8::LinearOrder, true, true>(L, g, S, E); }
            XBAR();
            const bool last = (l == DEPTH - 1 && f == 1);
            { const int vc = (BX % 8) * (NG / 8) + BX / 8;
              if (vc < DN_REST) { KArgsP A = KA(); unsigned char* ws = A->ws; pg8::Gemm g{(const bf16*)(ws + WS_BIG), (const bf16*)(ws + WS_W + (f ? W_DN2 : W_DN1)), MP, DM, FF, FF, FF}; pg8::LinearOrder S; S.init(DN_MAIN, DN_REST, 4, NG, BX);
                  pg8::EpiPlain E{(GAS bf16*)A->out, DM}; pg8::gemm_phase<pg8::EpiPlain, pg8::LinearOrder, true, true>(L, g, S, E); }
              else { KArgsP A = KA(); rowpass(A, (const GAS float*)A->in[f ? I_F2POST : I_F1POST] + l * DM, 0.5f, false, 0, ROWS_MAIN, (vc - DN_REST) * NWAVES + WID, (NG - DN_REST) * NWAVES, LANE); } }
            XBAR();
            { KArgsP A = KA(); rowpass(A, (const GAS float*)A->in[f ? I_F2POST : I_F1POST] + l * DM, 0.5f, false, ROWS_MAIN, MP, GW, NGW, LANE); }
            if (f == 1 && !last) { KArgsP A = KA(); convert_layer(A, l + 1, SCR, GW, NGW, LANE); }
            XBAR();
            if (last) { KArgsP A = KA(); output_pass(A, GW, NGW, LANE); }
        } else {
            for (int gi = 0; gi < 2; ++gi) {
                { KArgsP A = KA(); unsigned char* ws = A->ws; const Grp G = grp_of(gi);
                  pg8::Gemm g{(const bf16*)(ws + WS_XY) + (size_t)G.row0 * DM, (const bf16*)(ws + WS_W + W_IN), G.rows, NINP, DM, DM, DM}; pg8::StaticOrder S; S.init(G.rows, NINP, NG, BX);
                  pg8::EpiInProj E{(GAS bf16*)(ws + WS_BIG + B_Z), (GAS float*)(ws + WS_SSP) + (size_t)G.row0 * 32, (const GAS float*)(ws + WS_RINV) + G.row0, (LAS float*)(L + 132096)}; GEMM_CALL(pg8::EpiInProj, g, S, E); }
                XBAR();
                { KArgsP A = KA(); unsigned char* ws = A->ws; const Grp G = grp_of(gi);
                  pg8::Gemm g{(const bf16*)(ws + WS_BIG + B_Z) + 1536, (const bf16*)(ws + WS_W + W_UQ), G.rows, 768, 768, ZP, 768}; pg8::StaticOrder S; S.init(G.rows, 768, NG, BX);
                  pg8::EpiRowScale E{(GAS bf16*)A->out + (size_t)G.row0 * DM, 768, (const GAS float*)(ws + WS_SSP) + (size_t)G.row0 * 32, 0, 6, 1.0f / 768.0f, 0.10206207261596575f * LOG2E, 0, (LAS float*)(L + 132096)}; GEMM_CALL(pg8::EpiRowScale, g, S, E); }
                { KArgsP A = KA(); unsigned char* ws = A->ws; const Grp G = grp_of(gi);
                  pg8::Gemm g{(const bf16*)(ws + WS_BIG + B_Z) + 2304, (const bf16*)(ws + WS_W + W_UK), G.rows, 512, 256, ZP, 256}; pg8::StaticOrder S; S.init(G.rows, 512, NG, BX, NG - 140 % NG);
                  pg8::EpiRowScale E{(GAS bf16*)(ws + WS_BIG + B_K), 768, (const GAS float*)(ws + WS_SSP) + (size_t)G.row0 * 32, 24, 2, 1.0f / 256.0f, 1.0f, 1, (LAS float*)(L + 132096)}; GEMM_CALL(pg8::EpiRowScale, g, S, E); }
                { KArgsP A = KA(); unsigned char* ws = A->ws; const Grp G = grp_of(gi);
                  pg8::Gemm g{(const bf16*)(ws + WS_W + W_UV), (const bf16*)(ws + WS_BIG + B_Z) + 2304, 512, G.rows, 256, 256, ZP}; pg8::StaticOrder S; S.init(512, G.rows, NG, BX, NG - 148 % NG);
                  pg8::EpiColScale E{(GAS bf16*)(ws + WS_BIG + B_VT), G.rows, (const GAS float*)(ws + WS_SSP) + (size_t)G.row0 * 32, (LAS float*)(L + 132096)}; GEMM_CALL(pg8::EpiColScale, g, S, E); }
                { KArgsP A = KA(); const Grp G = grp_of(gi); conv_kpe_pass(A, l, G, GW, NGW, LANE); }
                XBAR();
                { KArgsP A = KA(); const Grp G = grp_of(gi); for (int rep_ = 0; rep_ < REP_ATT; ++rep_) attn_phase(A, l, G, (unsigned*)(A->ws + WS_CTL) + 64 * (l * 2 + gi) + 32 * rep_, L, TID, WID, LANE); }
                XBAR();
            }
            { KArgsP A = KA(); ynorm_pass(A, GW, NGW, LANE); }
            XBAR();
            { KArgsP A = KA(); unsigned char* ws = A->ws;
              pg8::Gemm g{(const bf16*)(ws + WS_BIG + B_YC), (const bf16*)(ws + WS_W + W_O), MP, DM, DM, DM, DM}; pg8::StaticOrder S; S.init(MP, DM, NG, BX);
              pg8::EpiPlain E{(GAS bf16*)A->out, DM}; GEMM_CALL(pg8::EpiPlain, g, S, E); }
            XBAR();
            { KArgsP A = KA(); rowpass(A, (const GAS float*)A->in[I_MPOST] + l * DM, 1.0f, false, 0, MP, GW, NGW, LANE); }
            XBAR();
        }
    }
}

extern "C" void kernel_launch(void* const* d_in, const int* in_sizes, int n_in, void* d_out, int out_size, void* d_ws, size_t ws_size, hipStream_t stream) {
    static int grid = 0;
    if (grid == 0) {
        if (n_in != 25 || ws_size < WS_END) { fprintf(stderr, "kernel_launch: need 25 inputs and %zu B of workspace (got %d, %zu)\n", (size_t)WS_END, n_in, ws_size); grid = -1; return; }
        int dev = 0, cus = 0, per_cu = 0;
        if (hipGetDevice(&dev) != hipSuccess || hipDeviceGetAttribute(&cus, hipDeviceAttributeMultiprocessorCount, dev) != hipSuccess) { grid = -1; return; }
        if (hipFuncSetAttribute((const void*)mk_fwd, hipFuncAttributeMaxDynamicSharedMemorySize, LDS_BYTES) != hipSuccess) { fprintf(stderr, "kernel_launch: hipFuncSetAttribute failed\n"); grid = -1; return; }
        if (hipOccupancyMaxActiveBlocksPerMultiprocessor(&per_cu, (const void*)mk_fwd, NTHR, LDS_BYTES) != hipSuccess || per_cu < 1) { fprintf(stderr, "kernel_launch: occupancy query says %d\n", per_cu); }
        (void)hipGetLastError();
        grid = cus;
    }
    if (grid < 0) return;
    if (hipMemsetAsync((char*)d_ws + WS_CTL, 0, 32768, stream) != hipSuccess) return;
    Args a{};
    for (int i = 0; i < 25; ++i) a.in[i] = (const float*)d_in[i];
    a.out = (float*)d_out; a.ws = (unsigned char*)d_ws;
    void* args[] = {&a};
    hipError_t e = hipLaunchCooperativeKernel((const void*)mk_fwd, dim3(grid), dim3(NTHR), args, LDS_BYTES, stream);
    if (e != hipSuccess) fprintf(stderr, "kernel_launch: cooperative launch failed: %s\n", hipGetErrorString(e));
}
```

```cpp
#include <hip/hip_runtime.h>
#include <hip/hip_cooperative_groups.h>
#include <cstdio>
#include <cstdint>
namespace cg = cooperative_groups;
#define GAS __attribute__((address_space(1)))
namespace pg8 {
#define PG8_LAS __attribute__((address_space(3)))
typedef unsigned short bf16_t;
typedef short bf16x8 __attribute__((ext_vector_type(8)));
typedef float f32x4 __attribute__((ext_vector_type(4)));
typedef unsigned u32x4 __attribute__((ext_vector_type(4)));
constexpr int BM = 256, BK = 64, HALF = 128, HTB = HALF * BK * 2  , STAGE_BYTES = 8 * HTB, NXCD = 8, WGM = 8;

__host__ __device__ __forceinline__ int lds_byte(int r, int c) { const int st = (r >> 4) * 2 + (c >> 5), rr = r & 15, cc = c & 31, ob = rr * 64 + cc * 2; return st * 1024 + (ob ^ (((ob >> 9) & 1) << 5)); }
__host__ __device__ __forceinline__ void stage_rc(int b, int& R, int& C) { const int st = b / 1024, sb = b % 1024, swz = sb ^ (((sb >> 9) & 1) << 5); R = (st >> 1) * 16 + swz / 64; C = (st & 1) * 32 + (swz % 64) / 2; }
__host__ __device__ __forceinline__ int perm32(int rho) { const int n = rho >> 4, i = rho & 15; return 8 * (i >> 2) + 4 * n + (i & 3); }

struct Unit { int pm, pn; };
struct Gemm { const bf16_t* A; const bf16_t* Bt; int M, N, K, lda, ldb; };

struct StaticOrder {
    int nM, nN, nwg, G, c;
    __host__ __device__ void init(int M, int N, int G_, int c_, int shift = 0) { nM = M / BM; nN = N / BM; nwg = nM * nN; G = G_; c = (c_ + shift) % G_; }
    __host__ __device__ bool next(int i, Unit& u) const {
        const long L = (long)i * G + c; if (L >= nwg) return false;
        int wgid = (int)L; { const int q = nwg / NXCD, r = nwg % NXCD, xcd = wgid % NXCD, off = wgid / NXCD; wgid = (xcd < r ? xcd * (q + 1) : r * (q + 1) + (xcd - r) * q) + off; }
        const int nig = WGM * nN, gid = wgid / nig, fm = gid * WGM, gsz = (nM - fm) < WGM ? (nM - fm) : WGM;
        u.pm = fm + ((wgid % nig) % gsz); u.pn = (wgid % nig) / gsz; return true;
    }
    __device__ __forceinline__ void a_ready(const Unit&) const {}
    __device__ __forceinline__ void done(const Unit&) const {}
};
struct LinearOrder {
    int first, count, nN, G, vc;
    __host__ __device__ void init(int first_, int count_, int nN_, int G_, int bx) { first = first_; count = count_; nN = nN_; G = G_; vc = (G_ % 8 == 0) ? (bx % 8) * (G_ / 8) + bx / 8 : bx; }
    __host__ __device__ bool next(int i, Unit& u) const { const int L = i * G + vc; if (L >= count) return false; const int w = first + L; u.pm = w / nN; u.pn = w % nN; return true; }
    __device__ __forceinline__ void a_ready(const Unit&) const {}
    __device__ __forceinline__ void done(const Unit&) const {}
};
__device__ __forceinline__ unsigned cvt_pk_bf16(float lo, float hi) { typedef float f2 __attribute__((ext_vector_type(2))); typedef __bf16 b2 __attribute__((ext_vector_type(2))); f2 v = {lo, hi}; b2 b = __builtin_convertvector(v, b2); return __builtin_bit_cast(unsigned, b); }
typedef unsigned u32x2 __attribute__((ext_vector_type(2)));
constexpr float LOG2E = 1.4426950408889634f;
constexpr float RMS_EPS = 1e-6f;
#define EPI_STORE8(ptr, v0, v1) do { u32x4 w_; w_.x = cvt_pk_bf16((v0)[0], (v0)[1]); w_.y = cvt_pk_bf16((v0)[2], (v0)[3]); w_.z = cvt_pk_bf16((v1)[0], (v1)[1]); w_.w = cvt_pk_bf16((v1)[2], (v1)[3]); *(GAS u32x4*)(ptr) = w_; } while (0)
struct EpiPlain {
    static constexpr bool PERM = true, AFTER_DRAIN = false;
    GAS bf16_t* O; int ldc;
    __device__ __forceinline__ float prefetch(const Unit&, int) const { return 0.f; }
    __device__ __forceinline__ void operator()(const f32x4 (&acc)[2][2][4][2], const Unit& u, int wr, int wc, int fr, int fq, float) const {
        const int row0 = u.pm * BM + wr * 64 + fr, col0 = u.pn * BM + wc * 32 + 8 * fq;
#pragma unroll
        for (int ai = 0; ai < 2; ++ai)
#pragma unroll
            for (int m = 0; m < 4; ++m) { GAS bf16_t* rowp = O + (size_t)(row0 + ai * HALF + m * 16) * ldc + col0;
#pragma unroll
                for (int bj = 0; bj < 2; ++bj) EPI_STORE8(rowp + bj * HALF, acc[ai][bj][m][0], acc[ai][bj][m][1]); }
    }
};
__device__ __forceinline__ float silu_mul(float g, float u) { return g * u * __builtin_amdgcn_rcpf(1.0f + __builtin_amdgcn_exp2f(-g * LOG2E)); }
struct EpiSwiGLU {
    static constexpr bool PERM = true, AFTER_DRAIN = false;
    GAS bf16_t* O; int ldc; const GAS float* rinv; PG8_LAS float* tab;
    __device__ __forceinline__ float prefetch(const Unit& u, int t) const { return t < 256 ? rinv[u.pm * BM + t] : 0.f; }
    __device__ __forceinline__ void operator()(const f32x4 (&acc)[2][2][4][2], const Unit& u, int wr, int wc, int fr, int fq, float pf) const {
        const int row0 = u.pm * BM + wr * 64 + fr, col0 = u.pn * HALF + wc * 32 + 8 * fq;
        __builtin_amdgcn_s_barrier();
        { const int t = threadIdx.x; if (t < 256) tab[t] = pf; }
        asm volatile("s_waitcnt lgkmcnt(0)" ::: "memory"); __builtin_amdgcn_s_barrier(); asm volatile("" ::: "memory");
#pragma unroll
        for (int ai = 0; ai < 2; ++ai)
#pragma unroll
            for (int m = 0; m < 4; ++m) { GAS bf16_t* rowp = O + (size_t)(row0 + ai * HALF + m * 16) * ldc + col0; const float rs = tab[ai * HALF + wr * 64 + m * 16 + fr]; const float c1 = -rs * LOG2E, c2 = rs * rs;
                f32x4 v0, v1;
#pragma unroll
                for (int e = 0; e < 4; ++e) {
                    const float g0 = acc[ai][0][m][0][e], u0 = acc[ai][1][m][0][e], g1 = acc[ai][0][m][1][e], u1 = acc[ai][1][m][1][e];
                    v0[e] = (g0 * u0) * (c2 * __builtin_amdgcn_rcpf(1.0f + __builtin_amdgcn_exp2f(g0 * c1)));
                    v1[e] = (g1 * u1) * (c2 * __builtin_amdgcn_rcpf(1.0f + __builtin_amdgcn_exp2f(g1 * c1))); }
                EPI_STORE8(rowp, v0, v1); }
    }
};
struct EpiInProj {
    static constexpr bool PERM = true, AFTER_DRAIN = false;
    GAS bf16_t* Z; GAS float* SSP; const GAS float* rinv; PG8_LAS float* tab;
    __device__ __forceinline__ float prefetch(const Unit& u, int t) const { return t < 256 ? rinv[u.pm * BM + t] : 0.f; }
    __device__ __forceinline__ void operator()(const f32x4 (&acc)[2][2][4][2], const Unit& u, int wr, int wc, int fr, int fq, float pf) const {
        const int row0 = u.pm * BM + wr * 64 + fr;
        __builtin_amdgcn_s_barrier();
        { const int t = threadIdx.x; if (t < 256) tab[t] = pf; }
        asm volatile("s_waitcnt lgkmcnt(0)" ::: "memory"); __builtin_amdgcn_s_barrier(); asm volatile("" ::: "memory");
#pragma unroll
        for (int bj = 0; bj < 2; ++bj) {
            const int G = 8 * u.pn + 4 * bj + wc, col0 = 32 * G;
            if (col0 >= 2592) continue;
            const float sc = (col0 >= 768 && col0 < 1024) ? 0.125f * LOG2E : 1.0f;
            const bool doss = (G >= 48 && G < 80); const int slot = G - 48;
#pragma unroll
            for (int ai = 0; ai < 2; ++ai)
#pragma unroll
                for (int m = 0; m < 4; ++m) { const int row = row0 + ai * HALF + m * 16; const float rs = tab[ai * HALF + wr * 64 + m * 16 + fr] * sc;
                    const f32x4 v0 = acc[ai][bj][m][0] * rs, v1 = acc[ai][bj][m][1] * rs;
                    if (doss) { float s = (v0[0] * v0[0] + v0[1] * v0[1]) + (v0[2] * v0[2] + v0[3] * v0[3]) + (v1[0] * v1[0] + v1[1] * v1[1]) + (v1[2] * v1[2] + v1[3] * v1[3]);
                        s += __shfl_xor(s, 16); s += __shfl_xor(s, 32); if (fq == 0) SSP[(size_t)row * 32 + slot] = s; }
                    EPI_STORE8(Z + (size_t)row * 2592 + col0 + 8 * fq, v0, v1); }
        }
    }
};
struct EpiRowScale {
    static constexpr bool PERM = true, AFTER_DRAIN = false;
    GAS bf16_t* O; int ldo; const GAS float* SSP; int slot0, nslot4; float invn, extra; int kmap; PG8_LAS float* tab;
    __device__ __forceinline__ float prefetch(const Unit& u, int t) const { float r = 0.f;
        if (t < 256) { const GAS f32x4* sp = (const GAS f32x4*)(SSP + (size_t)(u.pm * BM + t) * 32 + slot0); float s = 0.f;
            for (int k = 0; k < nslot4; ++k) { const f32x4 v = sp[k]; s += (v[0] + v[1]) + (v[2] + v[3]); }
            r = __builtin_amdgcn_rsqf(s * invn + RMS_EPS) * extra; }
        return r; }
    __device__ __forceinline__ void operator()(const f32x4 (&acc)[2][2][4][2], const Unit& u, int wr, int wc, int fr, int fq, float pf) const {
        const int row0 = u.pm * BM + wr * 64 + fr;
        __builtin_amdgcn_s_barrier();
        { const int t = threadIdx.x; if (t < 256) tab[t] = pf; }
        asm volatile("s_waitcnt lgkmcnt(0)" ::: "memory"); __builtin_amdgcn_s_barrier(); asm volatile("" ::: "memory");
#pragma unroll
        for (int ai = 0; ai < 2; ++ai)
#pragma unroll
            for (int m = 0; m < 4; ++m) { const float rs = tab[ai * HALF + wr * 64 + m * 16 + fr];
#pragma unroll
                for (int bj = 0; bj < 2; ++bj) { const int c0 = u.pn * BM + bj * HALF + wc * 32; const int dc = (kmap ? 96 * (c0 >> 6) + (c0 & 63) : c0) + 8 * fq;
                    const f32x4 v0 = acc[ai][bj][m][0] * rs, v1 = acc[ai][bj][m][1] * rs;
                    EPI_STORE8(O + (size_t)(row0 + ai * HALF + m * 16) * ldo + dc, v0, v1); } }
    }
};
struct EpiColScale {
    static constexpr bool PERM = true, AFTER_DRAIN = false;
    GAS bf16_t* O; int ldo; const GAS float* SSP; PG8_LAS float* tab;
    __device__ __forceinline__ float prefetch(const Unit& u, int t) const { float r = 0.f;
        if (t < 256) { const GAS f32x4* sp = (const GAS f32x4*)(SSP + (size_t)(u.pn * BM + t) * 32 + 24); const f32x4 a = sp[0], b = sp[1];
            r = __builtin_amdgcn_rsqf(((a[0] + a[1]) + (a[2] + a[3]) + (b[0] + b[1]) + (b[2] + b[3])) * (1.0f / 256.0f) + RMS_EPS); }
        return r; }
    __device__ __forceinline__ void operator()(const f32x4 (&acc)[2][2][4][2], const Unit& u, int wr, int wc, int fr, int fq, float pf) const {
        const int row0 = u.pm * BM + wr * 64 + fr;
        __builtin_amdgcn_s_barrier();
        { const int t = threadIdx.x; if (t < 256) tab[t] = pf; }
        asm volatile("s_waitcnt lgkmcnt(0)" ::: "memory"); __builtin_amdgcn_s_barrier(); asm volatile("" ::: "memory");
#pragma unroll
        for (int bj = 0; bj < 2; ++bj) { const int cl = bj * HALF + wc * 32 + 8 * fq, c0 = u.pn * BM + cl;
            const f32x4 s0 = *(const PG8_LAS f32x4*)(tab + cl), s1 = *(const PG8_LAS f32x4*)(tab + cl + 4);
#pragma unroll
            for (int ai = 0; ai < 2; ++ai)
#pragma unroll
                for (int m = 0; m < 4; ++m) { const f32x4 v0 = acc[ai][bj][m][0] * s0, v1 = acc[ai][bj][m][1] * s1;
                    GAS bf16_t* op = O + (size_t)(row0 + ai * HALF + m * 16) * ldo + (c0 & ~15) + ((c0 >> 3) & 1) * 4;
                    u32x2 w0, w1; w0.x = cvt_pk_bf16(v0[0], v0[1]); w0.y = cvt_pk_bf16(v0[2], v0[3]); w1.x = cvt_pk_bf16(v1[0], v1[1]); w1.y = cvt_pk_bf16(v1[2], v1[3]);
                    *(GAS u32x2*)op = w0; *(GAS u32x2*)(op + 8) = w1; } }
    }
};
template <class Epi, class Sched, bool ALIGN_EPI = false, bool SP2 = false>
__device__ __forceinline__ void gemm_phase(PG8_LAS unsigned char* lds, const Gemm g, const Sched& S, const Epi& E) {
    int tid_l = threadIdx.x; asm volatile("" : "+v"(tid_l)); const int tid = tid_l, wid = __builtin_amdgcn_readfirstlane(tid >> 6), lane = tid & 63, wr = wid >> 2, wc = wid & 3, fr = lane & 15, fq = lane >> 4;
    int K_l = g.K; asm volatile("" : "+s"(K_l)); const int K = K_l, nt = K / BK;
    unsigned voffA[2], voffB[2];
#pragma unroll
    for (int i = 0; i < 2; ++i) { int R, C; stage_rc(tid * 16 + i * 8192, R, C); const int Rb = Epi::PERM ? ((R & ~31) + perm32(R & 31)) : R;
        voffA[i] = (unsigned)(R * g.lda + C) * 2u; voffB[i] = (unsigned)(Rb * g.ldb + C) * 2u; }
    const size_t kstep = (size_t)(BK * 2);
    const size_t hstepA = (size_t)HALF * g.lda * 2, hstepB = (size_t)HALF * g.ldb * 2;
    const size_t tstepA = 2 * hstepA, tstepB = 2 * hstepB;
    const unsigned ldsw = (unsigned)wid * 1024u;
    const int aoff = lds_byte(wr * 64 + fr, fq * 8), boff = lds_byte(wc * 32 + fr, fq * 8);
#define PG8_SA(b, h) (((b) * 2 + (h)) * HTB)
#define PG8_SB(b, h) ((4 + (b) * 2 + (h)) * HTB)
#define PG8_STAGE(bufoff, gbase, voff) do { _Pragma("unroll") for (int _i = 0; _i < 2; ++_i) \
        __builtin_amdgcn_global_load_lds((const unsigned*)((const char*)(gbase) + (voff)[_i]), (PG8_LAS unsigned*)(lds + (bufoff) + ldsw + _i * 8192), 16, 0, 0); } while (0)
#define PG8_LDA(dst, b, h) do { _Pragma("unroll") for (int m = 0; m < 4; ++m) _Pragma("unroll") for (int k = 0; k < 2; ++k) dst[m][k] = *(const PG8_LAS bf16x8*)(lds + PG8_SA(b, h) + aoff + m * 2048 + k * 1024); } while (0)
#define PG8_LDB(dst, b, h) do { _Pragma("unroll") for (int n = 0; n < 2; ++n) _Pragma("unroll") for (int k = 0; k < 2; ++k) dst[n][k] = *(const PG8_LAS bf16x8*)(lds + PG8_SB(b, h) + boff + n * 2048 + k * 1024); } while (0)
#define PG8_MMA(ai, bj, At, Bt) do { __builtin_amdgcn_s_setprio(1); _Pragma("unroll") for (int m = 0; m < 4; ++m) _Pragma("unroll") for (int n = 0; n < 2; ++n) _Pragma("unroll") for (int k = 0; k < 2; ++k) \
        acc[ai][bj][m][n] = __builtin_amdgcn_mfma_f32_16x16x32_bf16(Bt[n][k], At[m][k], acc[ai][bj][m][n], 0, 0, 0); __builtin_amdgcn_s_setprio(0); } while (0)
#define PG8_WAIT_V(n) asm volatile("s_waitcnt vmcnt(" #n ")" ::: "memory")
#define PG8_WAIT_L(n) asm volatile("s_waitcnt lgkmcnt(" #n ")" ::: "memory")
#define PG8_BAR __builtin_amdgcn_s_barrier()
#define PG8_SCHED __builtin_amdgcn_sched_barrier(0)
    Unit cur, nxt; int ui = 0;
    if (!S.next(0, cur)) return;
    float epf = E.prefetch(cur, tid);
    f32x4 acc[2][2][4][2];
#pragma unroll
    for (int a = 0; a < 2; ++a)
#pragma unroll
        for (int b = 0; b < 2; ++b)
#pragma unroll
            for (int m = 0; m < 4; ++m)
#pragma unroll
                for (int n = 0; n < 2; ++n) acc[a][b][m][n] = (f32x4){0.f, 0.f, 0.f, 0.f};
    bf16x8 At[4][2], B0[2][2], B1[2][2];
    const char* cA = (const char*)g.A + (size_t)cur.pm * tstepA; const char* cB = (const char*)g.Bt + (size_t)cur.pn * tstepB;
    S.a_ready(cur);
    if constexpr (SP2) {
        PG8_STAGE(PG8_SB(0, 0), cB, voffB); PG8_STAGE(PG8_SB(0, 1), cB + hstepB, voffB); PG8_STAGE(PG8_SA(0, 0), cA, voffA); PG8_STAGE(PG8_SA(0, 1), cA + hstepA, voffA);
        if (wr == 1) PG8_BAR;
        PG8_WAIT_V(2); PG8_BAR;
        PG8_STAGE(PG8_SB(1, 0), cB + kstep, voffB); PG8_STAGE(PG8_SA(1, 0), cA + kstep, voffA); PG8_STAGE(PG8_SB(1, 1), cB + hstepB + kstep, voffB);
        PG8_WAIT_V(6); PG8_BAR;
    } else {
        PG8_STAGE(PG8_SB(0, 0), cB, voffB); PG8_STAGE(PG8_SA(0, 0), cA, voffA); PG8_STAGE(PG8_SB(0, 1), cB + hstepB, voffB); PG8_STAGE(PG8_SA(0, 1), cA + hstepA, voffA);
        if (wr == 1) PG8_BAR;
        PG8_WAIT_V(4); PG8_BAR;
        PG8_STAGE(PG8_SB(1, 0), cB + kstep, voffB); PG8_STAGE(PG8_SA(1, 0), cA + kstep, voffA); PG8_STAGE(PG8_SB(1, 1), cB + hstepB + kstep, voffB);
        PG8_WAIT_V(6); PG8_BAR;
    }
    for (;;) {
        const bool has_next = S.next(ui + 1, nxt);
        const char* nA = has_next ? (const char*)g.A + (size_t)nxt.pm * tstepA : cA; const char* nB = has_next ? (const char*)g.Bt + (size_t)nxt.pn * tstepB : cB;
        for (int t = 0; t < nt; t += 2) {
            const bool last = (t == nt - 2);
            const char* a1 = cA + (size_t)(t + 1) * kstep;
            const char* a2 = last ? nA : cA + (size_t)(t + 2) * kstep; const char* b2 = last ? nB : cB + (size_t)(t + 2) * kstep;
            const char* a3 = a2 + kstep; const char* b3 = b2 + kstep;
            if (last && has_next) S.a_ready(nxt);
            if constexpr (SP2) {
            PG8_LDB(B0, 0, 0); PG8_LDB(B1, 0, 1); PG8_SCHED; PG8_LDA(At, 0, 0); PG8_STAGE(PG8_SA(1, 1), a1 + hstepA, voffA);
            PG8_WAIT_V(8); PG8_WAIT_L(0); PG8_BAR; PG8_MMA(0, 0, At, B0); PG8_MMA(0, 1, At, B1); PG8_BAR; PG8_SCHED;
            PG8_LDA(At, 0, 1); PG8_STAGE(PG8_SB(0, 0), b2, voffB); PG8_STAGE(PG8_SB(0, 1), b2 + hstepB, voffB); PG8_STAGE(PG8_SA(0, 0), a2, voffA);
            PG8_WAIT_V(8); PG8_WAIT_L(0); PG8_BAR; PG8_MMA(1, 0, At, B0); PG8_MMA(1, 1, At, B1); PG8_BAR; PG8_SCHED;
            PG8_LDB(B0, 1, 0); PG8_LDB(B1, 1, 1); PG8_SCHED; PG8_LDA(At, 1, 0); PG8_STAGE(PG8_SA(0, 1), a2 + hstepA, voffA);
            PG8_WAIT_V(8); PG8_WAIT_L(0); PG8_BAR; PG8_MMA(0, 0, At, B0); PG8_MMA(0, 1, At, B1); PG8_BAR; PG8_SCHED;
            PG8_LDA(At, 1, 1); PG8_STAGE(PG8_SB(1, 0), b3, voffB); PG8_STAGE(PG8_SB(1, 1), b3 + hstepB, voffB); PG8_STAGE(PG8_SA(1, 0), a3, voffA);
            PG8_WAIT_V(8); PG8_WAIT_L(0); PG8_BAR; PG8_MMA(1, 0, At, B0); PG8_MMA(1, 1, At, B1); PG8_BAR; PG8_SCHED;
            } else {
            PG8_LDB(B0, 0, 0); PG8_SCHED; PG8_LDA(At, 0, 0); PG8_STAGE(PG8_SA(1, 1), a1 + hstepA, voffA);
            PG8_WAIT_L(8); PG8_BAR; PG8_WAIT_L(0); PG8_MMA(0, 0, At, B0); PG8_BAR; PG8_SCHED;
            PG8_LDB(B1, 0, 1); PG8_STAGE(PG8_SB(0, 0), b2, voffB);
            PG8_BAR; PG8_WAIT_L(0); PG8_MMA(0, 1, At, B1); PG8_BAR;
            PG8_LDA(At, 0, 1); PG8_STAGE(PG8_SA(0, 0), a2, voffA);
            PG8_BAR; PG8_WAIT_L(0); PG8_MMA(1, 0, At, B0); PG8_BAR; PG8_SCHED;
            PG8_STAGE(PG8_SB(0, 1), b2 + hstepB, voffB);
            PG8_WAIT_V(6); PG8_BAR; PG8_MMA(1, 1, At, B1); PG8_BAR;
            PG8_LDB(B0, 1, 0); PG8_SCHED; PG8_LDA(At, 1, 0); PG8_STAGE(PG8_SA(0, 1), a2 + hstepA, voffA);
            PG8_WAIT_L(8); PG8_BAR; PG8_WAIT_L(0); PG8_MMA(0, 0, At, B0); PG8_BAR; PG8_SCHED;
            PG8_LDB(B1, 1, 1); PG8_STAGE(PG8_SB(1, 0), b3, voffB);
            PG8_BAR; PG8_WAIT_L(0); PG8_MMA(0, 1, At, B1); PG8_BAR;
            PG8_LDA(At, 1, 1); PG8_STAGE(PG8_SA(1, 0), a3, voffA);
            PG8_BAR; PG8_WAIT_L(0); PG8_MMA(1, 0, At, B0); PG8_BAR; PG8_SCHED;
            PG8_STAGE(PG8_SB(1, 1), b3 + hstepB, voffB);
            PG8_WAIT_V(6); PG8_BAR; PG8_MMA(1, 1, At, B1); PG8_BAR;
            }
        }
        if constexpr (ALIGN_EPI) { if (wr == 0) PG8_BAR; }
        if constexpr (!Epi::AFTER_DRAIN) { E(acc, cur, wr, wc, fr, fq, epf); S.done(cur); }
        if (!has_next) break;
#pragma unroll
        for (int a = 0; a < 2; ++a)
#pragma unroll
            for (int b = 0; b < 2; ++b)
#pragma unroll
                for (int m = 0; m < 4; ++m)
#pragma unroll
                    for (int n = 0; n < 2; ++n) acc[a][b][m][n] = (f32x4){0.f, 0.f, 0.f, 0.f};
        cur = nxt; cA = nA; cB = nB; ++ui; epf = E.prefetch(cur, tid);
        if constexpr (ALIGN_EPI) { if (wr == 1) PG8_BAR; }
    }
    PG8_WAIT_V(0);
    if constexpr (!ALIGN_EPI) { if (wr == 0) PG8_BAR; }
    PG8_BAR;
    if constexpr (Epi::AFTER_DRAIN) { E.fused(acc, cur, wr, wc, fr, fq, lds, wid, lane); S.done(cur); }
#undef PG8_SA
#undef PG8_SB
#undef PG8_STAGE
#undef PG8_LDA
#undef PG8_LDB
#undef PG8_MMA
#undef PG8_WAIT_V
#undef PG8_WAIT_L
#undef PG8_BAR
#undef PG8_SCHED
}
}
#define LAS __attribute__((address_space(3)))
typedef unsigned short bf16;
typedef unsigned u32x4 __attribute__((ext_vector_type(4)));
typedef unsigned u32x2 __attribute__((ext_vector_type(2)));
typedef float f32x4 __attribute__((ext_vector_type(4)));
typedef float f32x16 __attribute__((ext_vector_type(16)));
typedef short bf16x8 __attribute__((ext_vector_type(8)));
typedef short s16x4 __attribute__((ext_vector_type(4)));
using pg8::cvt_pk_bf16; using pg8::LOG2E; using pg8::RMS_EPS;

constexpr int NWAVES = 8, NTHR = 512;
constexpr int DM = 1024, FF = 2816, ZP = 2592, NINP = 2816, DEPTH = 4;
constexpr int MP = 67072;
constexpr int G0_ROWS = 33792, G1_ROWS = 33280;
constexpr size_t MiB = 1u << 20;
constexpr size_t WS_RINV = 1 * MiB + 640 * 1024;
constexpr size_t WS_CTL = 0, WS_ROPE = 1 * MiB, WS_SSP = 2 * MiB, WS_METAH = 11 * MiB, WS_W = 13 * MiB, WS_XY = 61 * MiB, WS_BIG = 192 * MiB, WS_END = 574 * MiB;
constexpr size_t W_GU1 = 0, W_DN1 = 11 * MiB, W_GU2 = 33 * MiB / 2, W_DN2 = 55 * MiB / 2, W_IN = 33 * MiB, W_UQ = 77 * MiB / 2, W_UK = 40 * MiB, W_UV = 40 * MiB + MiB / 4, W_O = 40 * MiB + MiB / 2;
constexpr size_t B_Z = 0, B_K = 168 * MiB, B_VT = 218 * MiB, B_YC = 251 * MiB;
constexpr int LDS_BYTES = 147456;
constexpr int A_K = 0, A_KBUF = 64 * 208, A_V = 2 * A_KBUF, A_VBUF = 64 * 144, A_WSF = 61440, A_STG = A_WSF + 8 * 256, A_TAB = A_STG + 8 * 4096, A_UW = A_TAB + 4 * 640 * 4 + 256;
constexpr int D_K = 0, D_KBUF = 64 * 192, D_V = 3 * D_KBUF, D_VBUF = 64 * 128;
static_assert(D_V + 3 * D_VBUF <= A_WSF && A_V + 2 * A_VBUF <= A_WSF, "attention LDS rings");
static_assert(A_UW + 64 <= 131072, "attention LDS");

struct Args { const float* in[25]; float* out; unsigned char* ws; };
typedef const __attribute__((address_space(4))) Args KArgs;
typedef KArgs* KArgsP;
enum { I_XP = 0, I_XS, I_META, I_F1PRE, I_F1GU, I_F1DN, I_F1POST, I_MPRE, I_WIN, I_CONVW, I_RPB, I_MB, I_QN, I_WUQ, I_KVN, I_WUKV, I_CON, I_NON, I_MON, I_WO, I_MPOST, I_F2PRE, I_F2GU, I_F2DN, I_F2POST };

__device__ __forceinline__ float bf2f(unsigned short b) { return __uint_as_float((unsigned)b << 16); }
__device__ __forceinline__ float bflo(unsigned w) { return __uint_as_float(w << 16); }
__device__ __forceinline__ float bfhi(unsigned w) { return __uint_as_float(w & 0xffff0000u); }
__device__ __forceinline__ float wave_sum(float v) {
#pragma unroll
    for (int o = 1; o < 64; o <<= 1) v += __shfl_xor(v, o);
    return v;
}
__device__ __forceinline__ void row_decode(int row, int& s, int& i, int& T) {
    if (row < G0_ROWS) { s = row / 2112; i = row - s * 2112; T = 2048; } else { const int r = row - G0_ROWS, q = r / 4160; s = 16 + q; i = r - q * 4160; T = 4096; }
}
__device__ __forceinline__ GAS float* hptr(GAS float* out, GAS float* metah, int s, int i, int T) {
    if (i < T) { const size_t ob = s < 16 ? (size_t)s * 2048 : (size_t)32768 + (size_t)(s - 16) * 4096; return out + (ob + i) * DM; }
    return metah + (size_t)(s * 16 + (i - T)) * DM;
}
__device__ __forceinline__ void wt_item(const GAS float* W, int ldw, int K, GAS bf16* WT, const GAS float* gain, int k0, int srcn0, int dstn0, LAS float* scr, int lane) {
    const int c = lane & 7;
    if (srcn0 < 0) {
#pragma unroll
        for (int j = 0; j < 4; ++j) { const int n = (lane >> 3) + 8 * j; *(GAS u32x4*)(WT + (size_t)(dstn0 + n) * K + k0 + 8 * c) = (u32x4){0u, 0u, 0u, 0u}; }
        return;
    }
#pragma unroll 8
    for (int i = 0; i < 32; ++i) { const int kk = 2 * i + (lane >> 5); float v = W[(size_t)(k0 + kk) * ldw + srcn0 + (lane & 31)]; if (gain) v *= gain[k0 + kk]; scr[kk * 33 + (lane & 31)] = v; }
    asm volatile("s_waitcnt lgkmcnt(0)" ::: "memory");
#pragma unroll
    for (int j = 0; j < 4; ++j) { const int n = (lane >> 3) + 8 * j; const LAS float* s = scr + (8 * c) * 33 + n;
        u32x4 o; o.x = cvt_pk_bf16(s[0 * 33], s[1 * 33]); o.y = cvt_pk_bf16(s[2 * 33], s[3 * 33]); o.z = cvt_pk_bf16(s[4 * 33], s[5 * 33]); o.w = cvt_pk_bf16(s[6 * 33], s[7 * 33]);
        *(GAS u32x4*)(WT + (size_t)(dstn0 + n) * K + k0 + 8 * c) = o; }
    asm volatile("s_waitcnt lgkmcnt(0)" ::: "memory");
}
__device__ __forceinline__ void convert_layer(KArgsP ap, int l, LAS float* scr, int gw, int NGW, int lane) {
    const KArgs& a = *ap;
    GAS unsigned char* wb = (GAS unsigned char*)(a.ws + WS_W);
    constexpr int N_GU = 16 * 176, N_DN = 44 * 32, N_IN = 16 * 88, N_UQ = 12 * 24, N_UK = 4 * 16, N_WO = 16 * 32;
    constexpr int TOT = 2 * N_GU + 2 * N_DN + N_IN + N_UQ + 2 * N_UK + N_WO;
    for (int it = gw; it < TOT; it += NGW) {
        int r = it;
        if (r < 2 * N_GU) { const int f = r / N_GU; r -= f * N_GU; const int kb = r / 176, nb = r % 176; const int sb = ((nb >> 2) & 1) * 88 + 4 * (nb >> 3) + (nb & 3);
            wt_item((const GAS float*)a.in[f ? I_F2GU : I_F1GU] + (size_t)l * 1024 * 5632, 5632, 1024, (GAS bf16*)(wb + (f ? W_GU2 : W_GU1)), (const GAS float*)a.in[f ? I_F2PRE : I_F1PRE] + l * 1024, 64 * kb, 32 * sb, 32 * nb, scr, lane); continue; }
        r -= 2 * N_GU;
        if (r < 2 * N_DN) { const int f = r / N_DN; r -= f * N_DN; const int kb = r / 32, nb = r % 32;
            wt_item((const GAS float*)a.in[f ? I_F2DN : I_F1DN] + (size_t)l * 2816 * 1024, 1024, 2816, (GAS bf16*)(wb + (f ? W_DN2 : W_DN1)), nullptr, 64 * kb, 32 * nb, 32 * nb, scr, lane); continue; }
        r -= 2 * N_DN;
        if (r < N_IN) { const int kb = r / 88, nb = r % 88;
            wt_item((const GAS float*)a.in[I_WIN] + (size_t)l * 1024 * 2592, 2592, 1024, (GAS bf16*)(wb + W_IN), (const GAS float*)a.in[I_MPRE] + l * 1024, 64 * kb, nb < 81 ? 32 * nb : -1, 32 * nb, scr, lane); continue; }
        r -= N_IN;
        if (r < N_UQ) { const int kb = r / 24, nb = r % 24;
            wt_item((const GAS float*)a.in[I_WUQ] + (size_t)l * 768 * 768, 768, 768, (GAS bf16*)(wb + W_UQ), (const GAS float*)a.in[I_QN] + l * 768, 64 * kb, 32 * nb, 32 * nb, scr, lane); continue; }
        r -= N_UQ;
        if (r < 2 * N_UK) { const int v = r / N_UK; r -= v * N_UK; const int kb = r / 16, nb = r % 16; const int sb = (nb >> 1) * 4 + 2 * v + (nb & 1);
            wt_item((const GAS float*)a.in[I_WUKV] + (size_t)l * 256 * 1024, 1024, 256, (GAS bf16*)(wb + (v ? W_UV : W_UK)), (const GAS float*)a.in[I_KVN] + l * 256, 64 * kb, 32 * sb, 32 * nb, scr, lane); continue; }
        r -= 2 * N_UK;
        { const int kb = r / 32, nb = r % 32; const int k0 = 64 * kb;
            const GAS float* gain = k0 < 256 ? (const GAS float*)a.in[I_CON] + l * 256 : (k0 < 512 ? (const GAS float*)a.in[I_NON] + l * 256 - 256 : (const GAS float*)a.in[I_MON] + l * 512 - 512);
            wt_item((const GAS float*)a.in[I_WO] + (size_t)l * 1024 * 1024, 1024, 1024, (GAS bf16*)(wb + W_O), gain, k0, 32 * nb, 32 * nb, scr, lane); }
    }
}
__device__ __forceinline__ void wave_sum2(float& a, float& b) {
#pragma unroll
    for (int o = 1; o < 64; o <<= 1) { const float ta = __shfl_xor(a, o), tb = __shfl_xor(b, o); a += ta; b += tb; }
}
__device__ __forceinline__ void rowpass(KArgsP ap, const GAS float* gpost, float coef, bool init, int row_lo, int row_hi, int gw, int NGW, int lane) {
    const KArgs& a = *ap;
    GAS bf16* XY = (GAS bf16*)(a.ws + WS_XY); const GAS bf16* YB = (const GAS bf16*)a.out; GAS float* RINV = (GAS float*)(a.ws + WS_RINV);
    f32x4 g[4];
#pragma unroll
    for (int j = 0; j < 4; ++j) g[j] = init ? (f32x4){0.f, 0.f, 0.f, 0.f} : ((const GAS f32x4*)gpost)[lane + 64 * j] * coef;
    for (int row0 = row_lo + gw; row0 < row_hi; row0 += 2 * NGW) {
        GAS unsigned long long* xy8[2]; bool val[2], ex[2]; int rw[2]; f32x4 h[2][4]; unsigned long long yw[2][4];
#pragma unroll
        for (int k = 0; k < 2; ++k) {
            const int row = row0 + k * NGW; ex[k] = row < row_hi; rw[k] = ex[k] ? row : 0; int s = 0, i = 0, T = 1; row_decode(rw[k], s, i, T);
            val[k] = ex[k] && (i < T + 16);
            xy8[k] = (GAS unsigned long long*)(XY + (size_t)rw[k] * DM) + lane;
#pragma unroll
            for (int j = 0; j < 4; ++j) { h[k][j] = (f32x4){0.f, 0.f, 0.f, 0.f}; yw[k][j] = 0ull; }
            if (val[k]) {
                if (init) { const GAS float* src = (i < T) ? (s < 16 ? (const GAS float*)a.in[I_XP] + ((size_t)s * 2048 + i) * DM : (const GAS float*)a.in[I_XS] + ((size_t)(s - 16) * 4096 + i) * DM) : (const GAS float*)a.in[I_META] + (size_t)(i - T) * DM;
#pragma unroll
                    for (int j = 0; j < 4; ++j) h[k][j] = ((const GAS f32x4*)src)[lane + 64 * j]; }
                else { const GAS unsigned long long* y8 = (const GAS unsigned long long*)(YB + (size_t)rw[k] * DM) + lane;
#pragma unroll
                    for (int j = 0; j < 4; ++j) { yw[k][j] = y8[64 * j]; const unsigned long long hw = xy8[k][64 * j]; const unsigned lo = (unsigned)hw, hi = (unsigned)(hw >> 32); h[k][j] = (f32x4){bflo(lo), bfhi(lo), bflo(hi), bfhi(hi)}; } }
            }
        }
        f32x4 y[2][4]; float ss[2] = {0.f, 0.f};
#pragma unroll
        for (int k = 0; k < 2; ++k)
#pragma unroll
            for (int j = 0; j < 4; ++j) { const unsigned lo = (unsigned)yw[k][j], hi = (unsigned)(yw[k][j] >> 32);
                y[k][j] = (f32x4){bflo(lo), bfhi(lo), bflo(hi), bfhi(hi)}; ss[k] += (y[k][j][0] * y[k][j][0] + y[k][j][1] * y[k][j][1]) + (y[k][j][2] * y[k][j][2] + y[k][j][3] * y[k][j][3]); }
        if (!init) wave_sum2(ss[0], ss[1]);
        float s2[2] = {0.f, 0.f}; unsigned long long ow[2][4];
#pragma unroll
        for (int k = 0; k < 2; ++k) { const float ry = __builtin_amdgcn_rsqf(ss[k] * (1.0f / DM) + RMS_EPS);
#pragma unroll
            for (int j = 0; j < 4; ++j) { if (!init) h[k][j] = h[k][j] + y[k][j] * g[j] * ry;
                const unsigned lo = cvt_pk_bf16(h[k][j][0], h[k][j][1]), hi = cvt_pk_bf16(h[k][j][2], h[k][j][3]); ow[k][j] = (unsigned long long)lo | ((unsigned long long)hi << 32);
                const f32x4 hr = (f32x4){bflo(lo), bfhi(lo), bflo(hi), bfhi(hi)};
                s2[k] += (hr[0] * hr[0] + hr[1] * hr[1]) + (hr[2] * hr[2] + hr[3] * hr[3]); } }
        wave_sum2(s2[0], s2[1]);
#pragma unroll
        for (int k = 0; k < 2; ++k) if (ex[k]) {
#pragma unroll
            for (int j = 0; j < 4; ++j) xy8[k][64 * j] = val[k] ? ow[k][j] : 0ull;
            if (lane == 0) RINV[rw[k]] = val[k] ? __builtin_amdgcn_rsqf(s2[k] * (1.0f / DM) + RMS_EPS) : 0.f; }
    }
}
__device__ __forceinline__ void output_pass(KArgsP ap, int gw, int NGW, int lane) {
    const KArgs& a = *ap; const GAS bf16* XY = (const GAS bf16*)(a.ws + WS_XY); GAS float* out = (GAS float*)a.out;
    for (int row = gw; row < MP; row += NGW) {
        int s, i, T; row_decode(row, s, i, T); if (i >= T) continue;
        const size_t ob = s < 16 ? (size_t)s * 2048 : (size_t)32768 + (size_t)(s - 16) * 4096;
        const GAS unsigned long long* x8 = (const GAS unsigned long long*)(XY + (size_t)row * DM) + lane; GAS f32x4* o = (GAS f32x4*)(out + (ob + i) * DM) + lane;
#pragma unroll
        for (int j = 0; j < 4; ++j) { const unsigned long long w = x8[64 * j]; const unsigned lo = (unsigned)w, hi = (unsigned)(w >> 32); o[64 * j] = (f32x4){bflo(lo), bfhi(lo), bflo(hi), bfhi(hi)}; }
    }
}
__device__ __forceinline__ void rope_table(GAS float* tab, int gt, int NGT) {
    for (int e = gt; e < 4112 * 16; e += NGT) { const int pos = e >> 4, j = e & 15; double f = 1.0; for (int k = 0; k < j; ++k) f *= 0.56234132519034907;
        double rev = (double)pos * f * 0.15915494309189535; rev -= __builtin_floor(rev); const float rv = (float)rev;
        tab[2 * e] = __builtin_amdgcn_cosf(rv); tab[2 * e + 1] = __builtin_amdgcn_sinf(rv); }
}
struct Grp { int row0, rows, T, Lp, nseq; };
__device__ __forceinline__ Grp grp_of(int g) { Grp r; if (g == 0) { r.row0 = 0; r.rows = G0_ROWS; r.T = 2048; r.Lp = 2112; r.nseq = 16; } else { r.row0 = G0_ROWS; r.rows = G1_ROWS; r.T = 4096; r.Lp = 4160; r.nseq = 8; } return r; }
__device__ __forceinline__ f32x4 cprod(unsigned long long c, unsigned long long u) {
    return (f32x4){bflo((unsigned)c) * bflo((unsigned)u), bfhi((unsigned)c) * bfhi((unsigned)u), bflo((unsigned)(c >> 32)) * bflo((unsigned)(u >> 32)), bfhi((unsigned)(c >> 32)) * bfhi((unsigned)(u >> 32))};
}
__device__ __forceinline__ void conv_kpe_pass(KArgsP ap, int l, const Grp& G, int gw, int NGW, int lane) {
    const KArgs& a = *ap;
    const GAS bf16* Z = (const GAS bf16*)(a.ws + WS_BIG + B_Z); GAS bf16* KB = (GAS bf16*)(a.ws + WS_BIG + B_K); GAS bf16* YC = (GAS bf16*)(a.ws + WS_BIG + B_YC) + (size_t)G.row0 * DM;
    const GAS float* cw = (const GAS float*)a.in[I_CONVW] + (size_t)l * 3 * 256; const GAS float* rope = (const GAS float*)(a.ws + WS_ROPE);
    const f32x4 w0 = ((const GAS f32x4*)cw)[lane], w1 = ((const GAS f32x4*)(cw + 256))[lane], w2 = ((const GAS f32x4*)(cw + 512))[lane];
    const int T = G.T;
    for (int gr0 = gw; gr0 < G.rows; gr0 += 2 * NGW) {
        bool ex[2], val[2]; int grr[2], pp[2]; unsigned long long cb[2], cc[2], cu[2], lc[2], lu[2], rc[2], ru[2]; unsigned short x1[2], x2[2]; float rcs[2], rsn[2];
#pragma unroll
        for (int k = 0; k < 2; ++k) {
            const int gr = gr0 + k * NGW; ex[k] = gr < G.rows; grr[k] = ex[k] ? gr : 0;
            const int sq = grr[k] / G.Lp, i = grr[k] - sq * G.Lp; val[k] = ex[k] && (i < T + 16);
            const int p = (i < T) ? 16 + i : i - T; pp[k] = val[k] ? p : 0;
            const int il = (p == 0) ? -1 : ((p - 1 >= 16) ? p - 17 : T + p - 1), ir = (p == T + 15) ? -1 : ((p + 1 >= 16) ? p - 15 : T + p + 1);
            cb[k] = cc[k] = cu[k] = lc[k] = lu[k] = rc[k] = ru[k] = 0ull; x1[k] = x2[k] = 0; rcs[k] = 1.f; rsn[k] = 0.f;
            if (val[k]) {
                const GAS bf16* zr = Z + (size_t)grr[k] * ZP;
                cb[k] = *((const GAS unsigned long long*)zr + lane); cc[k] = *((const GAS unsigned long long*)(zr + 256) + lane); cu[k] = *((const GAS unsigned long long*)(zr + 512) + lane);
                if (il >= 0) { const GAS bf16* z2 = Z + (size_t)(sq * G.Lp + il) * ZP; lc[k] = *((const GAS unsigned long long*)(z2 + 256) + lane); lu[k] = *((const GAS unsigned long long*)(z2 + 512) + lane); }
                if (ir >= 0) { const GAS bf16* z2 = Z + (size_t)(sq * G.Lp + ir) * ZP; rc[k] = *((const GAS unsigned long long*)(z2 + 256) + lane); ru[k] = *((const GAS unsigned long long*)(z2 + 512) + lane); }
                if (lane < 16) { x1[k] = zr[2560 + lane]; x2[k] = zr[2576 + lane]; rcs[k] = rope[(size_t)p * 32 + 2 * lane]; rsn[k] = rope[(size_t)p * 32 + 2 * lane + 1]; }
            }
        }
        f32x4 y[2]; float ss[2];
#pragma unroll
        for (int k = 0; k < 2; ++k) { const f32x4 cbv = (f32x4){bflo((unsigned)cb[k]), bfhi((unsigned)cb[k]), bflo((unsigned)(cb[k] >> 32)), bfhi((unsigned)(cb[k] >> 32))};
            y[k] = cbv * (w0 * cprod(lc[k], lu[k]) + w1 * cprod(cc[k], cu[k]) + w2 * cprod(rc[k], ru[k]));
            ss[k] = (y[k][0] * y[k][0] + y[k][1] * y[k][1]) + (y[k][2] * y[k][2] + y[k][3] * y[k][3]); }
        wave_sum2(ss[0], ss[1]);
#pragma unroll
        for (int k = 0; k < 2; ++k) if (ex[k]) {
            const float rn = __builtin_amdgcn_rsqf(ss[k] * (1.0f / 256.0f) + RMS_EPS); const f32x4 o = y[k] * rn;
            *((GAS unsigned long long*)(YC + (size_t)grr[k] * DM) + lane) = (unsigned long long)cvt_pk_bf16(o[0], o[1]) | ((unsigned long long)cvt_pk_bf16(o[2], o[3]) << 32);
            if (lane < 16) { const float a1 = bf2f(x1[k]), a2 = bf2f(x2[k]); const unsigned pk = cvt_pk_bf16(a1 * rcs[k] - a2 * rsn[k], a1 * rsn[k] + a2 * rcs[k]); const bf16 o1 = (bf16)(pk & 0xffffu), o2 = (bf16)(pk >> 16);
#pragma unroll
                for (int h = 0; h < 8; ++h) { KB[(size_t)grr[k] * 768 + 96 * h + 64 + lane] = o1; KB[(size_t)grr[k] * 768 + 96 * h + 80 + lane] = o2; } }
        }
    }
}
__device__ __forceinline__ void ynorm_pass(KArgsP ap, int row_lo, int row_hi, int gw, int NGW, int lane) {
    const KArgs& a = *ap;
    GAS bf16* YC = (GAS bf16*)(a.ws + WS_BIG + B_YC);
    for (int gr0 = row_lo + gw; gr0 < row_hi; gr0 += 2 * NGW) {
        bool ex[2], val[2]; GAS unsigned long long* p1[2]; GAS u32x4* p2[2]; unsigned long long w[2]; u32x4 v[2];
#pragma unroll
        for (int k = 0; k < 2; ++k) { const int gr = gr0 + k * NGW; ex[k] = gr < row_hi; const int g2 = ex[k] ? gr : 0; int sq, i, T; row_decode(g2, sq, i, T); val[k] = ex[k] && (i < T + 16);
            p1[k] = (GAS unsigned long long*)(YC + (size_t)g2 * DM + 256) + lane; p2[k] = (GAS u32x4*)(YC + (size_t)g2 * DM + 512) + lane;
            w[k] = 0ull; v[k] = (u32x4){0u, 0u, 0u, 0u}; if (val[k]) { w[k] = *p1[k]; v[k] = *p2[k]; } }
        float y[2][4], z[2][8], s1[2], s2[2];
#pragma unroll
        for (int k = 0; k < 2; ++k) { y[k][0] = bflo((unsigned)w[k]); y[k][1] = bfhi((unsigned)w[k]); y[k][2] = bflo((unsigned)(w[k] >> 32)); y[k][3] = bfhi((unsigned)(w[k] >> 32));
            z[k][0] = bflo(v[k].x); z[k][1] = bfhi(v[k].x); z[k][2] = bflo(v[k].y); z[k][3] = bfhi(v[k].y); z[k][4] = bflo(v[k].z); z[k][5] = bfhi(v[k].z); z[k][6] = bflo(v[k].w); z[k][7] = bfhi(v[k].w);
            s1[k] = (y[k][0] * y[k][0] + y[k][1] * y[k][1]) + (y[k][2] * y[k][2] + y[k][3] * y[k][3]); s2[k] = 0.f;
#pragma unroll
            for (int e = 0; e < 8; ++e) s2[k] += z[k][e] * z[k][e]; }
        wave_sum2(s1[0], s1[1]); wave_sum2(s2[0], s2[1]);
#pragma unroll
        for (int k = 0; k < 2; ++k) if (ex[k]) {
            const float r1 = val[k] ? __builtin_amdgcn_rsqf(s1[k] * (1.0f / 256.0f) + RMS_EPS) : 0.f, r2 = val[k] ? __builtin_amdgcn_rsqf(s2[k] * (1.0f / 512.0f) + RMS_EPS) : 0.f;
            *p1[k] = (unsigned long long)cvt_pk_bf16(y[k][0] * r1, y[k][1] * r1) | ((unsigned long long)cvt_pk_bf16(y[k][2] * r1, y[k][3] * r1) << 32);
            u32x4 o; o.x = cvt_pk_bf16(z[k][0] * r2, z[k][1] * r2); o.y = cvt_pk_bf16(z[k][2] * r2, z[k][3] * r2); o.z = cvt_pk_bf16(z[k][4] * r2, z[k][5] * r2); o.w = cvt_pk_bf16(z[k][6] * r2, z[k][7] * r2); *p2[k] = o; }
    }
}
struct AttG { const GAS bf16 *Q, *K, *VT, *Z; GAS bf16* YC; const GAS float* rope; int rows, T, Lp; };
__device__ __forceinline__ int crow(int r, int hi) { return (r & 3) + 8 * (r >> 2) + 4 * hi; }
#define MFMA32(a, b, c) __builtin_amdgcn_mfma_f32_32x32x16_bf16((a), (b), (c), 0, 0, 0)
template <int MODE>
__device__ __forceinline__ void attn_unit(const AttG& P, int seq, int head, int qb, LAS unsigned char* lds, int tid, int wid, int lane) {
    constexpr int DQK = MODE == 0 ? 96 : 64, NDK = DQK / 16, KP = DQK * 2 + 16, VP = 144;
    const int r32 = lane & 31, hi = lane >> 5;
    const int T = P.T, Lp = P.Lp, nqbr = T >> 8; const bool metablk = (qb == nqbr);
    const int sbase = seq * Lp;
    const int qi = qb * 256 + wid * 32 + r32; const int qic = qi < Lp - 1 ? qi : Lp - 1;
    bf16x8 qr[NDK];
    { const GAS bf16* qsrc = MODE == 0 ? P.Q + (size_t)(sbase + qic) * 768 + 96 * head : P.Z + (size_t)(sbase + qic) * ZP + 768 + 64 * head;
#pragma unroll
      for (int d0 = 0; d0 < NDK; ++d0) qr[d0] = *(const GAS bf16x8*)(qsrc + 16 * d0 + 8 * hi); }
    if constexpr (MODE == 0) {
        const int pos = qic < T ? 16 + qic : (qic - T < 15 ? qic - T : 15);
        const GAS f32x4* rp = (const GAS f32x4*)(P.rope + (size_t)pos * 32 + 16 * hi);
#pragma unroll
        for (int e2 = 0; e2 < 4; ++e2) { const f32x4 cs = rp[e2];
#pragma unroll
            for (int q = 0; q < 2; ++q) { const int e = 2 * e2 + q; const float c = cs[2 * q], s = cs[2 * q + 1];
                const float x1 = bf2f((unsigned short)qr[4][e]), x2 = bf2f((unsigned short)qr[5][e]);
                const unsigned pk = cvt_pk_bf16(x1 * c - x2 * s, x1 * s + x2 * c); qr[4][e] = (short)(pk & 0xffffu); qr[5][e] = (short)(pk >> 16); } }
    }
    int nt, kr_lo = 0; const int rows_total = T >> 6;
    int na_r = 0, na_c = 0, na_rs = 0, na_cs = 0;
    if constexpr (MODE == 0) nt = rows_total + 1;
    else {
        if (metablk) nt = 1;
        else { const int r0 = 4 * qb; int lo = r0 - 4; lo = lo < 0 ? 0 : (lo > rows_total - 8 ? rows_total - 8 : lo); int h2 = r0 - 1; h2 = h2 < 0 ? 0 : (h2 > rows_total - 8 ? rows_total - 8 : h2);
            kr_lo = lo; nt = (h2 + 7 - lo + 1) + 1; }
        na_r = 4 * qb + (wid >> 1); na_c = 32 * (wid & 1) + r32;
        na_rs = na_r - 4; na_rs = na_rs < 0 ? 0 : (na_rs > rows_total - 8 ? rows_total - 8 : na_rs);
        na_cs = na_c - 8; na_cs = na_cs < 0 ? 0 : (na_cs > 48 ? 48 : na_cs);
    }
    const LAS float* tabL = (const LAS float*)(lds + A_TAB) + head * 640 + 64;
    const LAS float* mbL = (const LAS float*)(lds + A_TAB + 4 * 640 * 4) + head * 16;
    LAS float* wsf = (LAS float*)(lds + A_WSF) + wid * 64;
    u32x4 kst0, kst1 = {0u, 0u, 0u, 0u}, vst;
    const int kc0 = tid, kc1 = 512 + tid;
#define TILE_KB(t) ((t) == nt - 1 ? T : 64 * (kr_lo + (t)))
#define GLOAD(t) do { const int kb_ = TILE_KB(t); \
      if constexpr (MODE == 0) { { const int krow = kc0 / 12, part = kc0 % 12; kst0 = *(const GAS u32x4*)(P.K + (size_t)(sbase + kb_ + krow) * 768 + 96 * head + 8 * part); } \
          if (tid < 256) { const int krow = kc1 / 12, part = kc1 % 12; kst1 = *(const GAS u32x4*)(P.K + (size_t)(sbase + kb_ + krow) * 768 + 96 * head + 8 * part); } \
          { const int d = tid >> 3, part = tid & 7; vst = *(const GAS u32x4*)(P.VT + (size_t)(64 * head + d) * P.rows + sbase + kb_ + 8 * part); } } \
      else { const int krow = tid >> 3, part = tid & 7; const GAS bf16* zr_ = P.Z + (size_t)(sbase + kb_ + krow) * ZP + 64 * head + 8 * part; kst0 = *(const GAS u32x4*)(zr_ + 1024); vst = *(const GAS u32x4*)(zr_ + 1280); } } while (0)
#define LSTORE(buf) do { LAS unsigned char* Kb_ = lds + A_K + (buf) * A_KBUF; LAS unsigned char* Vb_ = lds + A_V + (buf) * A_VBUF; \
      if constexpr (MODE == 0) { { const int krow = kc0 / 12, part = kc0 % 12; *(LAS u32x4*)(Kb_ + krow * KP + part * 16) = kst0; } \
          if (tid < 256) { const int krow = kc1 / 12, part = kc1 % 12; *(LAS u32x4*)(Kb_ + krow * KP + part * 16) = kst1; } \
          { const int d = tid >> 3, part = tid & 7; *(LAS u32x4*)(Vb_ + d * VP + part * 16) = vst; } } \
      else { const int krow = tid >> 3, part = tid & 7; *(LAS u32x4*)(Kb_ + krow * KP + part * 16) = kst0; \
          const int kpos_ = (krow & ~12) | ((krow & 4) << 1) | ((krow & 8) >> 1); LAS unsigned short* vt_ = (LAS unsigned short*)(Vb_ + (8 * part) * VP + kpos_ * 2); \
          vt_[0 * (VP / 2)] = (unsigned short)(vst.x & 0xffffu); vt_[1 * (VP / 2)] = (unsigned short)(vst.x >> 16); vt_[2 * (VP / 2)] = (unsigned short)(vst.y & 0xffffu); vt_[3 * (VP / 2)] = (unsigned short)(vst.y >> 16); \
          vt_[4 * (VP / 2)] = (unsigned short)(vst.z & 0xffffu); vt_[5 * (VP / 2)] = (unsigned short)(vst.z >> 16); vt_[6 * (VP / 2)] = (unsigned short)(vst.w & 0xffffu); vt_[7 * (VP / 2)] = (unsigned short)(vst.w >> 16); } } while (0)
    GLOAD(0); LSTORE(0);
    __syncthreads();
    float l_reg = 0.f; bool have_m0 = false;
    f32x16 o0, o1, negm;
#pragma unroll
    for (int r = 0; r < 16; ++r) { o0[r] = 0.f; o1[r] = 0.f; negm[r] = 0.f; }
    for (int t = 0; t < nt; ++t) {
        const int buf = t & 1; const bool more = (t + 1 < nt);
        if (more) GLOAD(t + 1);
        const bool is_meta = (t == nt - 1);
        bool active = true;
        if constexpr (MODE == 1) { if (!is_meta) { const int kr = kr_lo + t; active = (kr >= na_rs && kr <= na_rs + 7); } }
        if (active) {
            const LAS unsigned char* Kb = lds + A_K + buf * A_KBUF; const LAS unsigned char* Vb = lds + A_V + buf * A_VBUF;
            f32x16 p0 = negm, p1 = negm;
            bf16x8 kf[2 * NDK]; bf16x8 vf[8];
#pragma unroll
            for (int d0 = 0; d0 < NDK; ++d0) {
                kf[2 * d0] = *(const LAS bf16x8*)(Kb + r32 * KP + d0 * 32 + hi * 16);
                kf[2 * d0 + 1] = *(const LAS bf16x8*)(Kb + (32 + r32) * KP + d0 * 32 + hi * 16);
            }
            __builtin_amdgcn_sched_barrier(0);
#pragma unroll
            for (int d0 = 0; d0 < NDK; ++d0) { p0 = MFMA32(kf[2 * d0], qr[d0], p0); p1 = MFMA32(kf[2 * d0 + 1], qr[d0], p1); }
            __builtin_amdgcn_sched_barrier(0);
#pragma unroll
            for (int ks = 0; ks < 4; ++ks) {
                const LAS unsigned char* vp0 = Vb + r32 * VP + (16 * ks + 8 * hi) * 2;
                vf[2 * ks] = *(const LAS bf16x8*)vp0; vf[2 * ks + 1] = *(const LAS bf16x8*)(vp0 + 32 * VP);
            }
            __builtin_amdgcn_sched_barrier(0);
            if (is_meta) {
#pragma unroll
                for (int r = 0; r < 16; ++r) { const int kv = crow(r, hi); float b = 0.f; if constexpr (MODE == 1) b = mbL[kv & 15]; p0[r] = kv < 16 ? p0[r] + b : -INFINITY; p1[r] = -INFINITY; }
            } else if constexpr (MODE == 1) {
                const int kr = kr_lo + t; const LAS float* rp = tabL + (kr - na_r + 7) * 31 + (15 - na_c);
#pragma unroll
                for (int r = 0; r < 16; ++r) { const int kc = crow(r, hi);
                    p0[r] = (kc >= na_cs && kc < na_cs + 16) ? p0[r] + rp[kc] : -INFINITY;
                    p1[r] = (kc + 32 >= na_cs && kc + 32 < na_cs + 16) ? p1[r] + rp[kc + 32] : -INFINITY; }
            }
            if (!have_m0) {
                float mx = fmaxf(p0[0], p1[0]);
#pragma unroll
                for (int r = 1; r < 16; ++r) mx = fmaxf(mx, fmaxf(p0[r], p1[r]));
                mx = fmaxf(mx, __shfl_xor(mx, 32));
#pragma unroll
                for (int r = 0; r < 16; ++r) { p0[r] -= mx; p1[r] -= mx; negm[r] = -mx; }
                have_m0 = true;
            }
            { typedef float f32x2 __attribute__((ext_vector_type(2)));
              f32x2 accA = {0.f, 0.f}, accB = {0.f, 0.f};
#pragma unroll
              for (int r = 0; r < 16; r += 2) {
                  f32x2 a, b;
                  a.x = __builtin_amdgcn_exp2f(fminf(p0[r], 100.0f)); a.y = __builtin_amdgcn_exp2f(fminf(p0[r + 1], 100.0f));
                  b.x = __builtin_amdgcn_exp2f(fminf(p1[r], 100.0f)); b.y = __builtin_amdgcn_exp2f(fminf(p1[r + 1], 100.0f));
                  accA += a; accB += b; p0[r] = a.x; p0[r + 1] = a.y; p1[r] = b.x; p1[r + 1] = b.y; }
              const f32x2 acc = accA + accB; l_reg += acc.x + acc.y; }
            bf16x8 pa[4];
#pragma unroll
            for (int ks = 0; ks < 4; ++ks) { u32x4 w;
                if (ks < 2) { w.x = cvt_pk_bf16(p0[8 * ks + 0], p0[8 * ks + 1]); w.y = cvt_pk_bf16(p0[8 * ks + 2], p0[8 * ks + 3]); w.z = cvt_pk_bf16(p0[8 * ks + 4], p0[8 * ks + 5]); w.w = cvt_pk_bf16(p0[8 * ks + 6], p0[8 * ks + 7]); }
                else { const int b = 8 * (ks - 2); w.x = cvt_pk_bf16(p1[b + 0], p1[b + 1]); w.y = cvt_pk_bf16(p1[b + 2], p1[b + 3]); w.z = cvt_pk_bf16(p1[b + 4], p1[b + 5]); w.w = cvt_pk_bf16(p1[b + 6], p1[b + 7]); }
                pa[ks] = __builtin_bit_cast(bf16x8, w); }
#pragma unroll
            for (int ks = 0; ks < 4; ++ks) {
                o0 = MFMA32(pa[ks], vf[2 * ks], o0); o1 = MFMA32(pa[ks], vf[2 * ks + 1], o1);
            }
        }
        if (more) LSTORE(buf ^ 1);
        __syncthreads();
    }
#undef GLOAD
#undef LSTORE
#undef TILE_KB
    l_reg += __shfl_xor(l_reg, 32);
    if (hi == 0) wsf[32 + r32] = l_reg;
    asm volatile("s_waitcnt lgkmcnt(0)" ::: "memory");
    LAS unsigned short* stg = (LAS unsigned short*)(lds + A_STG) + wid * 2048;
#pragma unroll
    for (int j = 0; j < 4; ++j) { const f32x4 lv = *(const LAS f32x4*)(wsf + 32 + 8 * j + 4 * hi);
#pragma unroll
        for (int e = 0; e < 4; ++e) { const int r = 4 * j + e; const float rl = __builtin_amdgcn_rcpf(lv[e]); const int orow = crow(r, hi);
            const unsigned pk = cvt_pk_bf16(o0[r] * rl, o1[r] * rl); stg[orow * 64 + r32] = (unsigned short)(pk & 0xffffu); stg[orow * 64 + 32 + r32] = (unsigned short)(pk >> 16); } }
    asm volatile("s_waitcnt lgkmcnt(0)" ::: "memory");
    { const int coloff = (MODE == 0 ? 512 : 256) + 64 * head;
#pragma unroll
      for (int i = 0; i < 4; ++i) { const int row = i * 8 + (lane >> 3), ch = lane & 7; const u32x4 v = *(const LAS u32x4*)(stg + row * 64 + ch * 8);
          const int qrow = qb * 256 + wid * 32 + row; const bool valid = metablk ? (wid == 0 && row < 16) : true;
          if (valid) *(GAS u32x4*)(P.YC + (size_t)(sbase + qrow) * DM + coloff + ch * 8) = v; } }
    asm volatile("s_waitcnt lgkmcnt(0)" ::: "memory");
}
__device__ __forceinline__ void glds16(const GAS void* gsrc, unsigned lds_dst) { unsigned keep;
    asm volatile("s_mov_b32 %0, m0\n\ts_mov_b32 m0, %2\n\ts_nop 0\n\tglobal_load_lds_dwordx4 %1, off\n\ts_mov_b32 m0, %0" : "=&s"(keep) : "v"(gsrc), "s"(lds_dst) : "memory"); }
__device__ __forceinline__ void attn_unit_mla(const AttG& P, int seq, int head, int qb, LAS unsigned char* lds, int tid_in, int wid, int lane_in) {
    int lane = lane_in, tid = tid_in; asm volatile("" : "+v"(lane), "+v"(tid));
    const int r32 = lane & 31, hi = lane >> 5;
    const int T = P.T, Lp = P.Lp, sbase = seq * Lp, nt = (T >> 6) + 1;
    const int qi = qb * 256 + wid * 32 + r32;
    bf16x8 qr[6];
    { const GAS bf16* qsrc = P.Q + (size_t)(sbase + qi) * 768 + 96 * head;
#pragma unroll
      for (int d0 = 0; d0 < 6; ++d0) qr[d0] = *(const GAS bf16x8*)(qsrc + 16 * d0 + 8 * hi);
      const GAS f32x4* rp = (const GAS f32x4*)(P.rope + (size_t)(16 + qi) * 32 + 16 * hi);
#pragma unroll
      for (int e2 = 0; e2 < 4; ++e2) { const f32x4 cs = rp[e2];
#pragma unroll
          for (int q = 0; q < 2; ++q) { const int e = 2 * e2 + q; const float c = cs[2 * q], sn = cs[2 * q + 1];
              const float x1 = bf2f((unsigned short)qr[4][e]), x2 = bf2f((unsigned short)qr[5][e]);
              const unsigned pk = cvt_pk_bf16(x1 * c - x2 * sn, x1 * sn + x2 * c); qr[4][e] = (short)(pk & 0xffffu); qr[5][e] = (short)(pk >> 16); } } }
    const unsigned lds0 = (unsigned)(unsigned long long)lds;
    int koffA, koffB, voff;
    { int s = 64 * wid + lane; int row = s / 12, pos = s - 12 * row; int part = pos - ((row >> 2) & 3); part = part < 0 ? part + 12 : part; koffA = row * 768 + 8 * part;
      s = 64 * (8 + wid) + lane; row = s / 12; pos = s - 12 * row; part = pos - ((row >> 2) & 3); part = part < 0 ? part + 12 : part; koffB = row * 768 + 8 * part;
      s = 64 * wid + lane; const int d = s >> 3, c = (s & 7) ^ ((d >> 1) & 7); voff = d * P.rows + 8 * c; }
    const GAS bf16* Kg = P.K + (size_t)sbase * 768 + 96 * head; const GAS bf16* Vg = P.VT + (size_t)(64 * head) * P.rows + sbase;
    const unsigned kdst = lds0 + D_K + wid * 1024, vdst = lds0 + D_V + wid * 1024;
#define DMA_TILE(t, b) do { const int kb_ = ((t) == nt - 1) ? T : 64 * (t); \
        glds16(Kg + (size_t)kb_ * 768 + koffA, (unsigned)__builtin_amdgcn_readfirstlane(kdst + (b) * D_KBUF)); \
        if (wid < 4) glds16(Kg + (size_t)kb_ * 768 + koffB, (unsigned)__builtin_amdgcn_readfirstlane(kdst + (b) * D_KBUF + 8192)); \
        glds16(Vg + voff + kb_, (unsigned)__builtin_amdgcn_readfirstlane(vdst + (b) * D_VBUF)); } while (0)
    int kpos[6], vpos[4];
    { const int f = (r32 >> 2) & 3;
#pragma unroll
      for (int d0 = 0; d0 < 6; ++d0) { int x = 2 * d0 + hi + f; x = x >= 12 ? x - 12 : x; kpos[d0] = r32 * 192 + x * 16; }
#pragma unroll
      for (int ks = 0; ks < 4; ++ks) vpos[ks] = r32 * 128 + (((2 * ks + hi) ^ ((r32 >> 1) & 7)) * 16); }
    asm volatile("s_waitcnt vmcnt(0)" ::: "memory");
    DMA_TILE(0, 0);
    DMA_TILE(1, 1);
    f32x16 o0, o1, o2, negm;
#pragma unroll
    for (int r = 0; r < 16; ++r) { o0[r] = 0.f; o1[r] = 0.f; o2[r] = 0.f; negm[r] = 0.f; }
    const bf16x8 ones = (bf16x8){0x3F80, 0x3F80, 0x3F80, 0x3F80, 0x3F80, 0x3F80, 0x3F80, 0x3F80};
    int b = 0;
    for (int t = 0; t < nt; ++t) {
        if (t + 1 < nt) { if (wid < 4) asm volatile("s_waitcnt vmcnt(3)" ::: "memory"); else asm volatile("s_waitcnt vmcnt(2)" ::: "memory"); }
        else asm volatile("s_waitcnt vmcnt(0)" ::: "memory");
        __builtin_amdgcn_s_barrier(); asm volatile("" ::: "memory");
        if (t + 2 < nt) { const int b2 = b >= 1 ? b - 1 : 2; DMA_TILE(t + 2, b2); }
        const LAS unsigned char* Kb = lds + D_K + b * D_KBUF; const LAS unsigned char* Vb = lds + D_V + b * D_VBUF;
        f32x16 p0 = negm, p1 = negm;
        bf16x8 kf[12], vf[8];
#pragma unroll
        for (int d0 = 0; d0 < 6; ++d0) { kf[2 * d0] = *(const LAS bf16x8*)(Kb + kpos[d0]); kf[2 * d0 + 1] = *(const LAS bf16x8*)(Kb + kpos[d0] + 32 * 192); }
        __builtin_amdgcn_sched_barrier(0);
#pragma unroll
        for (int d0 = 0; d0 < 6; ++d0) { p0 = MFMA32(kf[2 * d0], qr[d0], p0); p1 = MFMA32(kf[2 * d0 + 1], qr[d0], p1); }
        __builtin_amdgcn_sched_barrier(0);
#pragma unroll
        for (int ks = 0; ks < 4; ++ks) { vf[2 * ks] = *(const LAS bf16x8*)(Vb + vpos[ks]); vf[2 * ks + 1] = *(const LAS bf16x8*)(Vb + vpos[ks] + 32 * 128); }
        __builtin_amdgcn_sched_barrier(0);
        if (t == nt - 1) {
#pragma unroll
            for (int r = 0; r < 16; ++r) { if (crow(r, hi) >= 16) p0[r] = -INFINITY; p1[r] = -INFINITY; }
        }
        if (t == 0) { float mx = fmaxf(p0[0], p1[0]);
#pragma unroll
            for (int r = 1; r < 16; ++r) mx = fmaxf(mx, fmaxf(p0[r], p1[r]));
            mx = fmaxf(mx, __shfl_xor(mx, 32));
#pragma unroll
            for (int r = 0; r < 16; ++r) { p0[r] -= mx; p1[r] -= mx; negm[r] = -mx; } }
#pragma unroll
        for (int r = 0; r < 16; ++r) { p0[r] = __builtin_amdgcn_exp2f(p0[r]); p1[r] = __builtin_amdgcn_exp2f(p1[r]); }
#pragma unroll
        for (int ks = 0; ks < 4; ++ks) { u32x4 w;
            if (ks < 2) { w.x = cvt_pk_bf16(p0[8 * ks + 0], p0[8 * ks + 1]); w.y = cvt_pk_bf16(p0[8 * ks + 2], p0[8 * ks + 3]); w.z = cvt_pk_bf16(p0[8 * ks + 4], p0[8 * ks + 5]); w.w = cvt_pk_bf16(p0[8 * ks + 6], p0[8 * ks + 7]); }
            else { const int bb = 8 * (ks - 2); w.x = cvt_pk_bf16(p1[bb + 0], p1[bb + 1]); w.y = cvt_pk_bf16(p1[bb + 2], p1[bb + 3]); w.z = cvt_pk_bf16(p1[bb + 4], p1[bb + 5]); w.w = cvt_pk_bf16(p1[bb + 6], p1[bb + 7]); }
            const bf16x8 pa = __builtin_bit_cast(bf16x8, w);
            o0 = MFMA32(pa, vf[2 * ks], o0); o1 = MFMA32(pa, vf[2 * ks + 1], o1); o2 = MFMA32(pa, ones, o2); }
        b = b == 2 ? 0 : b + 1;
    }
#undef DMA_TILE
    LAS unsigned short* stg = (LAS unsigned short*)(lds + A_STG) + wid * 2048;
#pragma unroll
    for (int r = 0; r < 16; ++r) { const float rl = __builtin_amdgcn_rcpf(o2[r]); const int orow = crow(r, hi);
        const unsigned pk = cvt_pk_bf16(o0[r] * rl, o1[r] * rl); stg[orow * 64 + r32] = (unsigned short)(pk & 0xffffu); stg[orow * 64 + 32 + r32] = (unsigned short)(pk >> 16); }
    asm volatile("s_waitcnt lgkmcnt(0)" ::: "memory");
#pragma unroll
    for (int i = 0; i < 4; ++i) { const int row = i * 8 + (lane >> 3), ch = lane & 7; const u32x4 v = *(const LAS u32x4*)(stg + row * 64 + ch * 8);
        *(GAS u32x4*)(P.YC + (size_t)(sbase + qb * 256 + wid * 32 + row) * DM + 512 + 64 * head + ch * 8) = v; }
    asm volatile("s_waitcnt vmcnt(0) lgkmcnt(0)" ::: "memory");
}
__device__ __forceinline__ void mla_scores(const GAS bf16* Kh, int kb, int r32, const bf16x8 (&qr)[6], f32x16& p0, f32x16& p1) {
#pragma unroll
    for (int r = 0; r < 16; ++r) { p0[r] = 0.f; p1[r] = 0.f; }
    bf16x8 kf[12];
#pragma unroll
    for (int d0 = 0; d0 < 6; ++d0) { kf[2 * d0] = *(const GAS bf16x8*)(Kh + (size_t)(kb + r32) * 768 + 16 * d0); kf[2 * d0 + 1] = *(const GAS bf16x8*)(Kh + (size_t)(kb + 32 + r32) * 768 + 16 * d0); }
#pragma unroll
    for (int d0 = 0; d0 < 6; ++d0) { p0 = MFMA32(kf[2 * d0], qr[d0], p0); p1 = MFMA32(kf[2 * d0 + 1], qr[d0], p1); }
}
__device__ __forceinline__ void attn_meta_mla(const AttG& P, int seq, int head, LAS unsigned char* lds, int tid_in, int wid, int lane_in) {
    int lane = lane_in, tid = tid_in; asm volatile("" : "+v"(lane), "+v"(tid));
    const int r32 = lane & 31, hi = lane >> 5;
    const int T = P.T, Lp = P.Lp, sbase = seq * Lp, nt = (T >> 6) + 1;
    bf16x8 qr[6];
    { const GAS bf16* qsrc = P.Q + (size_t)(sbase + T + r32) * 768 + 96 * head;
#pragma unroll
      for (int d0 = 0; d0 < 6; ++d0) qr[d0] = *(const GAS bf16x8*)(qsrc + 16 * d0 + 8 * hi);
      const int pos = r32 < 15 ? r32 : 15; const GAS f32x4* rp = (const GAS f32x4*)(P.rope + (size_t)pos * 32 + 16 * hi);
#pragma unroll
      for (int e2 = 0; e2 < 4; ++e2) { const f32x4 cs = rp[e2];
#pragma unroll
          for (int q = 0; q < 2; ++q) { const int e = 2 * e2 + q; const float c = cs[2 * q], sn = cs[2 * q + 1];
              const float x1 = bf2f((unsigned short)qr[4][e]), x2 = bf2f((unsigned short)qr[5][e]);
              const unsigned pk = cvt_pk_bf16(x1 * c - x2 * sn, x1 * sn + x2 * c); qr[4][e] = (short)(pk & 0xffffu); qr[5][e] = (short)(pk >> 16); } } }
    float m0, l_reg = 0.f; f32x16 o0, o1;
#pragma unroll
    for (int r = 0; r < 16; ++r) { o0[r] = 0.f; o1[r] = 0.f; }
    const GAS bf16* Kh = P.K + (size_t)sbase * 768 + 96 * head + 8 * hi;
    const GAS bf16* Vh = P.VT + (size_t)(64 * head + r32) * P.rows + sbase + 8 * hi;
    { f32x16 p0, p1; mla_scores(Kh, 0, r32, qr, p0, p1);
      float mx = fmaxf(p0[0], p1[0]);
#pragma unroll
      for (int r = 1; r < 16; ++r) mx = fmaxf(mx, fmaxf(p0[r], p1[r]));
      m0 = fmaxf(mx, __shfl_xor(mx, 32)); }
#pragma unroll 1
    for (int t = wid; t < nt; t += 8) {
        const int kb = (t == nt - 1) ? T : 64 * t;
        f32x16 p0, p1; mla_scores(Kh, kb, r32, qr, p0, p1);
        bf16x8 vf[8];
#pragma unroll
        for (int ks = 0; ks < 4; ++ks) { const GAS bf16* v0 = Vh + kb + 16 * ks; vf[2 * ks] = *(const GAS bf16x8*)v0; vf[2 * ks + 1] = *(const GAS bf16x8*)(v0 + (size_t)32 * P.rows); }
        if (t == nt - 1) {
#pragma unroll
            for (int r = 0; r < 16; ++r) { if (crow(r, hi) >= 16) p0[r] = -INFINITY; p1[r] = -INFINITY; }
        }
        float ls = 0.f;
#pragma unroll
        for (int r = 0; r < 16; ++r) { p0[r] = __builtin_amdgcn_exp2f(fminf(p0[r] - m0, 100.0f)); p1[r] = __builtin_amdgcn_exp2f(fminf(p1[r] - m0, 100.0f)); ls += p0[r] + p1[r]; }
        l_reg += ls;
#pragma unroll
        for (int ks = 0; ks < 4; ++ks) { u32x4 w;
            if (ks < 2) { w.x = cvt_pk_bf16(p0[8 * ks + 0], p0[8 * ks + 1]); w.y = cvt_pk_bf16(p0[8 * ks + 2], p0[8 * ks + 3]); w.z = cvt_pk_bf16(p0[8 * ks + 4], p0[8 * ks + 5]); w.w = cvt_pk_bf16(p0[8 * ks + 6], p0[8 * ks + 7]); }
            else { const int b = 8 * (ks - 2); w.x = cvt_pk_bf16(p1[b + 0], p1[b + 1]); w.y = cvt_pk_bf16(p1[b + 2], p1[b + 3]); w.z = cvt_pk_bf16(p1[b + 4], p1[b + 5]); w.w = cvt_pk_bf16(p1[b + 6], p1[b + 7]); }
            const bf16x8 pa = __builtin_bit_cast(bf16x8, w);
            o0 = MFMA32(pa, vf[2 * ks], o0); o1 = MFMA32(pa, vf[2 * ks + 1], o1); }
    }
    l_reg += __shfl_xor(l_reg, 32);
    LAS float* red = (LAS float*)lds; LAS float* lred = (LAS float*)(lds + 108544);
#pragma unroll
    for (int r = 0; r < 16; ++r) { red[wid * 2048 + (r * 2 + 0) * 64 + lane] = o0[r]; red[wid * 2048 + (r * 2 + 1) * 64 + lane] = o1[r]; }
    if (hi == 0) lred[wid * 32 + r32] = l_reg;
    asm volatile("s_waitcnt lgkmcnt(0)" ::: "memory"); __syncthreads();
#pragma unroll 1
    for (int e = tid; e < 2048; e += NTHR) { float a = 0.f;
#pragma unroll
        for (int w = 0; w < 8; ++w) a += red[w * 2048 + e];
        red[e] = a; }
    if (tid < 32) { float a = 0.f;
#pragma unroll
        for (int w = 0; w < 8; ++w) a += lred[w * 32 + tid];
        lred[tid] = a; }
    asm volatile("s_waitcnt lgkmcnt(0)" ::: "memory"); __syncthreads();
    if (wid == 0) {
#pragma unroll
        for (int r = 0; r < 16; ++r) { o0[r] = red[(r * 2 + 0) * 64 + lane]; o1[r] = red[(r * 2 + 1) * 64 + lane]; }
        LAS float* lsum = lred;
        float rl[16];
#pragma unroll
        for (int j = 0; j < 4; ++j) { const f32x4 lv = *(const LAS f32x4*)(lsum + 8 * j + 4 * hi);
#pragma unroll
            for (int e = 0; e < 4; ++e) rl[4 * j + e] = __builtin_amdgcn_rcpf(lv[e]); }
        asm volatile("s_waitcnt lgkmcnt(0)" ::: "memory");
        LAS unsigned short* stg = (LAS unsigned short*)(lds + A_STG);
#pragma unroll
        for (int r = 0; r < 16; ++r) { const int orow = crow(r, hi); const unsigned pk = cvt_pk_bf16(o0[r] * rl[r], o1[r] * rl[r]); stg[orow * 64 + r32] = (unsigned short)(pk & 0xffffu); stg[orow * 64 + 32 + r32] = (unsigned short)(pk >> 16); }
        asm volatile("s_waitcnt lgkmcnt(0)" ::: "memory");
#pragma unroll
        for (int i = 0; i < 2; ++i) { const int row = i * 8 + (lane >> 3), ch = lane & 7; const u32x4 v = *(const LAS u32x4*)(stg + row * 64 + ch * 8);
            *(GAS u32x4*)(P.YC + (size_t)(sbase + T + row) * DM + 512 + 64 * head + ch * 8) = v; }
        asm volatile("s_waitcnt lgkmcnt(0)" ::: "memory");
    }
}
__device__ __forceinline__ void attn_phase(KArgsP ap, int l, const Grp& G, unsigned* ctr, LAS unsigned char* lds, int tid, int wid, int lane) {
    const KArgs& a = *ap;
    AttG P; P.Q = (const GAS bf16*)a.out + (size_t)G.row0 * DM; P.K = (const GAS bf16*)(a.ws + WS_BIG + B_K); P.VT = (const GAS bf16*)(a.ws + WS_BIG + B_VT); P.Z = (const GAS bf16*)(a.ws + WS_BIG + B_Z);
    P.YC = (GAS bf16*)(a.ws + WS_BIG + B_YC) + (size_t)G.row0 * DM; P.rope = (const GAS float*)(a.ws + WS_ROPE); P.rows = G.rows; P.T = G.T; P.Lp = G.Lp;
    { LAS float* tab = (LAS float*)(lds + A_TAB); const GAS float* rpb = (const GAS float*)a.in[I_RPB] + (size_t)l * 4 * 465; const GAS float* mb = (const GAS float*)a.in[I_MB] + (size_t)l * 64;
      for (int e = tid; e < 4 * 640; e += NTHR) { const int h = e / 640, j = e - h * 640 - 64; tab[e] = (j >= 0 && j < 465) ? rpb[h * 465 + j] * LOG2E : 0.f; }
      if (tid < 64) tab[4 * 640 + tid] = mb[tid] * LOG2E; }
    const int nqb = (G.T >> 8) + 1; const int P8 = G.nseq, P4 = G.nseq >> 1; const int nq_mla = P8 * nqb, nq_tot = nq_mla + P4 * nqb;
    LAS volatile unsigned* uw = (LAS volatile unsigned*)(lds + A_UW);
    int q = (int)(__builtin_amdgcn_s_getreg((3 << 11) | 20) & 7u), tried = 0;
    for (;;) {
        __syncthreads();
        if (tid == 0) { unsigned j; for (;;) { j = atomicAdd(ctr + q, 1u); if (j < (unsigned)nq_tot || tried >= 7) break; q = (q + 1) & 7; ++tried; }
            *uw = (j < (unsigned)nq_tot) ? (((unsigned)q << 16) | j) : 0xffffffffu; }
        __syncthreads();
        const unsigned w = *uw;
        if (w == 0xffffffffu) break;
        const int qq = (int)(w >> 16), j = (int)(w & 0xffffu);
        if (j < nq_mla) { const int pair = qq * P8 + j / nqb, qb = j % nqb; if (qb == nqb - 1) attn_meta_mla(P, pair >> 3, pair & 7, lds, tid, wid, lane); else attn_unit_mla(P, pair >> 3, pair & 7, qb, lds, tid, wid, lane); }
        else { const int v = j - nq_mla; const int pair = qq * P4 + v / nqb, qb = v % nqb; attn_unit<1>(P, pair >> 2, pair & 3, qb, lds, tid, wid, lane); }
    }
}
#define XB_TMO      128
#define XB_XCNT(j)  (256  + 64 * (j))
#define XB_XSUB(j)  (1280 + 64 * (j))
#define XB_XGEN(j)  (2304 + 64 * (j))
#define XB_TOP      3328
#define XB_TOPGEN   3392
#define XCD_BAR_WORDS 3456
#define XB_SPIN_CAP (1u << 18)

__device__ __forceinline__ unsigned xb_ld(unsigned* p)              { return __hip_atomic_load(p, __ATOMIC_RELAXED, __HIP_MEMORY_SCOPE_AGENT); }
__device__ __forceinline__ unsigned xb_add(unsigned* p, unsigned v) { return __hip_atomic_fetch_add(p, v, __ATOMIC_RELAXED, __HIP_MEMORY_SCOPE_AGENT); }
__device__ __forceinline__ unsigned xb_xcc_id() { return (unsigned)__builtin_amdgcn_s_getreg((3 << 11) | 20) & 0xFu; }
#define XB_SPIN(cond, bar) do { unsigned _sp = 0; while (cond) { __builtin_amdgcn_s_sleep(1); \
    if ((++_sp & 255u) == 0u) { if (xb_ld(&(bar)[XB_TMO])) break; if (_sp > XB_SPIN_CAP) { atomicAdd(&(bar)[XB_TMO], 1u); break; } } } } while (0)

struct XcdBarrier {
    unsigned* bar; unsigned x;
    volatile LAS unsigned* st;
};

__device__ __forceinline__ XcdBarrier xcd_barrier_post(unsigned* bar, volatile LAS unsigned* st) {
    XcdBarrier b; b.bar = bar; b.x = xb_xcc_id(); b.st = st;
    if (threadIdx.x == 0) (void)xb_add(&bar[XB_XCNT(b.x)], 1u);
    return b;
}
__device__ __forceinline__ void xcd_barrier_complete(unsigned* bar, unsigned x, unsigned& nloc, unsigned& nx) {
    const unsigned G = gridDim.x * gridDim.y * gridDim.z;
    unsigned sum, cnt, mine, sp = 0u;
    for (;;) {
        sum = 0u; cnt = 0u; mine = 0u;
#pragma unroll
        for (unsigned j = 0; j < 16; ++j) { const unsigned c = xb_ld(&bar[XB_XCNT(j)]); sum += c; cnt += (c > 0u) ? 1u : 0u; mine = (j == x) ? c : mine; }
        if (sum == G) break;
        __builtin_amdgcn_s_sleep(1);
        if ((++sp & 255u) == 0u) { if (xb_ld(&bar[XB_TMO])) break; if (sp > XB_SPIN_CAP) { atomicAdd(&bar[XB_TMO], 1u); break; } }
    }
    nloc = mine > 0u ? mine : 1u; nx = cnt > 0u ? cnt : 1u;
}

__device__ __forceinline__ void xcd_barrier(const XcdBarrier& b) {
    asm volatile("s_waitcnt vmcnt(0)" ::: "memory");
    __syncthreads();
    if (threadIdx.x == 0) {
        unsigned* bar = b.bar;
        __builtin_amdgcn_s_waitcnt(0);
        unsigned nloc = b.st[0], nx = b.st[1];
        if (nloc == 0u) { xcd_barrier_complete(bar, b.x, nloc, nx); b.st[0] = nloc; b.st[1] = nx; }
        const unsigned old = xb_add(&bar[XB_XSUB(b.x)], 1u);
        const unsigned gen = old / nloc;
        if (old + 1u == (gen + 1u) * nloc) {
            __builtin_amdgcn_fence(__ATOMIC_RELEASE, "agent");
            asm volatile("s_waitcnt vmcnt(0)" ::: "memory");
            const unsigned og = xb_add(&bar[XB_TOP], 1u);
            const unsigned tg = og / nx;
            if (og + 1u == (tg + 1u) * nx) xb_add(&bar[XB_TOPGEN], 1u);
            else XB_SPIN(xb_ld(&bar[XB_TOPGEN]) == tg, bar);
            __builtin_amdgcn_fence(__ATOMIC_ACQUIRE, "agent");
            xb_add(&bar[XB_XGEN(b.x)], 1u);
            asm volatile("s_waitcnt vmcnt(0)" ::: "memory");
        } else {
            XB_SPIN(xb_ld(&bar[XB_XGEN(b.x)]) == gen, bar);
            __builtin_amdgcn_fence(__ATOMIC_ACQUIRE, "agent");
            asm volatile("s_waitcnt vmcnt(0)" ::: "memory");
        }
    }
    __syncthreads();
}

constexpr int CW_BAR = 1024;
#define XBAR() do { KArgsP A_ = KA(); XcdBarrier b_; b_.bar = (unsigned*)(A_->ws + WS_CTL) + CW_BAR; b_.x = xb_xcc_id(); b_.st = (volatile LAS unsigned*)(L + 133120); xcd_barrier(b_); } while (0)

#ifndef REP_GEMM
#define REP_GEMM 1
#endif
#ifndef REP_ATT
#define REP_ATT 1
#endif
#ifndef REP_FFN
#define REP_FFN 1
#endif
#define GEMM_CALL1(EpiT, gobj, sobj, eobj) pg8::gemm_phase<EpiT, pg8::StaticOrder, true, true>(L, gobj, sobj, eobj)
#define GEMM_CALL2(EpiT, gobj, sobj, eobj) do { GEMM_CALL1(EpiT, gobj, sobj, eobj); asm volatile("" ::: "memory"); GEMM_CALL1(EpiT, gobj, sobj, eobj); } while (0)
#if REP_FFN == 1
#define GEMM_CALL_F GEMM_CALL1
#else
#define GEMM_CALL_F GEMM_CALL2
#endif
#if REP_GEMM == 1
#define GEMM_CALL(EpiT, gobj, sobj, eobj) pg8::gemm_phase<EpiT, pg8::StaticOrder, true, true>(L, gobj, sobj, eobj)
#else
#define GEMM_CALL(EpiT, gobj, sobj, eobj) do { pg8::gemm_phase<EpiT, pg8::StaticOrder, true, true>(L, gobj, sobj, eobj); asm volatile("" ::: "memory"); pg8::gemm_phase<EpiT, pg8::StaticOrder, true, true>(L, gobj, sobj, eobj); } while (0)
#endif
#define KA() ({ KArgsP p_ = (KArgsP)__builtin_amdgcn_kernarg_segment_ptr(); asm volatile("" : "+s"(p_)); p_; })
__global__ void __launch_bounds__(NTHR, 2) mk_fwd(Args a_unused) {
    extern __shared__ __attribute__((aligned(16))) unsigned char lds_raw[];
    cg::grid_group grid = cg::this_grid();
    LAS unsigned char* L = (LAS unsigned char*)lds_raw;
#define TID ({ int t_ = (int)threadIdx.x; asm volatile("" : "+v"(t_)); t_; })
#define LANE (TID & 63)
#define WID (__builtin_amdgcn_readfirstlane(TID >> 6))
#define NG ((int)gridDim.x)
#define BX ((int)blockIdx.x)
#define GW (BX * NWAVES + WID)
#define NGW (NG * NWAVES)
#define SCR ((LAS float*)(L + WID * 8448))
    if (threadIdx.x < 2) ((volatile LAS unsigned*)(L + 133120))[threadIdx.x] = 0u;
    __syncthreads();
    { KArgsP A = KA(); (void)xcd_barrier_post((unsigned*)(A->ws + WS_CTL) + CW_BAR, (volatile LAS unsigned*)(L + 133120)); }
    { KArgsP A = KA(); rope_table((GAS float*)(A->ws + WS_ROPE), BX * NTHR + TID, NG * NTHR); }
    { KArgsP A = KA(); convert_layer(A, 0, SCR, GW, NGW, LANE); }
    { KArgsP A = KA(); rowpass(A, nullptr, 0.f, true, 0, MP, GW, NGW, LANE); }
    grid.sync();
    for (int st = 0; st < 3 * DEPTH; ++st) {
        const int l = st / 3, k = st - 3 * l;
        if (k != 1) {
            const int f = k >> 1;
            { KArgsP A = KA(); unsigned char* ws = A->ws; pg8::Gemm g{(const bf16*)(ws + WS_XY), (const bf16*)(ws + WS_W + (f ? W_GU2 : W_GU1)), MP, 2 * FF, DM, DM, DM}; pg8::StaticOrder S; S.init(MP, 2 * FF, NG, BX);
              pg8::EpiSwiGLU E{(GAS bf16*)(ws + WS_BIG), FF, (const GAS float*)(ws + WS_RINV), (LAS float*)(L + 132096)}; GEMM_CALL_F(pg8::EpiSwiGLU, g, S, E); }
            XBAR();
            constexpr int DN_MAIN = 1024, DN_REST = (MP / 256) * 4 - DN_MAIN, ROWS_MAIN = (DN_MAIN / 4) * 256;
            { KArgsP A = KA(); unsigned char* ws = A->ws; pg8::Gemm g{(const bf16*)(ws + WS_BIG), (const bf16*)(ws + WS_W + (f ? W_DN2 : W_DN1)), MP, DM, FF, FF, FF}; pg8::LinearOrder S; S.init(0, DN_MAIN, 4, NG, BX);
              pg8::EpiPlain E{(GAS bf16*)A->out, DM}; pg8::gemm_phase<pg8::EpiPlain, pg8::LinearOrder, true, true>(L, g, S, E); }
            XBAR();
            const bool last = (l == DEPTH - 1 && f == 1);
            { const int vc = (BX % 8) * (NG / 8) + BX / 8;
              if (vc < DN_REST) { KArgsP A = KA(); unsigned char* ws = A->ws; pg8::Gemm g{(const bf16*)(ws + WS_BIG), (const bf16*)(ws + WS_W + (f ? W_DN2 : W_DN1)), MP, DM, FF, FF, FF}; pg8::LinearOrder S; S.init(DN_MAIN, DN_REST, 4, NG, BX);
                  pg8::EpiPlain E{(GAS bf16*)A->out, DM}; pg8::gemm_phase<pg8::EpiPlain, pg8::LinearOrder, true, true>(L, g, S, E); }
              else { KArgsP A = KA(); rowpass(A, (const GAS float*)A->in[f ? I_F2POST : I_F1POST] + l * DM, 0.5f, false, 0, ROWS_MAIN, (vc - DN_REST) * NWAVES + WID, (NG - DN_REST) * NWAVES, LANE); } }
            XBAR();
            { KArgsP A = KA(); rowpass(A, (const GAS float*)A->in[f ? I_F2POST : I_F1POST] + l * DM, 0.5f, false, ROWS_MAIN, MP, GW, NGW, LANE); }
            if (f == 1 && !last) { KArgsP A = KA(); convert_layer(A, l + 1, SCR, GW, NGW, LANE); }
            if (f == 1) XBAR();
            if (last) { KArgsP A = KA(); output_pass(A, GW, NGW, LANE); }
        } else {
            for (int gi = 0; gi < 2; ++gi) {
                { KArgsP A = KA(); unsigned char* ws = A->ws; const Grp G = grp_of(gi);
                  pg8::Gemm g{(const bf16*)(ws + WS_XY) + (size_t)G.row0 * DM, (const bf16*)(ws + WS_W + W_IN), G.rows, NINP, DM, DM, DM}; pg8::StaticOrder S; S.init(G.rows, NINP, NG, BX);
                  pg8::EpiInProj E{(GAS bf16*)(ws + WS_BIG + B_Z), (GAS float*)(ws + WS_SSP) + (size_t)G.row0 * 32, (const GAS float*)(ws + WS_RINV) + G.row0, (LAS float*)(L + 132096)}; GEMM_CALL(pg8::EpiInProj, g, S, E); }
                if (gi == 1) { KArgsP A = KA(); ynorm_pass(A, 0, G0_ROWS, GW, NGW, LANE); }
                XBAR();
                { KArgsP A = KA(); unsigned char* ws = A->ws; const Grp G = grp_of(gi);
                  pg8::Gemm g{(const bf16*)(ws + WS_BIG + B_Z) + 1536, (const bf16*)(ws + WS_W + W_UQ), G.rows, 768, 768, ZP, 768}; pg8::StaticOrder S; S.init(G.rows, 768, NG, BX);
                  pg8::EpiRowScale E{(GAS bf16*)A->out + (size_t)G.row0 * DM, 768, (const GAS float*)(ws + WS_SSP) + (size_t)G.row0 * 32, 0, 6, 1.0f / 768.0f, 0.10206207261596575f * LOG2E, 0, (LAS float*)(L + 132096)}; GEMM_CALL(pg8::EpiRowScale, g, S, E); }
                { KArgsP A = KA(); unsigned char* ws = A->ws; const Grp G = grp_of(gi);
                  pg8::Gemm g{(const bf16*)(ws + WS_BIG + B_Z) + 2304, (const bf16*)(ws + WS_W + W_UK), G.rows, 512, 256, ZP, 256}; pg8::StaticOrder S; S.init(G.rows, 512, NG, BX, NG - 140 % NG);
                  pg8::EpiRowScale E{(GAS bf16*)(ws + WS_BIG + B_K), 768, (const GAS float*)(ws + WS_SSP) + (size_t)G.row0 * 32, 24, 2, 1.0f / 256.0f, 1.0f, 1, (LAS float*)(L + 132096)}; GEMM_CALL(pg8::EpiRowScale, g, S, E); }
                { KArgsP A = KA(); unsigned char* ws = A->ws; const Grp G = grp_of(gi);
                  pg8::Gemm g{(const bf16*)(ws + WS_W + W_UV), (const bf16*)(ws + WS_BIG + B_Z) + 2304, 512, G.rows, 256, 256, ZP}; pg8::StaticOrder S; S.init(512, G.rows, NG, BX, NG - 148 % NG);
                  pg8::EpiColScale E{(GAS bf16*)(ws + WS_BIG + B_VT), G.rows, (const GAS float*)(ws + WS_SSP) + (size_t)G.row0 * 32, (LAS float*)(L + 132096)}; GEMM_CALL(pg8::EpiColScale, g, S, E); }
                { KArgsP A = KA(); const Grp G = grp_of(gi); conv_kpe_pass(A, l, G, GW, NGW, LANE); }
                XBAR();
                { KArgsP A = KA(); const Grp G = grp_of(gi); for (int rep_ = 0; rep_ < REP_ATT; ++rep_) attn_phase(A, l, G, (unsigned*)(A->ws + WS_CTL) + 64 * (l * 2 + gi) + 32 * rep_, L, TID, WID, LANE); }
                XBAR();
            }
            { KArgsP A = KA(); ynorm_pass(A, G0_ROWS, MP, GW, NGW, LANE); }
            XBAR();
            { KArgsP A = KA(); unsigned char* ws = A->ws;
              pg8::Gemm g{(const bf16*)(ws + WS_BIG + B_YC), (const bf16*)(ws + WS_W + W_O), MP, DM, DM, DM, DM}; pg8::StaticOrder S; S.init(MP, DM, NG, BX);
              pg8::EpiPlain E{(GAS bf16*)A->out, DM}; GEMM_CALL(pg8::EpiPlain, g, S, E); }
            XBAR();
            { KArgsP A = KA(); rowpass(A, (const GAS float*)A->in[I_MPOST] + l * DM, 1.0f, false, 0, MP, GW, NGW, LANE); }
            XBAR();
        }
    }
}

extern "C" void kernel_launch(void* const* d_in, const int* in_sizes, int n_in, void* d_out, int out_size, void* d_ws, size_t ws_size, hipStream_t stream) {
    static int grid = 0;
    if (grid == 0) {
        if (n_in != 25 || ws_size < WS_END) { fprintf(stderr, "kernel_launch: need 25 inputs and %zu B of workspace (got %d, %zu)\n", (size_t)WS_END, n_in, ws_size); grid = -1; return; }
        int dev = 0, cus = 0, per_cu = 0;
        if (hipGetDevice(&dev) != hipSuccess || hipDeviceGetAttribute(&cus, hipDeviceAttributeMultiprocessorCount, dev) != hipSuccess) { grid = -1; return; }
        if (hipFuncSetAttribute((const void*)mk_fwd, hipFuncAttributeMaxDynamicSharedMemorySize, LDS_BYTES) != hipSuccess) { fprintf(stderr, "kernel_launch: hipFuncSetAttribute failed\n"); grid = -1; return; }
        if (hipOccupancyMaxActiveBlocksPerMultiprocessor(&per_cu, (const void*)mk_fwd, NTHR, LDS_BYTES) != hipSuccess || per_cu < 1) { fprintf(stderr, "kernel_launch: occupancy query says %d\n", per_cu); }
        (void)hipGetLastError();
        grid = cus;
    }
    if (grid < 0) return;
    if (hipMemsetAsync((char*)d_ws + WS_CTL, 0, 32768, stream) != hipSuccess) return;
    Args a{};
    for (int i = 0; i < 25; ++i) a.in[i] = (const float*)d_in[i];
    a.out = (float*)d_out; a.ws = (unsigned char*)d_ws;
    void* args[] = {&a};
    hipError_t e = hipLaunchCooperativeKernel((const void*)mk_fwd, dim3(grid), dim3(NTHR), args, LDS_BYTES, stream);
    if (e != hipSuccess) fprintf(stderr, "kernel_launch: cooperative launch failed: %s\n", hipGetErrorString(e));
}
```
